# Optimizing an MI355X kernel written in HIP

```python
import math
import jax, jax.numpy as jnp
from jax import lax
import numpy as np

D_MODEL = 2048
BATCH = 2
SEQ = 16384
DEPTH = 1

GRID_W = 64
PLE_DIM = 256
MIX_W = D_MODEL
RWKV_W = MIX_W // 2
NAT_W = MIX_W - RWKV_W
HEAD_SIZE = 64
RWKV_HEADS = RWKV_W // HEAD_SIZE
NAT_HEADS = NAT_W // HEAD_SIZE
DECAY_LORA = 64
ICLR_LORA = 64
N_DIR = 2
NAT_KH = 8
NAT_KW = 16
NORM_EPS = 1e-6
LNX_EPS = 64e-5
DECAY_SCALE = math.exp(-0.5)

O_R = 0
O_K = RWKV_W
O_V = 2 * RWKV_W
O_WD = 3 * RWKV_W
O_AD = O_WD + N_DIR * DECAY_LORA
SHIFT_W = O_AD + N_DIR * ICLR_LORA
O_G_RWKV = SHIFT_W
O_NAT = SHIFT_W + RWKV_W
IN_W = O_NAT + 4 * NAT_W

kernel_name = "hybrid_rwkv7_natten2d_bidir_block"


def rms_norm(x, g):
    xf = x.astype(jnp.float32)
    y = xf * lax.rsqrt(jnp.mean(xf * xf, axis=-1, keepdims=True) + NORM_EPS)
    return (y * g.astype(jnp.float32)).astype(x.dtype)


def centred_shift_mix(z, mu_prev, mu_next):
    prev = jnp.pad(z[:, :-1], ((0, 0), (1, 0), (0, 0)))
    nxt = jnp.pad(z[:, 1:], ((0, 0), (0, 1), (0, 0)))
    return z + mu_prev * (prev - z) + mu_next * (nxt - z)


def wkv7_scan(r, w, k, v, a_vec, b_vec, reverse):
    bsz, _, nh, n = r.shape
    xs = tuple(jnp.moveaxis(t, 1, 0) for t in (r, w, k, v, a_vec, b_vec))

    def step(state, inp):
        r_t, w_t, k_t, v_t, a_t, b_t = inp
        sa = jnp.einsum('bhvk,bhk->bhv', state, a_t)
        state = (state * w_t[:, :, None, :]
                 + sa[..., None] * b_t[:, :, None, :]
                 + v_t[..., None] * k_t[:, :, None, :])
        y = jnp.einsum('bhvk,bhk->bhv', state, r_t)
        return state, y

    s0 = jnp.zeros((bsz, nh, n, n), jnp.float32)
    _, ys = lax.scan(step, s0, xs, reverse=reverse)
    return jnp.moveaxis(ys, 0, 1)


def rwkv7_branch(zs, gate, w0, w2, a0, a2, k_k, k_a, r_k, lnx_w, lnx_b):
    bsz, t_len, _ = zs.shape
    zf = zs.astype(jnp.float32)
    hd = (bsz, t_len, RWKV_HEADS, HEAD_SIZE)
    r = zf[..., O_R:O_K]
    k = zf[..., O_K:O_V]
    v = zf[..., O_V:O_WD]
    wd = zf[..., O_WD:O_AD].reshape(bsz, t_len, N_DIR, DECAY_LORA)
    ad = zf[..., O_AD:SHIFT_W].reshape(bsz, t_len, N_DIR, ICLR_LORA)
    f32 = lambda a: a.astype(jnp.float32)
    decay = jnp.exp(-DECAY_SCALE * jax.nn.sigmoid(
        f32(w0) + jnp.einsum('btdr,drc->btdc', jnp.tanh(wd), f32(w2))))
    iclr = jax.nn.sigmoid(f32(a0) + jnp.einsum('btdr,drc->btdc', ad, f32(a2)))
    kk = (k * f32(k_k)).reshape(hd)
    kk = kk / jnp.maximum(jnp.sqrt(jnp.sum(kk * kk, axis=-1, keepdims=True)), 1e-12)
    k_dir = k[:, :, None, :] * (1.0 + (iclr - 1.0) * f32(k_a))
    rh, vh = r.reshape(hd), v.reshape(hd)
    ys = []
    for d in range(N_DIR):
        ys.append(wkv7_scan(rh, decay[:, :, d].reshape(hd), k_dir[:, :, d].reshape(hd), vh,
                            -kk, kk * iclr[:, :, d].reshape(hd), reverse=(d == 1)))
    y = ys[0] + ys[1]
    mu = jnp.mean(y, axis=-1, keepdims=True)
    var = jnp.mean(jnp.square(y - mu), axis=-1, keepdims=True)
    y = (y - mu) * lax.rsqrt(var + LNX_EPS)
    y = y * f32(lnx_w).reshape(RWKV_HEADS, HEAD_SIZE) + f32(lnx_b).reshape(RWKV_HEADS, HEAD_SIZE)
    bonus = jnp.sum(rh * k.reshape(hd) * f32(r_k), axis=-1, keepdims=True) * vh
    out = (y + bonus).reshape(bsz, t_len, RWKV_W) * jax.nn.silu(gate.astype(jnp.float32))
    return out.astype(zs.dtype)


def nat2d_branch(q, k, v, rpb):
    bsz, t_len, _ = q.shape
    rows = t_len // GRID_W
    kh = min(NAT_KH, rows)
    scale = HEAD_SIZE ** -0.5

    def to_grid(a):
        return a.reshape(bsz, rows, GRID_W, NAT_HEADS, HEAD_SIZE).transpose(0, 3, 1, 2, 4)

    qg, kg, vg = to_grid(q), to_grid(k), to_grid(v)
    row_start = jnp.clip(jnp.arange(rows) - kh // 2, 0, rows - kh)
    cols = jnp.arange(GRID_W)
    col_idx = jnp.clip(cols - NAT_KW // 2, 0, GRID_W - NAT_KW)[:, None] + jnp.arange(NAT_KW)[None, :]
    bias_c = col_idx - cols[:, None] + (NAT_KW - 1)

    def one_row(args):
        r, q_row = args
        rs = row_start[r]
        k_rows = lax.dynamic_slice_in_dim(kg, rs, kh, axis=2)
        v_rows = lax.dynamic_slice_in_dim(vg, rs, kh, axis=2)
        k_nb = k_rows[:, :, :, col_idx]
        v_nb = v_rows[:, :, :, col_idx]
        s = jnp.einsum('bhcd,bhicjd->bhcij', q_row, k_nb).astype(jnp.float32) * scale
        bias_r = rs + jnp.arange(kh) - r + (NAT_KH - 1)
        bias = rpb[:, bias_r[None, :, None], bias_c[:, None, :]]
        s = s + bias.astype(jnp.float32)[None]
        prob = jax.nn.softmax(s.reshape(bsz, NAT_HEADS, GRID_W, kh * NAT_KW), axis=-1)
        prob = prob.reshape(bsz, NAT_HEADS, GRID_W, kh, NAT_KW).astype(q.dtype)
        return jnp.einsum('bhcij,bhicjd->bhcd', prob, v_nb)

    out = lax.map(one_row, (jnp.arange(rows), jnp.moveaxis(qg, 2, 0)))
    return out.transpose(1, 0, 3, 2, 4).reshape(bsz, t_len, NAT_W)


def setup_inputs(seed: int = 0) -> dict:
    key = jax.random.key(seed)
    ks = jax.random.split(key, 24)
    nrm = lambda k, s: jax.random.normal(k, s, jnp.float32)
    return {
        "x": nrm(ks[0], (BATCH, SEQ, D_MODEL)),
        "p": nrm(ks[1], (DEPTH, BATCH, SEQ, PLE_DIM)),
        "norm_mix_g": 1.0 + 0.02 * nrm(ks[2], (DEPTH, D_MODEL)),
        "w_in": nrm(ks[3], (DEPTH, D_MODEL, IN_W)) * D_MODEL ** -0.5,
        "shift_mu_prev": jax.random.uniform(ks[4], (DEPTH, SHIFT_W), jnp.float32, 0.0, 0.5),
        "shift_mu_next": jax.random.uniform(ks[5], (DEPTH, SHIFT_W), jnp.float32, 0.0, 0.5),
        "decay_w0": jax.random.uniform(ks[6], (DEPTH, N_DIR, RWKV_W), jnp.float32, -6.0, 1.0),
        "decay_w2": nrm(ks[7], (DEPTH, N_DIR, DECAY_LORA, RWKV_W)) * 0.5 * DECAY_LORA ** -0.5,
        "iclr_a0": 0.5 * nrm(ks[8], (DEPTH, N_DIR, RWKV_W)),
        "iclr_a2": nrm(ks[9], (DEPTH, N_DIR, ICLR_LORA, RWKV_W)) * 0.5 * ICLR_LORA ** -0.5,
        "k_k": 0.85 + 0.05 * nrm(ks[10], (DEPTH, RWKV_W)),
        "k_a": 1.0 + 0.05 * nrm(ks[11], (DEPTH, RWKV_W)),
        "r_k": 0.1 * nrm(ks[12], (DEPTH, RWKV_HEADS, HEAD_SIZE)),
        "lnx_w": 1.0 + 0.02 * nrm(ks[13], (DEPTH, RWKV_W)),
        "lnx_b": 0.02 * nrm(ks[14], (DEPTH, RWKV_W)),
        "nat_rpb": 0.1 * nrm(ks[15], (DEPTH, NAT_HEADS, 2 * NAT_KH - 1, 2 * NAT_KW - 1)),
        "w_out": nrm(ks[16], (DEPTH, MIX_W, D_MODEL)) * MIX_W ** -0.5,
        "ple_norm_g": 1.0 + 0.02 * nrm(ks[17], (DEPTH, D_MODEL)),
        "w_ple_gate": nrm(ks[18], (DEPTH, D_MODEL, D_MODEL)) * D_MODEL ** -0.5,
        "w_ple_proj": nrm(ks[19], (DEPTH, PLE_DIM, D_MODEL)) * PLE_DIM ** -0.5,
        "final_norm_g": 1.0 + 0.02 * nrm(ks[20], (D_MODEL,)),
    }


def reference(x, p, norm_mix_g, w_in, shift_mu_prev, shift_mu_next, decay_w0, decay_w2,
              iclr_a0, iclr_a2, k_k, k_a, r_k, lnx_w, lnx_b, nat_rpb, w_out,
              ple_norm_g, w_ple_gate, w_ple_proj, final_norm_g):
    h = x
    for i in range(DEPTH):
        hn = rms_norm(h, norm_mix_g[i])
        z = hn @ w_in[i]
        zs = centred_shift_mix(z[..., :SHIFT_W], shift_mu_prev[i], shift_mu_next[i])
        y_a = rwkv7_branch(zs, z[..., O_G_RWKV:O_NAT], decay_w0[i], decay_w2[i],
                           iclr_a0[i], iclr_a2[i], k_k[i], k_a[i], r_k[i], lnx_w[i], lnx_b[i])
        qn = z[..., O_NAT:O_NAT + NAT_W]
        kn = z[..., O_NAT + NAT_W:O_NAT + 2 * NAT_W]
        vn = z[..., O_NAT + 2 * NAT_W:O_NAT + 3 * NAT_W]
        gn = z[..., O_NAT + 3 * NAT_W:O_NAT + 4 * NAT_W]
        y_b = nat2d_branch(qn, kn, vn, nat_rpb[i]) * jax.nn.silu(gn)
        h = h + jnp.concatenate([y_a, y_b], axis=-1) @ w_out[i]
        ple_gate = jax.nn.sigmoid(rms_norm(h, ple_norm_g[i]) @ w_ple_gate[i])
        h = h + (p[i] @ w_ple_proj[i]) * ple_gate
    return rms_norm(h, final_norm_g)
```

```cpp
#include <hip/hip_runtime.h>
#include <hip/hip_cooperative_groups.h>
#include <cstdio>
namespace cg = cooperative_groups;

#ifndef MULTI_LAUNCH
#define MULTI_LAUNCH 0
#endif

#define LAS __attribute__((address_space(3)))
typedef unsigned short u16;
typedef short bf16x8 __attribute__((ext_vector_type(8)));
typedef float f32x4 __attribute__((ext_vector_type(4)));
typedef float f32x2 __attribute__((ext_vector_type(2)));
typedef unsigned u32x4 __attribute__((ext_vector_type(4)));
typedef unsigned u32x2 __attribute__((ext_vector_type(2)));
typedef const __attribute__((address_space(4))) f32x2* cf2p;

constexpr int SEQ = 16384, NTOK = 32768, DM = 2048, RW = 1024;
constexpr int NC = 64, LC = SEQ / NC;
constexpr int NTHREADS = 512, LDS_BYTES = 131072;
constexpr float DECAY_SCALE = 0.6065306597126334f;

constexpr size_t MiB = 1ull << 20;
constexpr size_t O_W1T = 0, O_W2T = 33 * MiB, O_W3T = 41 * MiB, O_WPT = 49 * MiB, O_WLT = 50 * MiB;
constexpr size_t O_HN = 56 * MiB;
constexpr size_t O_ZS = 184 * MiB;
constexpr size_t O_KD = O_ZS, O_PT = O_ZS + 128 * MiB, O_SLT = O_ZS + 160 * MiB;
constexpr size_t O_ZG = 392 * MiB;
constexpr size_t O_R = 456 * MiB;
constexpr size_t O_A = 584 * MiB;
constexpr size_t O_V = 712 * MiB;
constexpr size_t O_K = 776 * MiB;
constexpr size_t O_AL = 840 * MiB;
constexpr size_t O_BON = 856 * MiB;
constexpr size_t O_Y = 858 * MiB;
constexpr size_t O_SIT = 986 * MiB;
constexpr size_t WS_END = 1018 * MiB;

struct Params {
    const float *x, *p, *norm_mix_g, *w_in, *mu_prev, *mu_next, *decay_w0, *decay_w2, *iclr_a0, *iclr_a2, *k_k, *k_a, *r_k, *lnx_w, *lnx_b, *rpb, *w_out,
        *ple_norm_g, *w_ple_gate, *w_ple_proj, *final_g;
    float* out; unsigned char* ws;
    int ph_lo, ph_hi;
};

__device__ __forceinline__ float bf2f(u16 b) { return __uint_as_float(((unsigned)b) << 16); }
__device__ __forceinline__ float bflo(unsigned w) { return __uint_as_float(w << 16); }
__device__ __forceinline__ float bfhi(unsigned w) { return __uint_as_float(w & 0xffff0000u); }
__device__ __forceinline__ unsigned cvt_pk_bf16(float lo, float hi) { unsigned r; asm volatile("v_cvt_pk_bf16_f32 %0, %1, %2" : "=v"(r) : "v"(lo), "v"(hi)); return r; }
__device__ __forceinline__ float sigmoidf_(float x) { return __builtin_amdgcn_rcpf(1.0f + __expf(-x)); }
__device__ __forceinline__ f32x2 fma2(f32x2 a, f32x2 b, f32x2 c) { return __builtin_elementwise_fma(a, b, c); }

namespace pg8 {
constexpr int BM = 256, BK = 64, HALF = 128, HTB = HALF * BK * 2, NXCD = 8, WGM = 8;
__device__ __forceinline__ int lds_byte(int r, int c) { const int st = (r >> 4) * 2 + (c >> 5), rr = r & 15, cc = c & 31, ob = rr * 64 + cc * 2; return st * 1024 + (ob ^ (((ob >> 9) & 1) << 5)); }
__device__ __forceinline__ void stage_rc(int b, int& R, int& C) { const int st = b / 1024, sb = b % 1024, swz = sb ^ (((sb >> 9) & 1) << 5); R = (st >> 1) * 16 + swz / 64; C = (st & 1) * 32 + (swz % 64) / 2; }
__device__ __forceinline__ int perm32(int rho) { const int n = rho >> 4, i = rho & 15; return 8 * (i >> 2) + 4 * n + (i & 3); }
struct Unit { int pm, pn; };
struct Gemm { const u16* A; const u16* Bt; int M, N, K; };
struct StaticOrder {
    int nM, nN, nwg, G, c;
    __device__ void init(int M, int N, int G_, int c_) { nM = M / BM; nN = N / BM; nwg = nM * nN; G = G_; c = c_; }
    __device__ bool next(int i, Unit& u) const {
        const long L = (long)i * G + c; if (L >= nwg) return false;
        int wgid = (int)L; { const int q = nwg / NXCD, r = nwg % NXCD, xcd = wgid % NXCD, off = wgid / NXCD; wgid = (xcd < r ? xcd * (q + 1) : r * (q + 1) + (xcd - r) * q) + off; }
        const int nig = WGM * nN, gid = wgid / nig, fm = gid * WGM, gsz = (nM - fm) < WGM ? (nM - fm) : WGM;
        u.pm = fm + ((wgid % nig) % gsz); u.pn = (wgid % nig) / gsz; return true;
    }
};
template <class Epi>
__device__ __forceinline__ void gemm_phase(LAS unsigned char* lds, const Gemm g, const StaticOrder& S, const Epi& E) {
    const int tid = threadIdx.x, wid = __builtin_amdgcn_readfirstlane(tid >> 6), lane = tid & 63, wr = wid >> 2, wc = wid & 3, fr = lane & 15, fq = lane >> 4;
    const int K = g.K, nt = K / BK;
    unsigned voffA[2], voffB[2];
#pragma unroll
    for (int i = 0; i < 2; ++i) { int R, C; stage_rc(tid * 16 + i * 8192, R, C); const int Rb = Epi::PERM ? ((R & ~31) + perm32(R & 31)) : R;
        voffA[i] = (unsigned)(R * K + C) * 2u; voffB[i] = (unsigned)(Rb * K + C) * 2u; }
    const size_t kstep = (size_t)(BK * 2);
    const size_t hstep = (size_t)HALF * K * 2;
    const size_t tstep = 2 * hstep;
    const unsigned ldsw = (unsigned)wid * 1024u;
    const int aoff = lds_byte(wr * 64 + fr, fq * 8), boff = lds_byte(wc * 32 + fr, fq * 8);
#define PG8_SA(b, h) (((b) * 2 + (h)) * HTB)
#define PG8_SB(b, h) ((4 + (b) * 2 + (h)) * HTB)
#define PG8_STAGE(bufoff, gbase, voff) do { _Pragma("unroll") for (int _i = 0; _i < 2; ++_i) \
        __builtin_amdgcn_global_load_lds((const unsigned*)((const char*)(gbase) + (voff)[_i]), (LAS unsigned*)(lds + (bufoff) + ldsw + _i * 8192), 16, 0, 0); } while (0)
#define PG8_LDA(dst, b, h) do { _Pragma("unroll") for (int m = 0; m < 4; ++m) _Pragma("unroll") for (int k = 0; k < 2; ++k) dst[m][k] = *(const LAS bf16x8*)(lds + PG8_SA(b, h) + aoff + m * 2048 + k * 1024); } while (0)
#define PG8_LDB(dst, b, h) do { _Pragma("unroll") for (int n = 0; n < 2; ++n) _Pragma("unroll") for (int k = 0; k < 2; ++k) dst[n][k] = *(const LAS bf16x8*)(lds + PG8_SB(b, h) + boff + n * 2048 + k * 1024); } while (0)
#define PG8_MMA(ai, bj, At, Bt) do { __builtin_amdgcn_s_setprio(1); _Pragma("unroll") for (int m = 0; m < 4; ++m) _Pragma("unroll") for (int n = 0; n < 2; ++n) _Pragma("unroll") for (int k = 0; k < 2; ++k) \
        acc[ai][bj][m][n] = __builtin_amdgcn_mfma_f32_16x16x32_bf16(Bt[n][k], At[m][k], acc[ai][bj][m][n], 0, 0, 0); __builtin_amdgcn_s_setprio(0); } while (0)
#define PG8_WAIT_V(n) asm volatile("s_waitcnt vmcnt(" #n ")" ::: "memory")
#define PG8_WAIT_L(n) asm volatile("s_waitcnt lgkmcnt(" #n ")" ::: "memory")
#define PG8_BAR __builtin_amdgcn_s_barrier()
#define PG8_SCHED __builtin_amdgcn_sched_barrier(0)
    Unit cur, nxt; int ui = 0;
    if (!S.next(0, cur)) return;
    f32x4 acc[2][2][4][2];
#pragma unroll
    for (int a = 0; a < 2; ++a)
#pragma unroll
        for (int b = 0; b < 2; ++b)
#pragma unroll
            for (int m = 0; m < 4; ++m)
#pragma unroll
                for (int n = 0; n < 2; ++n) acc[a][b][m][n] = (f32x4){0.f, 0.f, 0.f, 0.f};
    bf16x8 At[4][2], B0[2][2], B1[2][2];
    const char* cA = (const char*)g.A + (size_t)cur.pm * tstep; const char* cB = (const char*)g.Bt + (size_t)cur.pn * tstep;
    PG8_STAGE(PG8_SB(0, 0), cB, voffB); PG8_STAGE(PG8_SA(0, 0), cA, voffA); PG8_STAGE(PG8_SB(0, 1), cB + hstep, voffB); PG8_STAGE(PG8_SA(0, 1), cA + hstep, voffA);
    if (wr == 1) PG8_BAR;
    PG8_WAIT_V(4); PG8_BAR;
    PG8_STAGE(PG8_SB(1, 0), cB + kstep, voffB); PG8_STAGE(PG8_SA(1, 0), cA + kstep, voffA); PG8_STAGE(PG8_SB(1, 1), cB + hstep + kstep, voffB);
    PG8_WAIT_V(6); PG8_BAR;
    for (;;) {
        const bool has_next = S.next(ui + 1, nxt);
        const char* nA = has_next ? (const char*)g.A + (size_t)nxt.pm * tstep : cA; const char* nB = has_next ? (const char*)g.Bt + (size_t)nxt.pn * tstep : cB;
        for (int t = 0; t < nt; t += 2) {
            const bool last = (t == nt - 2);
            const char* a1 = cA + (size_t)(t + 1) * kstep;
            const char* a2 = last ? nA : cA + (size_t)(t + 2) * kstep; const char* b2 = last ? nB : cB + (size_t)(t + 2) * kstep;
            const char* a3 = a2 + kstep; const char* b3 = b2 + kstep;
            PG8_LDB(B0, 0, 0); PG8_SCHED; PG8_LDA(At, 0, 0); PG8_STAGE(PG8_SA(1, 1), a1 + hstep, voffA);
            PG8_WAIT_L(8); PG8_BAR; PG8_WAIT_L(0); PG8_MMA(0, 0, At, B0); PG8_BAR; PG8_SCHED;
            PG8_LDB(B1, 0, 1); PG8_STAGE(PG8_SB(0, 0), b2, voffB);
            PG8_BAR; PG8_WAIT_L(0); PG8_MMA(0, 1, At, B1); PG8_BAR;
            PG8_LDA(At, 0, 1); PG8_STAGE(PG8_SA(0, 0), a2, voffA);
            PG8_BAR; PG8_WAIT_L(0); PG8_MMA(1, 0, At, B0); PG8_BAR; PG8_SCHED;
            PG8_STAGE(PG8_SB(0, 1), b2 + hstep, voffB);
            PG8_WAIT_V(6); PG8_BAR; PG8_MMA(1, 1, At, B1); PG8_BAR;
            PG8_LDB(B0, 1, 0); PG8_SCHED; PG8_LDA(At, 1, 0); PG8_STAGE(PG8_SA(0, 1), a2 + hstep, voffA);
            PG8_WAIT_L(8); PG8_BAR; PG8_WAIT_L(0); PG8_MMA(0, 0, At, B0); PG8_BAR; PG8_SCHED;
            PG8_LDB(B1, 1, 1); PG8_STAGE(PG8_SB(1, 0), b3, voffB);
            PG8_BAR; PG8_WAIT_L(0); PG8_MMA(0, 1, At, B1); PG8_BAR;
            PG8_LDA(At, 1, 1); PG8_STAGE(PG8_SA(1, 0), a3, voffA);
            PG8_BAR; PG8_WAIT_L(0); PG8_MMA(1, 0, At, B0); PG8_BAR; PG8_SCHED;
            PG8_STAGE(PG8_SB(1, 1), b3 + hstep, voffB);
            PG8_WAIT_V(6); PG8_BAR; PG8_MMA(1, 1, At, B1); PG8_BAR;
        }
        E(acc, cur, wr, wc, fr, fq);
        if (!has_next) break;
#pragma unroll
        for (int a = 0; a < 2; ++a)
#pragma unroll
            for (int b = 0; b < 2; ++b)
#pragma unroll
                for (int m = 0; m < 4; ++m)
#pragma unroll
                    for (int n = 0; n < 2; ++n) acc[a][b][m][n] = (f32x4){0.f, 0.f, 0.f, 0.f};
        cur = nxt; cA = nA; cB = nB; ++ui;
    }
    PG8_WAIT_V(0);
    if (wr == 0) PG8_BAR;
    PG8_BAR;
#undef PG8_SA
#undef PG8_SB
#undef PG8_STAGE
#undef PG8_LDA
#undef PG8_LDB
#undef PG8_MMA
#undef PG8_WAIT_V
#undef PG8_WAIT_L
#undef PG8_BAR
#undef PG8_SCHED
}
}
using pg8::Unit;
typedef f32x4 AccT[2][2][4][2];

struct EpiZ {
    static constexpr bool PERM = true;
    u16 *zs, *zg, *qn, *kn, *vt, *gn;
    __device__ __forceinline__ void operator()(const AccT& acc, const Unit& u, int wr, int wc, int fr, int fq) const {
        const int row0 = u.pm * 256 + wr * 64 + fr; const int pn = u.pn;
        if (pn >= 25 && pn < 29) {
            const int cb = (pn - 25) * 256 + wc * 32 + 8 * fq;
#pragma unroll
            for (int ai = 0; ai < 2; ++ai)
#pragma unroll
                for (int m = 0; m < 4; ++m) { const int row = row0 + ai * 128 + m * 16; const int b = row >> 14, tt = row & (SEQ - 1);
#pragma unroll
                    for (int bj = 0; bj < 2; ++bj)
#pragma unroll
                        for (int n = 0; n < 2; ++n)
#pragma unroll
                            for (int j = 0; j < 4; ++j) { const int ch = cb + bj * 128 + 4 * n + j;
                                vt[((size_t)(b * 1024 + ch)) * SEQ + tt] = (u16)(cvt_pk_bf16(acc[ai][bj][m][n][j], 0.f) & 0xffffu); } }
            return;
        }
        u16* base; int ld, colt;
        if (pn < 13) { base = zs; ld = 3328; colt = pn * 256; }
        else if (pn < 17) { base = zg; ld = 1024; colt = (pn - 13) * 256; }
        else if (pn < 21) { base = qn; ld = 1024; colt = (pn - 17) * 256; }
        else if (pn < 25) { base = kn; ld = 1024; colt = (pn - 21) * 256; }
        else { base = gn; ld = 1024; colt = (pn - 29) * 256; }
        const int col0 = colt + wc * 32 + 8 * fq;
#pragma unroll
        for (int ai = 0; ai < 2; ++ai)
#pragma unroll
            for (int m = 0; m < 4; ++m) { u16* rowp = base + (size_t)(row0 + ai * 128 + m * 16) * ld + col0;
#pragma unroll
                for (int bj = 0; bj < 2; ++bj) { const f32x4 v0 = acc[ai][bj][m][0], v1 = acc[ai][bj][m][1];
                    u32x4 w; w.x = cvt_pk_bf16(v0[0], v0[1]); w.y = cvt_pk_bf16(v0[2], v0[3]); w.z = cvt_pk_bf16(v1[0], v1[1]); w.w = cvt_pk_bf16(v1[2], v1[3]);
                    *(u32x4*)(rowp + bj * 128) = w; } }
    }
};
struct EpiBf {
    static constexpr bool PERM = true;
    u16* O; int ld;
    __device__ __forceinline__ void operator()(const AccT& acc, const Unit& u, int wr, int wc, int fr, int fq) const {
        const int row0 = u.pm * 256 + wr * 64 + fr, col0 = u.pn * 256 + wc * 32 + 8 * fq;
#pragma unroll
        for (int ai = 0; ai < 2; ++ai)
#pragma unroll
            for (int m = 0; m < 4; ++m) { u16* rowp = O + (size_t)(row0 + ai * 128 + m * 16) * ld + col0;
#pragma unroll
                for (int bj = 0; bj < 2; ++bj) { const f32x4 v0 = acc[ai][bj][m][0], v1 = acc[ai][bj][m][1];
                    u32x4 w; w.x = cvt_pk_bf16(v0[0], v0[1]); w.y = cvt_pk_bf16(v0[2], v0[3]); w.z = cvt_pk_bf16(v1[0], v1[1]); w.w = cvt_pk_bf16(v1[2], v1[3]);
                    *(u32x4*)(rowp + bj * 128) = w; } }
    }
};
struct EpiLora {
    static constexpr bool PERM = false;
    const float *w0, *a0, *ka; const float* A; const u16* Kb; float *Wd, *Bd, *KD;
    __device__ __forceinline__ void operator()(const AccT& acc, const Unit& u, int wr, int wc, int fr, int fq) const {
        const int row0 = u.pm * 256 + wr * 64 + fr, col0 = u.pn * 256 + wc * 32 + 4 * fq;
        if (u.pn < 4) {
#pragma unroll
            for (int bj = 0; bj < 2; ++bj)
#pragma unroll
                for (int n = 0; n < 2; ++n) { const int col = col0 + bj * 128 + n * 16; const f32x4 wv = *(const f32x4*)(w0 + col);
#pragma unroll
                    for (int ai = 0; ai < 2; ++ai)
#pragma unroll
                        for (int m = 0; m < 4; ++m) { const int row = row0 + ai * 128 + m * 16; f32x4 o;
#pragma unroll
                            for (int j = 0; j < 4; ++j) o[j] = __expf(-DECAY_SCALE * sigmoidf_(wv[j] + acc[ai][bj][m][n][j]));
                            *(f32x4*)(Wd + (size_t)row * RW + col) = o; asm volatile("" ::: "memory"); } }
        } else {
#pragma unroll
            for (int bj = 0; bj < 2; ++bj)
#pragma unroll
                for (int n = 0; n < 2; ++n) { const int col = col0 - 1024 + bj * 128 + n * 16; const f32x4 av0 = *(const f32x4*)(a0 + col), kav = *(const f32x4*)(ka + col);
#pragma unroll
                    for (int ai = 0; ai < 2; ++ai)
#pragma unroll
                        for (int m = 0; m < 4; ++m) { const int row = row0 + ai * 128 + m * 16; const size_t off = (size_t)row * RW + col;
                            const f32x4 aa = *(const f32x4*)(A + off); const u32x2 kw = *(const u32x2*)(Kb + off);
                            const float kf[4] = {bflo(kw.x), bfhi(kw.x), bflo(kw.y), bfhi(kw.y)}; f32x4 ob, ok;
#pragma unroll
                            for (int j = 0; j < 4; ++j) { const float ic = sigmoidf_(av0[j] + acc[ai][bj][m][n][j]); ob[j] = -aa[j] * ic; ok[j] = kf[j] * (1.0f + (ic - 1.0f) * kav[j]); }
                            *(f32x4*)(Bd + off) = ob; *(f32x4*)(KD + off) = ok; asm volatile("" ::: "memory"); } }
        }
    }
};
struct EpiH {
    static constexpr bool PERM = false;
    const float* X; float* H;
    __device__ __forceinline__ void operator()(const AccT& acc, const Unit& u, int wr, int wc, int fr, int fq) const {
        const int row0 = u.pm * 256 + wr * 64 + fr, col0 = u.pn * 256 + wc * 32 + 4 * fq;
#pragma unroll
        for (int ai = 0; ai < 2; ++ai)
#pragma unroll
            for (int m = 0; m < 4; ++m) { const size_t ro = (size_t)(row0 + ai * 128 + m * 16) * DM + col0;
#pragma unroll
                for (int bj = 0; bj < 2; ++bj)
#pragma unroll
                    for (int n = 0; n < 2; ++n) { const size_t o = ro + bj * 128 + n * 16; *(f32x4*)(H + o) = acc[ai][bj][m][n] + *(const f32x4*)(X + o); } asm volatile("" ::: "memory"); }
    }
};
struct EpiGate {
    static constexpr bool PERM = false;
    float* H; const u16* PP;
    __device__ __forceinline__ void operator()(const AccT& acc, const Unit& u, int wr, int wc, int fr, int fq) const {
        const int row0 = u.pm * 256 + wr * 64 + fr, col0 = u.pn * 256 + wc * 32 + 4 * fq;
#pragma unroll
        for (int ai = 0; ai < 2; ++ai)
#pragma unroll
            for (int m = 0; m < 4; ++m) { const size_t ro = (size_t)(row0 + ai * 128 + m * 16) * DM + col0;
#pragma unroll
                for (int bj = 0; bj < 2; ++bj)
#pragma unroll
                    for (int n = 0; n < 2; ++n) { const size_t o = ro + bj * 128 + n * 16; const f32x4 h = *(const f32x4*)(H + o); const u32x2 pw = *(const u32x2*)(PP + o);
                        const f32x4 a = acc[ai][bj][m][n]; f32x4 r;
                        r[0] = h[0] + bflo(pw.x) * sigmoidf_(a[0]); r[1] = h[1] + bfhi(pw.x) * sigmoidf_(a[1]); r[2] = h[2] + bflo(pw.y) * sigmoidf_(a[2]); r[3] = h[3] + bfhi(pw.y) * sigmoidf_(a[3]);
                        *(f32x4*)(H + o) = r; asm volatile("" ::: "memory"); } }
    }
};

template <class Epi> __device__ __forceinline__ void run_gemm(unsigned char* lds, const u16* A, const u16* Bt, int M, int N, int K, const Epi& E) {
    pg8::Gemm g; g.A = A; g.Bt = Bt; g.M = M; g.N = N; g.K = K;
    pg8::StaticOrder S; S.init(M, N, gridDim.x, blockIdx.x);
    pg8::gemm_phase<Epi>((LAS unsigned char*)lds, g, S, E);
    __syncthreads();
}

__device__ __forceinline__ void transpose_cvt(const float* __restrict__ src, int K, int N, u16* __restrict__ dst, int ldd, float* tile) {
    const int tid = threadIdx.x, tn = N / 64, ntile = (K / 64) * tn;
    for (int t = blockIdx.x; t < ntile; t += gridDim.x) {
        const int k0 = (t / tn) * 64, n0 = (t % tn) * 64;
#pragma unroll
        for (int ps = 0; ps < 2; ++ps) { const int r = (tid >> 4) + ps * 32, c4 = (tid & 15) * 4; const f32x4 v = *(const f32x4*)(src + (size_t)(k0 + r) * N + n0 + c4);
            tile[r * 65 + c4] = v[0]; tile[r * 65 + c4 + 1] = v[1]; tile[r * 65 + c4 + 2] = v[2]; tile[r * 65 + c4 + 3] = v[3]; }
        __syncthreads();
        { const int n = tid >> 3, ks = (tid & 7) * 8; u32x4 w;
          w.x = cvt_pk_bf16(tile[(ks + 0) * 65 + n], tile[(ks + 1) * 65 + n]); w.y = cvt_pk_bf16(tile[(ks + 2) * 65 + n], tile[(ks + 3) * 65 + n]);
          w.z = cvt_pk_bf16(tile[(ks + 4) * 65 + n], tile[(ks + 5) * 65 + n]); w.w = cvt_pk_bf16(tile[(ks + 6) * 65 + n], tile[(ks + 7) * 65 + n]);
          *(u32x4*)(dst + (size_t)(n0 + n) * ldd + k0 + ks) = w; }
        __syncthreads();
    }
}
__device__ __forceinline__ void build_wlt(const Params& p) {
    u16* W = (u16*)(p.ws + O_WLT);
    for (int i = blockIdx.x * NTHREADS + threadIdx.x; i < 2 * 2048 * 256; i += gridDim.x * NTHREADS) {
        const int k = i & 255, n = (i >> 8) & 2047, d = i >> 19; float v = 0.f;
        if (n < 1024) { if ((k >> 6) == d) v = p.decay_w2[((size_t)d * 64 + (k & 63)) * RW + n]; }
        else { if ((k >> 6) == 2 + d) v = p.iclr_a2[((size_t)d * 64 + (k & 63)) * RW + (n - 1024)]; }
        W[i] = (u16)(cvt_pk_bf16(v, 0.f) & 0xffffu);
    }
}
template <bool BF> __device__ __forceinline__ void rownorm(const float* src, const float* __restrict__ g, void* dst) {
    const int lane = threadIdx.x & 63, wid = threadIdx.x >> 6;
    for (int row = blockIdx.x * 8 + wid; row < NTOK; row += gridDim.x * 8) {
        const float* s = src + (size_t)row * DM + lane * 4; f32x4 v[8]; float ss = 0.f;
#pragma unroll
        for (int i = 0; i < 8; ++i) { v[i] = *(const f32x4*)(s + i * 256); ss += v[i][0] * v[i][0] + v[i][1] * v[i][1] + v[i][2] * v[i][2] + v[i][3] * v[i][3]; }
#pragma unroll
        for (int o = 32; o >= 1; o >>= 1) ss += __shfl_xor(ss, o);
        const float sc = rsqrtf(ss * (1.0f / DM) + 1e-6f);
#pragma unroll
        for (int i = 0; i < 8; ++i) { const f32x4 gv = *(const f32x4*)(g + lane * 4 + i * 256); const f32x4 o = v[i] * sc * gv;
            if (BF) { u32x2 w; w.x = cvt_pk_bf16(o[0], o[1]); w.y = cvt_pk_bf16(o[2], o[3]); *(u32x2*)((u16*)dst + (size_t)row * DM + lane * 4 + i * 256) = w; }
            else *(f32x4*)((float*)dst + (size_t)row * DM + lane * 4 + i * 256) = o; }
    }
}

__device__ __forceinline__ void ld16bf(const u16* p, float* o) {
    const u32x4 a = *(const u32x4*)p, b = *(const u32x4*)(p + 8);
    o[0] = bflo(a.x); o[1] = bfhi(a.x); o[2] = bflo(a.y); o[3] = bfhi(a.y); o[4] = bflo(a.z); o[5] = bfhi(a.z); o[6] = bflo(a.w); o[7] = bfhi(a.w);
    o[8] = bflo(b.x); o[9] = bfhi(b.x); o[10] = bflo(b.y); o[11] = bfhi(b.y); o[12] = bflo(b.z); o[13] = bfhi(b.z); o[14] = bflo(b.w); o[15] = bfhi(b.w);
}
__device__ __forceinline__ void st16bf(u16* p, const float* v) {
    u32x4 a, b; a.x = cvt_pk_bf16(v[0], v[1]); a.y = cvt_pk_bf16(v[2], v[3]); a.z = cvt_pk_bf16(v[4], v[5]); a.w = cvt_pk_bf16(v[6], v[7]);
    b.x = cvt_pk_bf16(v[8], v[9]); b.y = cvt_pk_bf16(v[10], v[11]); b.z = cvt_pk_bf16(v[12], v[13]); b.w = cvt_pk_bf16(v[14], v[15]);
    *(u32x4*)p = a; *(u32x4*)(p + 8) = b;
}
__device__ __forceinline__ void shift16(const u16* zc, bool hp, bool hn, const float* __restrict__ mp, const float* __restrict__ mn, int c, float* o) {
    float z[16], zp[16], zn[16]; ld16bf(zc + c, z);
    if (hp) ld16bf(zc - 3328 + c, zp); else {
#pragma unroll
        for (int j = 0; j < 16; ++j) zp[j] = 0.f; }
    if (hn) ld16bf(zc + 3328 + c, zn); else {
#pragma unroll
        for (int j = 0; j < 16; ++j) zn[j] = 0.f; }
#pragma unroll
    for (int j4 = 0; j4 < 4; ++j4) { const f32x4 a = *(const f32x4*)(mp + c + j4 * 4), b = *(const f32x4*)(mn + c + j4 * 4);
#pragma unroll
        for (int j = 0; j < 4; ++j) { const int q = j4 * 4 + j; o[q] = z[q] + a[j] * (zp[q] - z[q]) + b[j] * (zn[q] - z[q]); } }
}
__device__ __forceinline__ void prep_phase(const Params& p) {
    const int lane = threadIdx.x & 63, wid = threadIdx.x >> 6;
    const u16* ZS = (const u16*)(p.ws + O_ZS);
    float* R = (float*)(p.ws + O_R); float* A = (float*)(p.ws + O_A); u16* V = (u16*)(p.ws + O_V); u16* Kb = (u16*)(p.ws + O_K); u16* AL = (u16*)(p.ws + O_AL); float* BON = (float*)(p.ws + O_BON);
    for (int t = blockIdx.x * 8 + wid; t < NTOK; t += gridDim.x * 8) {
        const int tt = t & (SEQ - 1); const bool hp = tt > 0, hn = tt < SEQ - 1;
        const u16* zc = ZS + (size_t)t * 3328; const int c = lane * 16;
        float r[16], k[16], v[16];
        shift16(zc, hp, hn, p.mu_prev, p.mu_next, c, r);
        shift16(zc, hp, hn, p.mu_prev, p.mu_next, 1024 + c, k);
        shift16(zc, hp, hn, p.mu_prev, p.mu_next, 2048 + c, v);
        float kk[16], s2 = 0.f, bs = 0.f;
#pragma unroll
        for (int j4 = 0; j4 < 4; ++j4) { const f32x4 kkv = *(const f32x4*)(p.k_k + c + j4 * 4), rkv = *(const f32x4*)(p.r_k + c + j4 * 4);
#pragma unroll
            for (int j = 0; j < 4; ++j) { const int q = j4 * 4 + j; kk[q] = k[q] * kkv[j]; s2 += kk[q] * kk[q]; bs += r[q] * k[q] * rkv[j]; } }
        s2 += __shfl_xor(s2, 1); s2 += __shfl_xor(s2, 2); bs += __shfl_xor(bs, 1); bs += __shfl_xor(bs, 2);
        const float inv = -1.0f / fmaxf(sqrtf(s2), 1e-12f);
        const size_t o = (size_t)t * RW + c;
#pragma unroll
        for (int j4 = 0; j4 < 4; ++j4) { *(f32x4*)(R + o + j4 * 4) = (f32x4){r[j4 * 4], r[j4 * 4 + 1], r[j4 * 4 + 2], r[j4 * 4 + 3]};
            *(f32x4*)(A + o + j4 * 4) = (f32x4){kk[j4 * 4] * inv, kk[j4 * 4 + 1] * inv, kk[j4 * 4 + 2] * inv, kk[j4 * 4 + 3] * inv}; }
        st16bf(Kb + o, k); st16bf(V + o, v);
        if ((lane & 3) == 0) BON[(size_t)t * 16 + (lane >> 2)] = bs;
        { const int cl = 3072 + lane * 4; const u32x2 zw = *(const u32x2*)(zc + cl); u32x2 pw = {0u, 0u}, nw = {0u, 0u};
          if (hp) pw = *(const u32x2*)(zc - 3328 + cl); if (hn) nw = *(const u32x2*)(zc + 3328 + cl);
          const f32x4 a = *(const f32x4*)(p.mu_prev + cl), b = *(const f32x4*)(p.mu_next + cl);
          const float z4[4] = {bflo(zw.x), bfhi(zw.x), bflo(zw.y), bfhi(zw.y)}, p4[4] = {bflo(pw.x), bfhi(pw.x), bflo(pw.y), bfhi(pw.y)}, n4[4] = {bflo(nw.x), bfhi(nw.x), bflo(nw.y), bfhi(nw.y)};
          float o4[4];
#pragma unroll
          for (int j = 0; j < 4; ++j) { float s = z4[j] + a[j] * (p4[j] - z4[j]) + b[j] * (n4[j] - z4[j]); o4[j] = (lane < 32) ? tanhf(s) : s; }
          u32x2 w; w.x = cvt_pk_bf16(o4[0], o4[1]); w.y = cvt_pk_bf16(o4[2], o4[3]); *(u32x2*)(AL + (size_t)t * 256 + lane * 4) = w; }
    }
}

__device__ __forceinline__ void nat_phase(const Params& p) {
    const int lane = threadIdx.x & 63, wid = __builtin_amdgcn_readfirstlane(threadIdx.x >> 6), l15 = lane & 15, lq = lane >> 4;
    const u16* Qn = (const u16*)p.out; const u16* Kn = Qn + (size_t)NTOK * RW; const u16* VT = Kn + (size_t)NTOK * RW; const u16* Gn = VT + (size_t)NTOK * RW;
    u16* MIX = (u16*)(p.ws + O_HN);
    for (int item = blockIdx.x * 8 + wid; item < 8192; item += gridDim.x * 8) {
        const int r = item & 255, h = (item >> 8) & 15, b = item >> 12;
        const int rs = min(max(r - 4, 0), 248);
        const u16* Qb = Qn + (size_t)(b * SEQ + r * 64) * RW + h * 64;
        const u16* Kb = Kn + (size_t)(b * SEQ + rs * 64) * RW + h * 64;
        const u16* Vb = VT + (size_t)((b * 16 + h) * 64) * SEQ + rs * 64;
        const float* rpb = p.rpb + h * 465 + (rs - r + 7) * 31;
#pragma unroll 1
        for (int qt = 0; qt < 4; ++qt) {
            const int c0 = qt * 16, cs0 = (qt == 0) ? 0 : (qt == 1 ? 8 : (qt == 2 ? 24 : 32));
            const int c = c0 + l15, csq = min(max(c - 8, 0), 48);
            const bf16x8 bq0 = *(const bf16x8*)(Qb + (size_t)c * RW + lq * 8), bq1 = *(const bf16x8*)(Qb + (size_t)c * RW + 32 + lq * 8);
            f32x4 sc[8][2];
#pragma unroll
            for (int i = 0; i < 8; ++i)
#pragma unroll
                for (int hf = 0; hf < 2; ++hf) { const u16* kp = Kb + (size_t)(i * 64 + cs0 + hf * 16 + l15) * RW + lq * 8;
                    const bf16x8 a0 = *(const bf16x8*)kp, a1 = *(const bf16x8*)(kp + 32); f32x4 z = {0.f, 0.f, 0.f, 0.f};
                    z = __builtin_amdgcn_mfma_f32_16x16x32_bf16(a0, bq0, z, 0, 0, 0); z = __builtin_amdgcn_mfma_f32_16x16x32_bf16(a1, bq1, z, 0, 0, 0); sc[i][hf] = z; }
            float mx = -1e30f;
#pragma unroll
            for (int i = 0; i < 8; ++i)
#pragma unroll
                for (int hf = 0; hf < 2; ++hf)
#pragma unroll
                    for (int j = 0; j < 4; ++j) { const int kc = cs0 + hf * 16 + lq * 4 + j; const bool valid = (kc >= csq) && (kc < csq + 16); const int bc = valid ? (kc - c + 15) : 0;
                        const float s = valid ? sc[i][hf][j] * 0.125f + rpb[i * 31 + bc] : -1e30f; sc[i][hf][j] = s; mx = fmaxf(mx, s); }
            mx = fmaxf(mx, __shfl_xor(mx, 16)); mx = fmaxf(mx, __shfl_xor(mx, 32));
            float sum = 0.f;
#pragma unroll
            for (int i = 0; i < 8; ++i)
#pragma unroll
                for (int hf = 0; hf < 2; ++hf)
#pragma unroll
                    for (int j = 0; j < 4; ++j) { const float e = __expf(sc[i][hf][j] - mx); sc[i][hf][j] = e; sum += e; }
            sum += __shfl_xor(sum, 16); sum += __shfl_xor(sum, 32);
            const float inv = 1.0f / sum;
            f32x4 o[4];
#pragma unroll
            for (int mt = 0; mt < 4; ++mt) o[mt] = (f32x4){0.f, 0.f, 0.f, 0.f};
#pragma unroll
            for (int i = 0; i < 8; ++i) {
                u32x4 pw; pw.x = cvt_pk_bf16(sc[i][0][0] * inv, sc[i][0][1] * inv); pw.y = cvt_pk_bf16(sc[i][0][2] * inv, sc[i][0][3] * inv);
                pw.z = cvt_pk_bf16(sc[i][1][0] * inv, sc[i][1][1] * inv); pw.w = cvt_pk_bf16(sc[i][1][2] * inv, sc[i][1][3] * inv);
                const bf16x8 bp = __builtin_bit_cast(bf16x8, pw);
#pragma unroll
                for (int mt = 0; mt < 4; ++mt) { const u16* vp = Vb + (size_t)(mt * 16 + l15) * SEQ + i * 64 + cs0 + lq * 4;
                    const u32x2 v0 = *(const u32x2*)vp, v1 = *(const u32x2*)(vp + 16); u32x4 vw; vw.x = v0.x; vw.y = v0.y; vw.z = v1.x; vw.w = v1.y;
                    o[mt] = __builtin_amdgcn_mfma_f32_16x16x32_bf16(__builtin_bit_cast(bf16x8, vw), bp, o[mt], 0, 0, 0); }
            }
            const size_t tok = (size_t)(b * SEQ + r * 64 + c);
#pragma unroll
            for (int mt = 0; mt < 4; ++mt) { const int ch = h * 64 + mt * 16 + lq * 4; const u32x2 gw = *(const u32x2*)(Gn + tok * RW + ch);
                const float g0 = bflo(gw.x), g1 = bfhi(gw.x), g2 = bflo(gw.y), g3 = bfhi(gw.y);
                u32x2 w; w.x = cvt_pk_bf16(o[mt][0] * g0 * sigmoidf_(g0), o[mt][1] * g1 * sigmoidf_(g1)); w.y = cvt_pk_bf16(o[mt][2] * g2 * sigmoidf_(g2), o[mt][3] * g3 * sigmoidf_(g3));
                *(u32x2*)(MIX + tok * DM + 1024 + ch) = w; }
        }
    }
}

__device__ __forceinline__ void scan_pass1(const Params& p, int d) {
    const int lane = threadIdx.x & 63, wid = __builtin_amdgcn_readfirstlane(threadIdx.x >> 6);
    const float* Wd = p.out; const float* Bd = p.out + (size_t)NTOK * RW; const float* KD = (const float*)(p.ws + O_KD); const float* A = (const float*)(p.ws + O_A);
    const u16* V = (const u16*)(p.ws + O_V); float* PT = (float*)(p.ws + O_PT); float* SLT = (float*)(p.ws + O_SLT);
    for (int item = blockIdx.x * 8 + wid; item < 32 * (NC - 1); item += gridDim.x * 8) {
        const int bh = item / (NC - 1), c = item - bh * (NC - 1), b = bh >> 4, h = bh & 15;
        const int t0 = d ? (SEQ - 1 - c * LC) : c * LC;
        const size_t off0 = ((size_t)(b * SEQ + t0)) * RW + h * 64; const long stp = d ? -(long)(RW / 2) : (long)(RW / 2);
        cf2p wp = (cf2p)(Wd + off0), ap = (cf2p)(A + off0), bp = (cf2p)(Bd + off0), kp = (cf2p)(KD + off0);
        const u16* vp = V + off0 + lane; const long vstp = d ? -(long)RW : (long)RW;
        f32x2 S[32], P[32];
#pragma unroll
        for (int i = 0; i < 32; ++i) { S[i] = (f32x2){0.f, 0.f}; P[i] = (f32x2){lane == 2 * i ? 1.f : 0.f, lane == 2 * i + 1 ? 1.f : 0.f}; }
        float vv = bf2f(*vp);
#pragma unroll 1
        for (int s = 0; s < LC; ++s) {
            vp += vstp; const float vnext = (s + 1 < LC) ? bf2f(*vp) : 0.f;
            f32x2 s0 = {0.f, 0.f}, s1 = {0.f, 0.f}, q0 = {0.f, 0.f}, q1 = {0.f, 0.f};
#pragma unroll
            for (int i = 0; i < 32; i += 2) { const f32x2 a0 = ap[i], a1 = ap[i + 1]; s0 = fma2(S[i], a0, s0); s1 = fma2(S[i + 1], a1, s1); q0 = fma2(P[i], a0, q0); q1 = fma2(P[i + 1], a1, q1); }
            const float saS = (s0.x + s0.y) + (s1.x + s1.y), saP = (q0.x + q0.y) + (q1.x + q1.y);
            const f32x2 sS = {saS, saS}, sP = {saP, saP}, v2 = {vv, vv};
#pragma unroll
            for (int i = 0; i < 32; ++i) { const f32x2 w = wp[i], bb = bp[i]; f32x2 tmp = v2 * kp[i]; tmp = fma2(S[i], w, tmp); S[i] = fma2(sS, bb, tmp); P[i] = fma2(sP, bb, P[i] * w); }
            wp += stp; ap += stp; bp += stp; kp += stp; vv = vnext;
        }
        float* po = PT + ((size_t)(bh * NC + c)) * 4096 + lane; float* so = SLT + ((size_t)(bh * NC + c)) * 4096 + lane;
#pragma unroll
        for (int i = 0; i < 32; ++i) { po[(2 * i) * 64] = P[i].x; po[(2 * i + 1) * 64] = P[i].y; so[(2 * i) * 64] = S[i].x; so[(2 * i + 1) * 64] = S[i].y; }
    }
}
__device__ __forceinline__ void scan_combine(const Params& p, float* sl) {
    const int tid = threadIdx.x, vl = tid & 7, k = tid >> 3;
    const float* PT = (const float*)(p.ws + O_PT); const float* SLT = (const float*)(p.ws + O_SLT); float* SIT = (float*)(p.ws + O_SIT);
    for (int item = blockIdx.x; item < 256; item += gridDim.x) {
        const int bh = item >> 3, g = item & 7;
        const float* pt = PT + (size_t)bh * NC * 4096 + k * 64; const float* st = SLT + (size_t)bh * NC * 4096 + k * 64 + g * 8 + vl; float* si = SIT + (size_t)bh * NC * 4096 + k * 64 + g * 8 + vl;
        __syncthreads();
        sl[tid] = 0.f;
        f32x4 Pr[16], Pn[16];
#pragma unroll
        for (int i = 0; i < 16; ++i) Pr[i] = *(const f32x4*)(pt + i * 4);
        __syncthreads();
#pragma unroll 1
        for (int c = 0; c < NC - 1; ++c) {
            if (c + 1 < NC - 1) {
#pragma unroll
                for (int i = 0; i < 16; ++i) Pn[i] = *(const f32x4*)(pt + (size_t)(c + 1) * 4096 + i * 4); }
            float acc = st[(size_t)c * 4096];
#pragma unroll
            for (int i = 0; i < 16; ++i) { const f32x4 sv = *(const f32x4*)(sl + vl * 64 + i * 4); acc += sv[0] * Pr[i][0] + sv[1] * Pr[i][1] + sv[2] * Pr[i][2] + sv[3] * Pr[i][3]; }
            __syncthreads();
            sl[vl * 64 + k] = acc; si[(size_t)(c + 1) * 4096] = acc;
            __syncthreads();
#pragma unroll
            for (int i = 0; i < 16; ++i) Pr[i] = Pn[i];
        }
    }
}
__device__ __forceinline__ void scan_pass2(const Params& p, int d) {
    const int lane = threadIdx.x & 63, wid = __builtin_amdgcn_readfirstlane(threadIdx.x >> 6);
    const float* Wd = p.out; const float* Bd = p.out + (size_t)NTOK * RW; const float* KD = (const float*)(p.ws + O_KD); const float* A = (const float*)(p.ws + O_A); const float* R = (const float*)(p.ws + O_R);
    const u16* V = (const u16*)(p.ws + O_V); const float* SIT = (const float*)(p.ws + O_SIT); float* Y = (float*)(p.ws + O_Y);
    for (int item = blockIdx.x * 8 + wid; item < 32 * NC; item += gridDim.x * 8) {
        const int bh = item / NC, c = item - bh * NC, b = bh >> 4, h = bh & 15;
        const int t0 = d ? (SEQ - 1 - c * LC) : c * LC;
        const size_t off0 = ((size_t)(b * SEQ + t0)) * RW + h * 64; const long stp = d ? -(long)(RW / 2) : (long)(RW / 2);
        cf2p wp = (cf2p)(Wd + off0), ap = (cf2p)(A + off0), bp = (cf2p)(Bd + off0), kp = (cf2p)(KD + off0), rp = (cf2p)(R + off0);
        const u16* vp = V + off0 + lane; float* yp = Y + off0 + lane; const long vstp = d ? -(long)RW : (long)RW;
        f32x2 S[32];
        if (c == 0) {
#pragma unroll
            for (int i = 0; i < 32; ++i) S[i] = (f32x2){0.f, 0.f};
        } else { const float* si = SIT + ((size_t)(bh * NC + c)) * 4096 + lane;
#pragma unroll
            for (int i = 0; i < 32; ++i) S[i] = (f32x2){si[(2 * i) * 64], si[(2 * i + 1) * 64]}; }
        float vv = bf2f(*vp); float yold = d ? *yp : 0.f;
#pragma unroll 1
        for (int s = 0; s < LC; ++s) {
            vp += vstp; const bool more = (s + 1 < LC); const float vnext = more ? bf2f(*vp) : 0.f; const float ynext = (d && more) ? yp[vstp] : 0.f;
            f32x2 s0 = {0.f, 0.f}, s1 = {0.f, 0.f}, s2 = {0.f, 0.f}, s3 = {0.f, 0.f};
#pragma unroll
            for (int i = 0; i < 32; i += 4) { s0 = fma2(S[i], ap[i], s0); s1 = fma2(S[i + 1], ap[i + 1], s1); s2 = fma2(S[i + 2], ap[i + 2], s2); s3 = fma2(S[i + 3], ap[i + 3], s3); }
            const f32x2 st = (s0 + s1) + (s2 + s3); const float sa = st.x + st.y;
            const f32x2 sS = {sa, sa}, v2 = {vv, vv};
            f32x2 y0 = {0.f, 0.f}, y1 = {0.f, 0.f};
#pragma unroll
            for (int i = 0; i < 32; i += 2) {
                f32x2 t0v = v2 * kp[i]; t0v = fma2(S[i], wp[i], t0v); S[i] = fma2(sS, bp[i], t0v); y0 = fma2(S[i], rp[i], y0);
                f32x2 t1v = v2 * kp[i + 1]; t1v = fma2(S[i + 1], wp[i + 1], t1v); S[i + 1] = fma2(sS, bp[i + 1], t1v); y1 = fma2(S[i + 1], rp[i + 1], y1); }
            const f32x2 yt = y0 + y1;
            *yp = yt.x + yt.y + yold;
            wp += stp; ap += stp; bp += stp; kp += stp; rp += stp; yp += vstp; vv = vnext; yold = ynext;
        }
    }
}

__device__ __forceinline__ void post_phase(const Params& p) {
    const int lane = threadIdx.x & 63, wid = threadIdx.x >> 6;
    const float* Y = (const float*)(p.ws + O_Y); const u16* V = (const u16*)(p.ws + O_V); const u16* ZG = (const u16*)(p.ws + O_ZG); const float* BON = (const float*)(p.ws + O_BON);
    u16* MIX = (u16*)(p.ws + O_HN); u16* PB = (u16*)(p.ws + O_AL);
    for (int t = blockIdx.x * 8 + wid; t < NTOK; t += gridDim.x * 8) {
        const int c = lane * 16; const size_t o = (size_t)t * RW + c;
        float y[16], v[16], g[16]; float s = 0.f;
#pragma unroll
        for (int j4 = 0; j4 < 4; ++j4) { const f32x4 a = *(const f32x4*)(Y + o + j4 * 4); y[j4 * 4] = a[0]; y[j4 * 4 + 1] = a[1]; y[j4 * 4 + 2] = a[2]; y[j4 * 4 + 3] = a[3]; s += a[0] + a[1] + a[2] + a[3]; }
        ld16bf(V + o, v); ld16bf(ZG + o, g);
        s += __shfl_xor(s, 1); s += __shfl_xor(s, 2); const float mu = s * (1.0f / 64.0f);
        float q = 0.f;
#pragma unroll
        for (int j = 0; j < 16; ++j) { y[j] -= mu; q += y[j] * y[j]; }
        q += __shfl_xor(q, 1); q += __shfl_xor(q, 2); const float rs = rsqrtf(q * (1.0f / 64.0f) + 64e-5f);
        const float bon = BON[(size_t)t * 16 + (lane >> 2)];
        float outv[16];
#pragma unroll
        for (int j4 = 0; j4 < 4; ++j4) { const f32x4 lw = *(const f32x4*)(p.lnx_w + c + j4 * 4), lb = *(const f32x4*)(p.lnx_b + c + j4 * 4);
#pragma unroll
            for (int j = 0; j < 4; ++j) { const int i = j4 * 4 + j; const float yn = y[i] * rs * lw[j] + lb[j]; outv[i] = (yn + bon * v[i]) * g[i] * sigmoidf_(g[i]); } }
        st16bf(MIX + (size_t)t * DM + c, outv);
        { const f32x4 pv = *(const f32x4*)(p.p + (size_t)t * 256 + lane * 4); u32x2 w; w.x = cvt_pk_bf16(pv[0], pv[1]); w.y = cvt_pk_bf16(pv[2], pv[3]); *(u32x2*)(PB + (size_t)t * 256 + lane * 4) = w; }
    }
}

__global__ void __launch_bounds__(NTHREADS, 2) mega(Params p) {
    extern __shared__ __attribute__((aligned(16))) unsigned char lds[];
    cg::grid_group grid = cg::this_grid();
    unsigned char* ws = p.ws;
#define PH_ON(n) (p.ph_lo <= (n) && (n) < p.ph_hi)
#define PH_END(n) do { if ((n) + 1 < p.ph_hi) grid.sync(); } while (0)
    if (PH_ON(0)) {
        transpose_cvt(p.w_in, 2048, 8448, (u16*)(ws + O_W1T), 2048, (float*)lds);
        transpose_cvt(p.w_out, 2048, 2048, (u16*)(ws + O_W2T), 2048, (float*)lds);
        transpose_cvt(p.w_ple_gate, 2048, 2048, (u16*)(ws + O_W3T), 2048, (float*)lds);
        transpose_cvt(p.w_ple_proj, 256, 2048, (u16*)(ws + O_WPT), 256, (float*)lds);
        build_wlt(p);
        rownorm<true>(p.x, p.norm_mix_g, ws + O_HN);
        PH_END(0);
    }
    if (PH_ON(1)) {
        EpiZ e; e.zs = (u16*)(ws + O_ZS); e.zg = (u16*)(ws + O_ZG); e.qn = (u16*)p.out; e.kn = e.qn + (size_t)NTOK * RW; e.vt = e.kn + (size_t)NTOK * RW; e.gn = e.vt + (size_t)NTOK * RW;
        run_gemm(lds, (const u16*)(ws + O_HN), (const u16*)(ws + O_W1T), NTOK, 8448, 2048, e);
        PH_END(1);
    }
    if (PH_ON(2)) { nat_phase(p); prep_phase(p); PH_END(2); }
#define SCAN_DIR(d, pb) \
    if (PH_ON(pb)) { \
        EpiLora e; e.w0 = p.decay_w0 + (d) * RW; e.a0 = p.iclr_a0 + (d) * RW; e.ka = p.k_a; e.A = (const float*)(ws + O_A); e.Kb = (const u16*)(ws + O_K); \
        e.Wd = p.out; e.Bd = p.out + (size_t)NTOK * RW; e.KD = (float*)(ws + O_KD); \
        run_gemm(lds, (const u16*)(ws + O_AL), (const u16*)(ws + O_WLT) + (size_t)(d) * 2048 * 256, NTOK, 2048, 256, e); \
        PH_END(pb); \
    } \
    if (PH_ON(pb + 1)) { scan_pass1(p, d); PH_END(pb + 1); } \
    if (PH_ON(pb + 2)) { scan_combine(p, (float*)lds); PH_END(pb + 2); } \
    if (PH_ON(pb + 3)) { scan_pass2(p, d); PH_END(pb + 3); }
    SCAN_DIR(0, 3)
    SCAN_DIR(1, 7)
    if (PH_ON(11)) { post_phase(p); PH_END(11); }
    if (PH_ON(12)) {
        EpiH e; e.X = p.x; e.H = p.out;
        run_gemm(lds, (const u16*)(ws + O_HN), (const u16*)(ws + O_W2T), NTOK, 2048, 2048, e);
        EpiBf e2; e2.O = (u16*)(ws + O_R); e2.ld = DM;
        run_gemm(lds, (const u16*)(ws + O_AL), (const u16*)(ws + O_WPT), NTOK, 2048, 256, e2);
        PH_END(12);
    }
    if (PH_ON(13)) { rownorm<true>(p.out, p.ple_norm_g, ws + O_HN); PH_END(13); }
    if (PH_ON(14)) {
        EpiGate e; e.H = p.out; e.PP = (const u16*)(ws + O_R);
        run_gemm(lds, (const u16*)(ws + O_HN), (const u16*)(ws + O_W3T), NTOK, 2048, 2048, e);
        PH_END(14);
    }
    if (PH_ON(15)) { rownorm<false>(p.out, p.final_g, p.out); }
}

extern "C" void kernel_launch(void* const* d_in, const int* in_sizes, int n_in, void* d_out, int out_size, void* d_ws, size_t ws_size, hipStream_t stream) {
    static int grid = 0;
    if (grid == 0) {
        if (n_in != 21 || out_size != NTOK * DM || ws_size < WS_END) { fprintf(stderr, "kernel_launch: unexpected shapes (n_in %d out %d ws %zu need %zu)\n", n_in, out_size, ws_size, (size_t)WS_END); grid = -1; return; }
        int dev = 0, cus = 0, per_cu = 0;
        hipGetDevice(&dev); hipDeviceGetAttribute(&cus, hipDeviceAttributeMultiprocessorCount, dev);
        hipFuncSetAttribute((const void*)mega, hipFuncAttributeMaxDynamicSharedMemorySize, LDS_BYTES);
        hipOccupancyMaxActiveBlocksPerMultiprocessor(&per_cu, (const void*)mega, NTHREADS, LDS_BYTES);
        if (per_cu < 1) { fprintf(stderr, "kernel_launch: occupancy query says %d blocks/CU\n", per_cu); grid = -1; return; }
        grid = cus;
    }
    if (grid < 0) return;
    Params p{};
    const float** f = (const float**)&p;
    for (int i = 0; i < 21; ++i) f[i] = (const float*)d_in[i];
    p.out = (float*)d_out; p.ws = (unsigned char*)d_ws;
#if MULTI_LAUNCH
    for (int ph = 0; ph < 16; ++ph) { p.ph_lo = ph; p.ph_hi = ph + 1; hipLaunchKernelGGL(mega, dim3(grid), dim3(NTHREADS), LDS_BYTES, stream, p); }
#else
    p.ph_lo = 0; p.ph_hi = 16;
    void* args[] = {&p};
    hipError_t e = hipLaunchCooperativeKernel((const void*)mega, dim3(grid), dim3(NTHREADS), args, LDS_BYTES, stream);
    if (e != hipSuccess) fprintf(stderr, "cooperative launch failed: %s (grid %d)\n", hipGetErrorString(e), grid);
#endif
}
```

```cpp
#include <hip/hip_runtime.h>
#include <hip/hip_cooperative_groups.h>
#include <cstdio>
namespace cg = cooperative_groups;

#ifndef MULTI_LAUNCH
#define MULTI_LAUNCH 0
#endif

#define LAS __attribute__((address_space(3)))
typedef unsigned short u16;
typedef short bf16x8 __attribute__((ext_vector_type(8)));
typedef float f32x4 __attribute__((ext_vector_type(4)));
typedef float f32x2 __attribute__((ext_vector_type(2)));
typedef unsigned u32x4 __attribute__((ext_vector_type(4)));
typedef unsigned u32x2 __attribute__((ext_vector_type(2)));
typedef const __attribute__((address_space(4))) f32x2* cf2p;

constexpr int SEQ = 16384, NTOK = 32768, DM = 2048, RW = 1024;
constexpr int NC = 64, LC = SEQ / NC;
constexpr int NTHREADS = 512, LDS_BYTES = 131072;
constexpr float DECAY_SCALE = 0.6065306597126334f;

constexpr size_t MiB = 1ull << 20;
constexpr size_t O_W1T = 0, O_W2T = 33 * MiB, O_W3T = 41 * MiB, O_WPT = 49 * MiB, O_WLT = 50 * MiB;
constexpr size_t O_HN = 56 * MiB;
constexpr size_t O_ZS = 184 * MiB;
constexpr size_t O_KD = O_ZS, O_PT = O_ZS + 128 * MiB, O_SLT = O_ZS + 160 * MiB;
constexpr size_t O_ZG = 392 * MiB;
constexpr size_t O_R = 456 * MiB;
constexpr size_t O_A = 584 * MiB;
constexpr size_t O_V = 712 * MiB;
constexpr size_t O_K = 776 * MiB;
constexpr size_t O_AL = 840 * MiB;
constexpr size_t O_BON = 856 * MiB;
constexpr size_t O_Y = 858 * MiB;
constexpr size_t O_SIT = 986 * MiB;
constexpr size_t WS_END = 1018 * MiB;

struct Params {
    const float *x, *p, *norm_mix_g, *w_in, *mu_prev, *mu_next, *decay_w0, *decay_w2, *iclr_a0, *iclr_a2, *k_k, *k_a, *r_k, *lnx_w, *lnx_b, *rpb, *w_out,
        *ple_norm_g, *w_ple_gate, *w_ple_proj, *final_g;
    float* out; unsigned char* ws;
    int ph_lo, ph_hi;
};

__device__ __forceinline__ float bf2f(u16 b) { return __uint_as_float(((unsigned)b) << 16); }
__device__ __forceinline__ float bflo(unsigned w) { return __uint_as_float(w << 16); }
__device__ __forceinline__ float bfhi(unsigned w) { return __uint_as_float(w & 0xffff0000u); }
__device__ __forceinline__ unsigned cvt_pk_bf16(float lo, float hi) { unsigned r; asm volatile("v_cvt_pk_bf16_f32 %0, %1, %2" : "=v"(r) : "v"(lo), "v"(hi)); return r; }
__device__ __forceinline__ float sigmoidf_(float x) { return __builtin_amdgcn_rcpf(1.0f + __expf(-x)); }
__device__ __forceinline__ f32x2 fma2(f32x2 a, f32x2 b, f32x2 c) { return __builtin_elementwise_fma(a, b, c); }

namespace pg8 {
constexpr int BM = 256, BK = 64, HALF = 128, HTB = HALF * BK * 2, NXCD = 8, WGM = 8;
__device__ __forceinline__ int lds_byte(int r, int c) { const int st = (r >> 4) * 2 + (c >> 5), rr = r & 15, cc = c & 31, ob = rr * 64 + cc * 2; return st * 1024 + (ob ^ (((ob >> 9) & 1) << 5)); }
__device__ __forceinline__ void stage_rc(int b, int& R, int& C) { const int st = b / 1024, sb = b % 1024, swz = sb ^ (((sb >> 9) & 1) << 5); R = (st >> 1) * 16 + swz / 64; C = (st & 1) * 32 + (swz % 64) / 2; }
__device__ __forceinline__ int perm32(int rho) { const int n = rho >> 4, i = rho & 15; return 8 * (i >> 2) + 4 * n + (i & 3); }
struct Unit { int pm, pn; };
struct Gemm { const u16* A; const u16* Bt; int M, N, K; };
struct StaticOrder {
    int nM, nN, nwg, G, c;
    __device__ void init(int M, int N, int G_, int c_) { nM = M / BM; nN = N / BM; nwg = nM * nN; G = G_; c = c_; }
    __device__ bool next(int i, Unit& u) const {
        const long L = (long)i * G + c; if (L >= nwg) return false;
        int wgid = (int)L; { const int q = nwg / NXCD, r = nwg % NXCD, xcd = wgid % NXCD, off = wgid / NXCD; wgid = (xcd < r ? xcd * (q + 1) : r * (q + 1) + (xcd - r) * q) + off; }
        const int nig = WGM * nN, gid = wgid / nig, fm = gid * WGM, gsz = (nM - fm) < WGM ? (nM - fm) : WGM;
        u.pm = fm + ((wgid % nig) % gsz); u.pn = (wgid % nig) / gsz; return true;
    }
};
template <class Epi>
__device__ __forceinline__ void gemm_phase(LAS unsigned char* lds, const Gemm g, const StaticOrder& S, const Epi& E) {
    const int tid = threadIdx.x, wid = __builtin_amdgcn_readfirstlane(tid >> 6), lane = tid & 63, wr = wid >> 2, wc = wid & 3, fr = lane & 15, fq = lane >> 4;
    const int K = g.K, nt = K / BK;
    unsigned voffA[2], voffB[2];
#pragma unroll
    for (int i = 0; i < 2; ++i) { int R, C; stage_rc(tid * 16 + i * 8192, R, C); const int Rb = Epi::PERM ? ((R & ~31) + perm32(R & 31)) : R;
        voffA[i] = (unsigned)(R * K + C) * 2u; voffB[i] = (unsigned)(Rb * K + C) * 2u; }
    const size_t kstep = (size_t)(BK * 2);
    const size_t hstep = (size_t)HALF * K * 2;
    const size_t tstep = 2 * hstep;
    const unsigned ldsw = (unsigned)wid * 1024u;
    const int aoff = lds_byte(wr * 64 + fr, fq * 8), boff = lds_byte(wc * 32 + fr, fq * 8);
#define PG8_SA(b, h) (((b) * 2 + (h)) * HTB)
#define PG8_SB(b, h) ((4 + (b) * 2 + (h)) * HTB)
#define PG8_STAGE(bufoff, gbase, voff) do { _Pragma("unroll") for (int _i = 0; _i < 2; ++_i) \
        __builtin_amdgcn_global_load_lds((const unsigned*)((const char*)(gbase) + (voff)[_i]), (LAS unsigned*)(lds + (bufoff) + ldsw + _i * 8192), 16, 0, 0); } while (0)
#define PG8_LDA(dst, b, h) do { _Pragma("unroll") for (int m = 0; m < 4; ++m) _Pragma("unroll") for (int k = 0; k < 2; ++k) dst[m][k] = *(const LAS bf16x8*)(lds + PG8_SA(b, h) + aoff + m * 2048 + k * 1024); } while (0)
#define PG8_LDB(dst, b, h) do { _Pragma("unroll") for (int n = 0; n < 2; ++n) _Pragma("unroll") for (int k = 0; k < 2; ++k) dst[n][k] = *(const LAS bf16x8*)(lds + PG8_SB(b, h) + boff + n * 2048 + k * 1024); } while (0)
#define PG8_MMA(ai, bj, At, Bt) do { __builtin_amdgcn_s_setprio(1); _Pragma("unroll") for (int m = 0; m < 4; ++m) _Pragma("unroll") for (int n = 0; n < 2; ++n) _Pragma("unroll") for (int k = 0; k < 2; ++k) \
        acc[ai][bj][m][n] = __builtin_amdgcn_mfma_f32_16x16x32_bf16(Bt[n][k], At[m][k], acc[ai][bj][m][n], 0, 0, 0); __builtin_amdgcn_s_setprio(0); } while (0)
#define PG8_WAIT_V(n) asm volatile("s_waitcnt vmcnt(" #n ")" ::: "memory")
#define PG8_WAIT_L(n) asm volatile("s_waitcnt lgkmcnt(" #n ")" ::: "memory")
#define PG8_BAR __builtin_amdgcn_s_barrier()
#define PG8_SCHED __builtin_amdgcn_sched_barrier(0)
    Unit cur, nxt; int ui = 0;
    if (!S.next(0, cur)) return;
    f32x4 acc[2][2][4][2];
#pragma unroll
    for (int a = 0; a < 2; ++a)
#pragma unroll
        for (int b = 0; b < 2; ++b)
#pragma unroll
            for (int m = 0; m < 4; ++m)
#pragma unroll
                for (int n = 0; n < 2; ++n) acc[a][b][m][n] = (f32x4){0.f, 0.f, 0.f, 0.f};
    bf16x8 At[4][2], B0[2][2], B1[2][2];
    const char* cA = (const char*)g.A + (size_t)cur.pm * tstep; const char* cB = (const char*)g.Bt + (size_t)cur.pn * tstep;
    PG8_STAGE(PG8_SB(0, 0), cB, voffB); PG8_STAGE(PG8_SA(0, 0), cA, voffA); PG8_STAGE(PG8_SB(0, 1), cB + hstep, voffB); PG8_STAGE(PG8_SA(0, 1), cA + hstep, voffA);
    if (wr == 1) PG8_BAR;
    PG8_WAIT_V(4); PG8_BAR;
    PG8_STAGE(PG8_SB(1, 0), cB + kstep, voffB); PG8_STAGE(PG8_SA(1, 0), cA + kstep, voffA); PG8_STAGE(PG8_SB(1, 1), cB + hstep + kstep, voffB);
    PG8_WAIT_V(6); PG8_BAR;
    for (;;) {
        const bool has_next = S.next(ui + 1, nxt);
        const char* nA = has_next ? (const char*)g.A + (size_t)nxt.pm * tstep : cA; const char* nB = has_next ? (const char*)g.Bt + (size_t)nxt.pn * tstep : cB;
        for (int t = 0; t < nt; t += 2) {
            const bool last = (t == nt - 2);
            const char* a1 = cA + (size_t)(t + 1) * kstep;
            const char* a2 = last ? nA : cA + (size_t)(t + 2) * kstep; const char* b2 = last ? nB : cB + (size_t)(t + 2) * kstep;
            const char* a3 = a2 + kstep; const char* b3 = b2 + kstep;
            PG8_LDB(B0, 0, 0); PG8_SCHED; PG8_LDA(At, 0, 0); PG8_STAGE(PG8_SA(1, 1), a1 + hstep, voffA);
            PG8_WAIT_L(8); PG8_BAR; PG8_WAIT_L(0); PG8_MMA(0, 0, At, B0); PG8_BAR; PG8_SCHED;
            PG8_LDB(B1, 0, 1); PG8_STAGE(PG8_SB(0, 0), b2, voffB);
            PG8_BAR; PG8_WAIT_L(0); PG8_MMA(0, 1, At, B1); PG8_BAR;
            PG8_LDA(At, 0, 1); PG8_STAGE(PG8_SA(0, 0), a2, voffA);
            PG8_BAR; PG8_WAIT_L(0); PG8_MMA(1, 0, At, B0); PG8_BAR; PG8_SCHED;
            PG8_STAGE(PG8_SB(0, 1), b2 + hstep, voffB);
            PG8_WAIT_V(6); PG8_BAR; PG8_MMA(1, 1, At, B1); PG8_BAR;
            PG8_LDB(B0, 1, 0); PG8_SCHED; PG8_LDA(At, 1, 0); PG8_STAGE(PG8_SA(0, 1), a2 + hstep, voffA);
            PG8_WAIT_L(8); PG8_BAR; PG8_WAIT_L(0); PG8_MMA(0, 0, At, B0); PG8_BAR; PG8_SCHED;
            PG8_LDB(B1, 1, 1); PG8_STAGE(PG8_SB(1, 0), b3, voffB);
            PG8_BAR; PG8_WAIT_L(0); PG8_MMA(0, 1, At, B1); PG8_BAR;
            PG8_LDA(At, 1, 1); PG8_STAGE(PG8_SA(1, 0), a3, voffA);
            PG8_BAR; PG8_WAIT_L(0); PG8_MMA(1, 0, At, B0); PG8_BAR; PG8_SCHED;
            PG8_STAGE(PG8_SB(1, 1), b3 + hstep, voffB);
            PG8_WAIT_V(6); PG8_BAR; PG8_MMA(1, 1, At, B1); PG8_BAR;
        }
        E(acc, cur, wr, wc, fr, fq);
        if (!has_next) break;
#pragma unroll
        for (int a = 0; a < 2; ++a)
#pragma unroll
            for (int b = 0; b < 2; ++b)
#pragma unroll
                for (int m = 0; m < 4; ++m)
#pragma unroll
                    for (int n = 0; n < 2; ++n) acc[a][b][m][n] = (f32x4){0.f, 0.f, 0.f, 0.f};
        cur = nxt; cA = nA; cB = nB; ++ui;
    }
    PG8_WAIT_V(0);
    if (wr == 0) PG8_BAR;
    PG8_BAR;
#undef PG8_SA
#undef PG8_SB
#undef PG8_STAGE
#undef PG8_LDA
#undef PG8_LDB
#undef PG8_MMA
#undef PG8_WAIT_V
#undef PG8_WAIT_L
#undef PG8_BAR
#undef PG8_SCHED
}
}
using pg8::Unit;
typedef f32x4 AccT[2][2][4][2];

struct EpiZ {
    static constexpr bool PERM = true;
    u16 *zs, *zg, *qn, *kn, *vt, *gn;
    __device__ __forceinline__ void operator()(const AccT& acc, const Unit& u, int wr, int wc, int fr, int fq) const {
        const int row0 = u.pm * 256 + wr * 64 + fr; const int pn = u.pn;
        if (pn >= 25 && pn < 29) {
            const int cb = (pn - 25) * 256 + wc * 32 + 8 * fq;
#pragma unroll
            for (int ai = 0; ai < 2; ++ai)
#pragma unroll
                for (int m = 0; m < 4; ++m) { const int row = row0 + ai * 128 + m * 16; const int b = row >> 14, tt = row & (SEQ - 1);
#pragma unroll
                    for (int bj = 0; bj < 2; ++bj)
#pragma unroll
                        for (int n = 0; n < 2; ++n)
#pragma unroll
                            for (int j = 0; j < 4; ++j) { const int ch = cb + bj * 128 + 4 * n + j;
                                vt[((size_t)(b * 1024 + ch)) * SEQ + tt] = (u16)(cvt_pk_bf16(acc[ai][bj][m][n][j], 0.f) & 0xffffu); } }
            return;
        }
        u16* base; int ld, colt;
        if (pn < 13) { base = zs; ld = 3328; colt = pn * 256; }
        else if (pn < 17) { base = zg; ld = 1024; colt = (pn - 13) * 256; }
        else if (pn < 21) { base = qn; ld = 1024; colt = (pn - 17) * 256; }
        else if (pn < 25) { base = kn; ld = 1024; colt = (pn - 21) * 256; }
        else { base = gn; ld = 1024; colt = (pn - 29) * 256; }
        const int col0 = colt + wc * 32 + 8 * fq;
#pragma unroll
        for (int ai = 0; ai < 2; ++ai)
#pragma unroll
            for (int m = 0; m < 4; ++m) { u16* rowp = base + (size_t)(row0 + ai * 128 + m * 16) * ld + col0;
#pragma unroll
                for (int bj = 0; bj < 2; ++bj) { const f32x4 v0 = acc[ai][bj][m][0], v1 = acc[ai][bj][m][1];
                    u32x4 w; w.x = cvt_pk_bf16(v0[0], v0[1]); w.y = cvt_pk_bf16(v0[2], v0[3]); w.z = cvt_pk_bf16(v1[0], v1[1]); w.w = cvt_pk_bf16(v1[2], v1[3]);
                    *(u32x4*)(rowp + bj * 128) = w; } }
    }
};
struct EpiBf {
    static constexpr bool PERM = true;
    u16* O; int ld;
    __device__ __forceinline__ void operator()(const AccT& acc, const Unit& u, int wr, int wc, int fr, int fq) const {
        const int row0 = u.pm * 256 + wr * 64 + fr, col0 = u.pn * 256 + wc * 32 + 8 * fq;
#pragma unroll
        for (int ai = 0; ai < 2; ++ai)
#pragma unroll
            for (int m = 0; m < 4; ++m) { u16* rowp = O + (size_t)(row0 + ai * 128 + m * 16) * ld + col0;
#pragma unroll
                for (int bj = 0; bj < 2; ++bj) { const f32x4 v0 = acc[ai][bj][m][0], v1 = acc[ai][bj][m][1];
                    u32x4 w; w.x = cvt_pk_bf16(v0[0], v0[1]); w.y = cvt_pk_bf16(v0[2], v0[3]); w.z = cvt_pk_bf16(v1[0], v1[1]); w.w = cvt_pk_bf16(v1[2], v1[3]);
                    *(u32x4*)(rowp + bj * 128) = w; } }
    }
};
struct EpiLora {
    static constexpr bool PERM = false;
    const float *w0, *a0, *ka; const float* A; const u16* Kb; float *Wd, *Bd, *KD;
    __device__ __forceinline__ void operator()(const AccT& acc, const Unit& u, int wr, int wc, int fr, int fq) const {
        const int row0 = u.pm * 256 + wr * 64 + fr, col0 = u.pn * 256 + wc * 32 + 4 * fq;
        if (u.pn < 4) {
#pragma unroll
            for (int bj = 0; bj < 2; ++bj)
#pragma unroll
                for (int n = 0; n < 2; ++n) { const int col = col0 + bj * 128 + n * 16; const f32x4 wv = *(const f32x4*)(w0 + col);
#pragma unroll
                    for (int ai = 0; ai < 2; ++ai)
#pragma unroll
                        for (int m = 0; m < 4; ++m) { const int row = row0 + ai * 128 + m * 16; f32x4 o;
#pragma unroll
                            for (int j = 0; j < 4; ++j) o[j] = __expf(-DECAY_SCALE * sigmoidf_(wv[j] + acc[ai][bj][m][n][j]));
                            *(f32x4*)(Wd + (size_t)row * RW + col) = o; asm volatile("" ::: "memory"); } }
        } else {
#pragma unroll
            for (int bj = 0; bj < 2; ++bj)
#pragma unroll
                for (int n = 0; n < 2; ++n) { const int col = col0 - 1024 + bj * 128 + n * 16; const f32x4 av0 = *(const f32x4*)(a0 + col), kav = *(const f32x4*)(ka + col);
#pragma unroll
                    for (int ai = 0; ai < 2; ++ai)
#pragma unroll
                        for (int m = 0; m < 4; ++m) { const int row = row0 + ai * 128 + m * 16; const size_t off = (size_t)row * RW + col;
                            const f32x4 aa = *(const f32x4*)(A + off); const u32x2 kw = *(const u32x2*)(Kb + off);
                            const float kf[4] = {bflo(kw.x), bfhi(kw.x), bflo(kw.y), bfhi(kw.y)}; f32x4 ob, ok;
#pragma unroll
                            for (int j = 0; j < 4; ++j) { const float ic = sigmoidf_(av0[j] + acc[ai][bj][m][n][j]); ob[j] = -aa[j] * ic; ok[j] = kf[j] * (1.0f + (ic - 1.0f) * kav[j]); }
                            *(f32x4*)(Bd + off) = ob; *(f32x4*)(KD + off) = ok; asm volatile("" ::: "memory"); } }
        }
    }
};
struct EpiH {
    static constexpr bool PERM = false;
    const float* X; float* H;
    __device__ __forceinline__ void operator()(const AccT& acc, const Unit& u, int wr, int wc, int fr, int fq) const {
        const int row0 = u.pm * 256 + wr * 64 + fr, col0 = u.pn * 256 + wc * 32 + 4 * fq;
#pragma unroll
        for (int ai = 0; ai < 2; ++ai)
#pragma unroll
            for (int m = 0; m < 4; ++m) { const size_t ro = (size_t)(row0 + ai * 128 + m * 16) * DM + col0;
#pragma unroll
                for (int bj = 0; bj < 2; ++bj)
#pragma unroll
                    for (int n = 0; n < 2; ++n) { const size_t o = ro + bj * 128 + n * 16; *(f32x4*)(H + o) = acc[ai][bj][m][n] + *(const f32x4*)(X + o); } asm volatile("" ::: "memory"); }
    }
};
struct EpiGate {
    static constexpr bool PERM = false;
    float* H; const u16* PP;
    __device__ __forceinline__ void operator()(const AccT& acc, const Unit& u, int wr, int wc, int fr, int fq) const {
        const int row0 = u.pm * 256 + wr * 64 + fr, col0 = u.pn * 256 + wc * 32 + 4 * fq;
#pragma unroll
        for (int ai = 0; ai < 2; ++ai)
#pragma unroll
            for (int m = 0; m < 4; ++m) { const size_t ro = (size_t)(row0 + ai * 128 + m * 16) * DM + col0;
#pragma unroll
                for (int bj = 0; bj < 2; ++bj)
#pragma unroll
                    for (int n = 0; n < 2; ++n) { const size_t o = ro + bj * 128 + n * 16; const f32x4 h = *(const f32x4*)(H + o); const u32x2 pw = *(const u32x2*)(PP + o);
                        const f32x4 a = acc[ai][bj][m][n]; f32x4 r;
                        r[0] = h[0] + bflo(pw.x) * sigmoidf_(a[0]); r[1] = h[1] + bfhi(pw.x) * sigmoidf_(a[1]); r[2] = h[2] + bflo(pw.y) * sigmoidf_(a[2]); r[3] = h[3] + bfhi(pw.y) * sigmoidf_(a[3]);
                        *(f32x4*)(H + o) = r; asm volatile("" ::: "memory"); } }
    }
};

template <class Epi> __device__ __forceinline__ void run_gemm(unsigned char* lds, const u16* A, const u16* Bt, int M, int N, int K, const Epi& E) {
    pg8::Gemm g; g.A = A; g.Bt = Bt; g.M = M; g.N = N; g.K = K;
    pg8::StaticOrder S; S.init(M, N, gridDim.x, blockIdx.x);
    pg8::gemm_phase<Epi>((LAS unsigned char*)lds, g, S, E);
    __syncthreads();
}

__device__ __forceinline__ void transpose_cvt(const float* __restrict__ src, int K, int N, u16* __restrict__ dst, int ldd, float* tile) {
    const int tid = threadIdx.x, tn = N / 64, ntile = (K / 64) * tn;
    for (int t = blockIdx.x; t < ntile; t += gridDim.x) {
        const int k0 = (t / tn) * 64, n0 = (t % tn) * 64;
#pragma unroll
        for (int ps = 0; ps < 2; ++ps) { const int r = (tid >> 4) + ps * 32, c4 = (tid & 15) * 4; const f32x4 v = *(const f32x4*)(src + (size_t)(k0 + r) * N + n0 + c4);
            tile[r * 65 + c4] = v[0]; tile[r * 65 + c4 + 1] = v[1]; tile[r * 65 + c4 + 2] = v[2]; tile[r * 65 + c4 + 3] = v[3]; }
        __syncthreads();
        { const int n = tid >> 3, ks = (tid & 7) * 8; u32x4 w;
          w.x = cvt_pk_bf16(tile[(ks + 0) * 65 + n], tile[(ks + 1) * 65 + n]); w.y = cvt_pk_bf16(tile[(ks + 2) * 65 + n], tile[(ks + 3) * 65 + n]);
          w.z = cvt_pk_bf16(tile[(ks + 4) * 65 + n], tile[(ks + 5) * 65 + n]); w.w = cvt_pk_bf16(tile[(ks + 6) * 65 + n], tile[(ks + 7) * 65 + n]);
          *(u32x4*)(dst + (size_t)(n0 + n) * ldd + k0 + ks) = w; }
        __syncthreads();
    }
}
__device__ __forceinline__ void build_wlt(const Params& p) {
    u16* W = (u16*)(p.ws + O_WLT);
    for (int i = blockIdx.x * NTHREADS + threadIdx.x; i < 2 * 2048 * 256; i += gridDim.x * NTHREADS) {
        const int k = i & 255, n = (i >> 8) & 2047, d = i >> 19; float v = 0.f;
        if (n < 1024) { if ((k >> 6) == d) v = p.decay_w2[((size_t)d * 64 + (k & 63)) * RW + n]; }
        else { if ((k >> 6) == 2 + d) v = p.iclr_a2[((size_t)d * 64 + (k & 63)) * RW + (n - 1024)]; }
        W[i] = (u16)(cvt_pk_bf16(v, 0.f) & 0xffffu);
    }
}
template <bool BF> __device__ __forceinline__ void rownorm(const float* src, const float* __restrict__ g, void* dst) {
    const int lane = threadIdx.x & 63, wid = threadIdx.x >> 6;
    for (int row = blockIdx.x * 8 + wid; row < NTOK; row += gridDim.x * 8) {
        const float* s = src + (size_t)row * DM + lane * 4; f32x4 v[8]; float ss = 0.f;
#pragma unroll
        for (int i = 0; i < 8; ++i) { v[i] = *(const f32x4*)(s + i * 256); ss += v[i][0] * v[i][0] + v[i][1] * v[i][1] + v[i][2] * v[i][2] + v[i][3] * v[i][3]; }
#pragma unroll
        for (int o = 32; o >= 1; o >>= 1) ss += __shfl_xor(ss, o);
        const float sc = rsqrtf(ss * (1.0f / DM) + 1e-6f);
#pragma unroll
        for (int i = 0; i < 8; ++i) { const f32x4 gv = *(const f32x4*)(g + lane * 4 + i * 256); const f32x4 o = v[i] * sc * gv;
            if (BF) { u32x2 w; w.x = cvt_pk_bf16(o[0], o[1]); w.y = cvt_pk_bf16(o[2], o[3]); *(u32x2*)((u16*)dst + (size_t)row * DM + lane * 4 + i * 256) = w; }
            else *(f32x4*)((float*)dst + (size_t)row * DM + lane * 4 + i * 256) = o; }
    }
}

__device__ __forceinline__ void ld16bf(const u16* p, float* o) {
    const u32x4 a = *(const u32x4*)p, b = *(const u32x4*)(p + 8);
    o[0] = bflo(a.x); o[1] = bfhi(a.x); o[2] = bflo(a.y); o[3] = bfhi(a.y); o[4] = bflo(a.z); o[5] = bfhi(a.z); o[6] = bflo(a.w); o[7] = bfhi(a.w);
    o[8] = bflo(b.x); o[9] = bfhi(b.x); o[10] = bflo(b.y); o[11] = bfhi(b.y); o[12] = bflo(b.z); o[13] = bfhi(b.z); o[14] = bflo(b.w); o[15] = bfhi(b.w);
}
__device__ __forceinline__ void st16bf(u16* p, const float* v) {
    u32x4 a, b; a.x = cvt_pk_bf16(v[0], v[1]); a.y = cvt_pk_bf16(v[2], v[3]); a.z = cvt_pk_bf16(v[4], v[5]); a.w = cvt_pk_bf16(v[6], v[7]);
    b.x = cvt_pk_bf16(v[8], v[9]); b.y = cvt_pk_bf16(v[10], v[11]); b.z = cvt_pk_bf16(v[12], v[13]); b.w = cvt_pk_bf16(v[14], v[15]);
    *(u32x4*)p = a; *(u32x4*)(p + 8) = b;
}
__device__ __forceinline__ void shift16(const u16* zc, bool hp, bool hn, const float* __restrict__ mp, const float* __restrict__ mn, int c, float* o) {
    float z[16], zp[16], zn[16]; ld16bf(zc + c, z);
    if (hp) ld16bf(zc - 3328 + c, zp); else {
#pragma unroll
        for (int j = 0; j < 16; ++j) zp[j] = 0.f; }
    if (hn) ld16bf(zc + 3328 + c, zn); else {
#pragma unroll
        for (int j = 0; j < 16; ++j) zn[j] = 0.f; }
#pragma unroll
    for (int j4 = 0; j4 < 4; ++j4) { const f32x4 a = *(const f32x4*)(mp + c + j4 * 4), b = *(const f32x4*)(mn + c + j4 * 4);
#pragma unroll
        for (int j = 0; j < 4; ++j) { const int q = j4 * 4 + j; o[q] = z[q] + a[j] * (zp[q] - z[q]) + b[j] * (zn[q] - z[q]); } }
}
__device__ __forceinline__ void prep_phase(const Params& p) {
    const int lane = threadIdx.x & 63, wid = threadIdx.x >> 6;
    const u16* ZS = (const u16*)(p.ws + O_ZS);
    float* R = (float*)(p.ws + O_R); float* A = (float*)(p.ws + O_A); u16* V = (u16*)(p.ws + O_V); u16* Kb = (u16*)(p.ws + O_K); u16* AL = (u16*)(p.ws + O_AL); float* BON = (float*)(p.ws + O_BON);
    for (int t = blockIdx.x * 8 + wid; t < NTOK; t += gridDim.x * 8) {
        const int tt = t & (SEQ - 1); const bool hp = tt > 0, hn = tt < SEQ - 1;
        const u16* zc = ZS + (size_t)t * 3328; const int c = lane * 16;
        float r[16], k[16], v[16];
        shift16(zc, hp, hn, p.mu_prev, p.mu_next, c, r);
        shift16(zc, hp, hn, p.mu_prev, p.mu_next, 1024 + c, k);
        shift16(zc, hp, hn, p.mu_prev, p.mu_next, 2048 + c, v);
        float kk[16], s2 = 0.f, bs = 0.f;
#pragma unroll
        for (int j4 = 0; j4 < 4; ++j4) { const f32x4 kkv = *(const f32x4*)(p.k_k + c + j4 * 4), rkv = *(const f32x4*)(p.r_k + c + j4 * 4);
#pragma unroll
            for (int j = 0; j < 4; ++j) { const int q = j4 * 4 + j; kk[q] = k[q] * kkv[j]; s2 += kk[q] * kk[q]; bs += r[q] * k[q] * rkv[j]; } }
        s2 += __shfl_xor(s2, 1); s2 += __shfl_xor(s2, 2); bs += __shfl_xor(bs, 1); bs += __shfl_xor(bs, 2);
        const float inv = -1.0f / fmaxf(sqrtf(s2), 1e-12f);
        const size_t o = (size_t)t * RW + c;
#pragma unroll
        for (int j4 = 0; j4 < 4; ++j4) { *(f32x4*)(R + o + j4 * 4) = (f32x4){r[j4 * 4], r[j4 * 4 + 1], r[j4 * 4 + 2], r[j4 * 4 + 3]};
            *(f32x4*)(A + o + j4 * 4) = (f32x4){kk[j4 * 4] * inv, kk[j4 * 4 + 1] * inv, kk[j4 * 4 + 2] * inv, kk[j4 * 4 + 3] * inv}; }
        st16bf(Kb + o, k); st16bf(V + o, v);
        if ((lane & 3) == 0) BON[(size_t)t * 16 + (lane >> 2)] = bs;
        { const int cl = 3072 + lane * 4; const u32x2 zw = *(const u32x2*)(zc + cl); u32x2 pw = {0u, 0u}, nw = {0u, 0u};
          if (hp) pw = *(const u32x2*)(zc - 3328 + cl); if (hn) nw = *(const u32x2*)(zc + 3328 + cl);
          const f32x4 a = *(const f32x4*)(p.mu_prev + cl), b = *(const f32x4*)(p.mu_next + cl);
          const float z4[4] = {bflo(zw.x), bfhi(zw.x), bflo(zw.y), bfhi(zw.y)}, p4[4] = {bflo(pw.x), bfhi(pw.x), bflo(pw.y), bfhi(pw.y)}, n4[4] = {bflo(nw.x), bfhi(nw.x), bflo(nw.y), bfhi(nw.y)};
          float o4[4];
#pragma unroll
          for (int j = 0; j < 4; ++j) { float s = z4[j] + a[j] * (p4[j] - z4[j]) + b[j] * (n4[j] - z4[j]); o4[j] = (lane < 32) ? tanhf(s) : s; }
          u32x2 w; w.x = cvt_pk_bf16(o4[0], o4[1]); w.y = cvt_pk_bf16(o4[2], o4[3]); *(u32x2*)(AL + (size_t)t * 256 + lane * 4) = w; }
    }
}

__device__ __forceinline__ void nat_phase(const Params& p) {
    const int lane = threadIdx.x & 63, wid = __builtin_amdgcn_readfirstlane(threadIdx.x >> 6), l15 = lane & 15, lq = lane >> 4;
    const u16* Qn = (const u16*)p.out; const u16* Kn = Qn + (size_t)NTOK * RW; const u16* VT = Kn + (size_t)NTOK * RW; const u16* Gn = VT + (size_t)NTOK * RW;
    u16* MIX = (u16*)(p.ws + O_HN);
    for (int item = blockIdx.x * 8 + wid; item < 8192; item += gridDim.x * 8) {
        const int r = item & 255, h = (item >> 8) & 15, b = item >> 12;
        const int rs = min(max(r - 4, 0), 248);
        const u16* Qb = Qn + (size_t)(b * SEQ + r * 64) * RW + h * 64;
        const u16* Kb = Kn + (size_t)(b * SEQ + rs * 64) * RW + h * 64;
        const u16* Vb = VT + (size_t)((b * 16 + h) * 64) * SEQ + rs * 64;
        const float* rpb = p.rpb + h * 465 + (rs - r + 7) * 31;
#pragma unroll 1
        for (int qt = 0; qt < 4; ++qt) {
            const int c0 = qt * 16, cs0 = (qt == 0) ? 0 : (qt == 1 ? 8 : (qt == 2 ? 24 : 32));
            const int c = c0 + l15, csq = min(max(c - 8, 0), 48);
            const bf16x8 bq0 = *(const bf16x8*)(Qb + (size_t)c * RW + lq * 8), bq1 = *(const bf16x8*)(Qb + (size_t)c * RW + 32 + lq * 8);
            f32x4 sc[8][2];
#pragma unroll
            for (int i = 0; i < 8; ++i)
#pragma unroll
                for (int hf = 0; hf < 2; ++hf) { const u16* kp = Kb + (size_t)(i * 64 + cs0 + hf * 16 + l15) * RW + lq * 8;
                    const bf16x8 a0 = *(const bf16x8*)kp, a1 = *(const bf16x8*)(kp + 32); f32x4 z = {0.f, 0.f, 0.f, 0.f};
                    z = __builtin_amdgcn_mfma_f32_16x16x32_bf16(a0, bq0, z, 0, 0, 0); z = __builtin_amdgcn_mfma_f32_16x16x32_bf16(a1, bq1, z, 0, 0, 0); sc[i][hf] = z; }
            float mx = -1e30f;
#pragma unroll
            for (int i = 0; i < 8; ++i)
#pragma unroll
                for (int hf = 0; hf < 2; ++hf)
#pragma unroll
                    for (int j = 0; j < 4; ++j) { const int kc = cs0 + hf * 16 + lq * 4 + j; const bool valid = (kc >= csq) && (kc < csq + 16); const int bc = valid ? (kc - c + 15) : 0;
                        const float s = valid ? sc[i][hf][j] * 0.125f + rpb[i * 31 + bc] : -1e30f; sc[i][hf][j] = s; mx = fmaxf(mx, s); }
            mx = fmaxf(mx, __shfl_xor(mx, 16)); mx = fmaxf(mx, __shfl_xor(mx, 32));
            float sum = 0.f;
#pragma unroll
            for (int i = 0; i < 8; ++i)
#pragma unroll
                for (int hf = 0; hf < 2; ++hf)
#pragma unroll
                    for (int j = 0; j < 4; ++j) { const float e = __expf(sc[i][hf][j] - mx); sc[i][hf][j] = e; sum += e; }
            sum += __shfl_xor(sum, 16); sum += __shfl_xor(sum, 32);
            const float inv = 1.0f / sum;
            f32x4 o[4];
#pragma unroll
            for (int mt = 0; mt < 4; ++mt) o[mt] = (f32x4){0.f, 0.f, 0.f, 0.f};
#pragma unroll
            for (int i = 0; i < 8; ++i) {
                u32x4 pw; pw.x = cvt_pk_bf16(sc[i][0][0] * inv, sc[i][0][1] * inv); pw.y = cvt_pk_bf16(sc[i][0][2] * inv, sc[i][0][3] * inv);
                pw.z = cvt_pk_bf16(sc[i][1][0] * inv, sc[i][1][1] * inv); pw.w = cvt_pk_bf16(sc[i][1][2] * inv, sc[i][1][3] * inv);
                const bf16x8 bp = __builtin_bit_cast(bf16x8, pw);
#pragma unroll
                for (int mt = 0; mt < 4; ++mt) { const u16* vp = Vb + (size_t)(mt * 16 + l15) * SEQ + i * 64 + cs0 + lq * 4;
                    const u32x2 v0 = *(const u32x2*)vp, v1 = *(const u32x2*)(vp + 16); u32x4 vw; vw.x = v0.x; vw.y = v0.y; vw.z = v1.x; vw.w = v1.y;
                    o[mt] = __builtin_amdgcn_mfma_f32_16x16x32_bf16(__builtin_bit_cast(bf16x8, vw), bp, o[mt], 0, 0, 0); }
            }
            const size_t tok = (size_t)(b * SEQ + r * 64 + c);
#pragma unroll
            for (int mt = 0; mt < 4; ++mt) { const int ch = h * 64 + mt * 16 + lq * 4; const u32x2 gw = *(const u32x2*)(Gn + tok * RW + ch);
                const float g0 = bflo(gw.x), g1 = bfhi(gw.x), g2 = bflo(gw.y), g3 = bfhi(gw.y);
                u32x2 w; w.x = cvt_pk_bf16(o[mt][0] * g0 * sigmoidf_(g0), o[mt][1] * g1 * sigmoidf_(g1)); w.y = cvt_pk_bf16(o[mt][2] * g2 * sigmoidf_(g2), o[mt][3] * g3 * sigmoidf_(g3));
                *(u32x2*)(MIX + tok * DM + 1024 + ch) = w; }
        }
    }
}

template <int N> __device__ __forceinline__ void fmac_bc(float& d, float bsrc, float o) { asm volatile("v_fmac_f32_dpp %0, %1, %2 row_newbcast:%3 row_mask:0xf bank_mask:0xf" : "+v"(d) : "v"(bsrc), "v"(o), "n"(N)); }
template <int N> __device__ __forceinline__ float mul_bc(float bsrc, float o) { float d; asm volatile("v_mul_f32_dpp %0, %1, %2 row_newbcast:%3 row_mask:0xf bank_mask:0xf" : "=v"(d) : "v"(bsrc), "v"(o), "n"(N)); return d; }
struct In1 { f32x4 w, a, b, kd; unsigned v; };
struct In2 { f32x4 w, a, b, kd, r; unsigned v; float yo; };
#define BC(x, k) x[(k) & 3]
template <int K> struct ScanK {
    static constexpr int N0 = K >> 2, N1 = (K + 1) >> 2;
    static __device__ __forceinline__ void dot(const float (&S)[64], const f32x4& a, float& s0, float& s1) {
        fmac_bc<N0>(s0, BC(a, K), S[K]); fmac_bc<N1>(s1, BC(a, K + 1), S[K + 1]);
        if constexpr (K + 2 < 64) ScanK<K + 2>::dot(S, a, s0, s1);
    }
    static __device__ __forceinline__ void upd(float (&S)[64], const In2& in, float sa, float vv, float& y0, float& y1) {
        float t0 = mul_bc<N0>(BC(in.kd, K), vv); float t1 = mul_bc<N1>(BC(in.kd, K + 1), vv);
        fmac_bc<N0>(t0, BC(in.w, K), S[K]); fmac_bc<N1>(t1, BC(in.w, K + 1), S[K + 1]);
        fmac_bc<N0>(t0, BC(in.b, K), sa); fmac_bc<N1>(t1, BC(in.b, K + 1), sa);
        S[K] = t0; S[K + 1] = t1;
        fmac_bc<N0>(y0, BC(in.r, K), t0); fmac_bc<N1>(y1, BC(in.r, K + 1), t1);
        if constexpr (K + 2 < 64) ScanK<K + 2>::upd(S, in, sa, vv, y0, y1);
    }
    static __device__ __forceinline__ void updS(float (&S)[64], const In1& in, float sa, float vv) {
        float t0 = mul_bc<N0>(BC(in.kd, K), vv); float t1 = mul_bc<N1>(BC(in.kd, K + 1), vv);
        fmac_bc<N0>(t0, BC(in.w, K), S[K]); fmac_bc<N1>(t1, BC(in.w, K + 1), S[K + 1]);
        fmac_bc<N0>(t0, BC(in.b, K), sa); fmac_bc<N1>(t1, BC(in.b, K + 1), sa);
        S[K] = t0; S[K + 1] = t1;
        if constexpr (K + 2 < 64) ScanK<K + 2>::updS(S, in, sa, vv);
    }
    static __device__ __forceinline__ void updP(float (&P)[64], const In1& in, float sa) {
        float u0 = mul_bc<N0>(BC(in.w, K), P[K]); float u1 = mul_bc<N1>(BC(in.w, K + 1), P[K + 1]);
        fmac_bc<N0>(u0, BC(in.b, K), sa); fmac_bc<N1>(u1, BC(in.b, K + 1), sa);
        P[K] = u0; P[K + 1] = u1;
        if constexpr (K + 2 < 64) ScanK<K + 2>::updP(P, in, sa);
    }
};
__device__ __forceinline__ void scan_pass1(const Params& p, int d) {
    const int lane = threadIdx.x & 63, wid = __builtin_amdgcn_readfirstlane(threadIdx.x >> 6); const unsigned lo16 = (lane & 15) * 16, lo2 = lane * 2;
    const float* Wd = p.out; const float* Bd = p.out + (size_t)NTOK * RW; const float* KD = (const float*)(p.ws + O_KD); const float* A = (const float*)(p.ws + O_A);
    const u16* V = (const u16*)(p.ws + O_V); float* PT = (float*)(p.ws + O_PT); float* SLT = (float*)(p.ws + O_SLT);
    constexpr int NS = 32 * (NC - 1);
    for (int item = blockIdx.x * 8 + wid; item < 2 * NS; item += gridDim.x * 8) {
        const bool isP = item >= NS; const int idx = isP ? item - NS : item;
        const int bh = idx / (NC - 1), c = idx - bh * (NC - 1), b = bh >> 4, h = bh & 15;
        const int t0 = d ? (SEQ - 1 - c * LC) : c * LC;
        const size_t off0 = ((size_t)(b * SEQ + t0)) * RW + h * 64; const long stp = d ? -(long)RW : (long)RW;
        const float *wq = Wd + off0, *aq = A + off0, *bq = Bd + off0, *kq = KD + off0; const u16* vq = V + off0;
        float S[64]; int ln = lane; asm volatile("" : "+v"(ln));
#define SB __builtin_amdgcn_sched_barrier(0)
#define LDX(base, o_) (*(const f32x4*)((const char*)((base) + (o_)) + lo16))
        if (!isP) {
#pragma unroll
            for (int i = 0; i < 64; ++i) S[i] = 0.f;
#define LD1(set, s) { const long o_ = (long)min((int)(s), LC - 1) * stp; set.w = LDX(wq, o_); set.a = LDX(aq, o_); set.b = LDX(bq, o_); set.kd = LDX(kq, o_); set.v = *(const u16*)((const char*)(vq + o_) + lo2); }
#define TOUCH1(set) asm volatile("" :: "v"(set.w), "v"(set.a), "v"(set.b), "v"(set.kd), "v"(set.v))
#define ST1(set) { float s0 = 0.f, s1 = 0.f; ScanK<0>::dot(S, set.a, s0, s1); ScanK<0>::updS(S, set, s0 + s1, __uint_as_float(set.v << 16)); }
            In1 i0, i1; LD1(i0, 0);
#pragma unroll 1
            for (int s = 0; s < LC; s += 2) { TOUCH1(i0); SB; LD1(i1, s + 1); SB; ST1(i0); TOUCH1(i1); SB; LD1(i0, s + 2); SB; ST1(i1); }
#undef LD1
#undef TOUCH1
#undef ST1
        } else {
#pragma unroll
            for (int i = 0; i < 64; ++i) S[i] = (ln == i) ? 1.f : 0.f;
#define LD1(set, s) { const long o_ = (long)min((int)(s), LC - 1) * stp; set.w = LDX(wq, o_); set.a = LDX(aq, o_); set.b = LDX(bq, o_); }
#define TOUCH1(set) asm volatile("" :: "v"(set.w), "v"(set.a), "v"(set.b))
#define ST1(set) { float s0 = 0.f, s1 = 0.f; ScanK<0>::dot(S, set.a, s0, s1); ScanK<0>::updP(S, set, s0 + s1); }
            In1 i0, i1; LD1(i0, 0);
#pragma unroll 1
            for (int s = 0; s < LC; s += 2) { TOUCH1(i0); SB; LD1(i1, s + 1); SB; ST1(i0); TOUCH1(i1); SB; LD1(i0, s + 2); SB; ST1(i1); }
#undef LD1
#undef TOUCH1
#undef ST1
        }
        float* po = (isP ? PT : SLT) + ((size_t)(bh * NC + c)) * 4096 + lane;
#pragma unroll
        for (int i = 0; i < 64; ++i) { *po = S[i]; po += 64; asm volatile("" : "+v"(po)); }
    }
}
__device__ __forceinline__ void scan_combine(const Params& p, float* sl) {
    const int tid = threadIdx.x, vl = tid & 7, k = tid >> 3;
    const float* PT = (const float*)(p.ws + O_PT); const float* SLT = (const float*)(p.ws + O_SLT); float* SIT = (float*)(p.ws + O_SIT);
    for (int item = blockIdx.x; item < 256; item += gridDim.x) {
        const int bh = item >> 3, g = item & 7;
        const float* pt = PT + (size_t)bh * NC * 4096 + k * 64; const float* st = SLT + (size_t)bh * NC * 4096 + k * 64 + g * 8 + vl; float* si = SIT + (size_t)bh * NC * 4096 + k * 64 + g * 8 + vl;
        __syncthreads();
        sl[tid] = 0.f;
        f32x4 Pr[16], Pn[16];
#pragma unroll
        for (int i = 0; i < 16; ++i) Pr[i] = *(const f32x4*)(pt + i * 4);
        __syncthreads();
#pragma unroll 1
        for (int c = 0; c < NC - 1; ++c) {
            if (c + 1 < NC - 1) {
#pragma unroll
                for (int i = 0; i < 16; ++i) Pn[i] = *(const f32x4*)(pt + (size_t)(c + 1) * 4096 + i * 4); }
            float acc = st[(size_t)c * 4096];
#pragma unroll
            for (int i = 0; i < 16; ++i) { const f32x4 sv = *(const f32x4*)(sl + vl * 64 + i * 4); acc += sv[0] * Pr[i][0] + sv[1] * Pr[i][1] + sv[2] * Pr[i][2] + sv[3] * Pr[i][3]; }
            __syncthreads();
            sl[vl * 64 + k] = acc; si[(size_t)(c + 1) * 4096] = acc;
            __syncthreads();
#pragma unroll
            for (int i = 0; i < 16; ++i) Pr[i] = Pn[i];
        }
    }
}
__device__ __forceinline__ void scan_pass2(const Params& p, int d) {
    const int lane = threadIdx.x & 63, wid = __builtin_amdgcn_readfirstlane(threadIdx.x >> 6); const unsigned lo16 = (lane & 15) * 16, lo2 = lane * 2, lo4b = lane * 4;
    const float* Wd = p.out; const float* Bd = p.out + (size_t)NTOK * RW; const float* KD = (const float*)(p.ws + O_KD); const float* A = (const float*)(p.ws + O_A); const float* R = (const float*)(p.ws + O_R);
    const u16* V = (const u16*)(p.ws + O_V); const float* SIT = (const float*)(p.ws + O_SIT); float* Y = (float*)(p.ws + O_Y);
    for (int item = blockIdx.x * 8 + wid; item < 32 * NC; item += gridDim.x * 8) {
        const int bh = item / NC, c = item - bh * NC, b = bh >> 4, h = bh & 15;
        const int t0 = d ? (SEQ - 1 - c * LC) : c * LC;
        const size_t off0 = ((size_t)(b * SEQ + t0)) * RW + h * 64; const long stp = d ? -(long)RW : (long)RW;
        const float *wq = Wd + off0, *aq = A + off0, *bq = Bd + off0, *kq = KD + off0, *rq = R + off0; const u16* vq = V + off0; float* yq = Y + off0;
        float S[64];
        if (c == 0) {
#pragma unroll
            for (int i = 0; i < 64; ++i) S[i] = 0.f;
        } else { const float* si = SIT + ((size_t)(bh * NC + c)) * 4096 + lane;
#pragma unroll
            for (int i = 0; i < 64; ++i) { S[i] = *si; si += 64; asm volatile("" : "+v"(si)); } }
#define LD2(set, s) { const long o_ = (long)min((int)(s), LC - 1) * stp; set.w = LDX(wq, o_); set.a = LDX(aq, o_); set.b = LDX(bq, o_); set.kd = LDX(kq, o_); \
            set.r = LDX(rq, o_); set.v = *(const u16*)((const char*)(vq + o_) + lo2); set.yo = d ? *(const float*)((const char*)(yq + o_) + lo4b) : 0.f; }
#define ST2(set, s) { float s0 = 0.f, s1 = 0.f; ScanK<0>::dot(S, set.a, s0, s1); float y0 = set.yo, y1 = 0.f; ScanK<0>::upd(S, set, s0 + s1, __uint_as_float(set.v << 16), y0, y1); *(float*)((char*)(yq + (long)(s) * stp) + lo4b) = y0 + y1; }
#define TOUCH2(set) asm volatile("" :: "v"(set.w), "v"(set.a), "v"(set.b), "v"(set.kd), "v"(set.r), "v"(set.v), "v"(set.yo))
        In2 i0, i1; LD2(i0, 0);
#pragma unroll 1
        for (int s = 0; s < LC; s += 2) { TOUCH2(i0); SB; LD2(i1, s + 1); SB; ST2(i0, s); TOUCH2(i1); SB; LD2(i0, s + 2); SB; ST2(i1, s + 1); }
#undef LD2
#undef ST2
    }
}

__device__ __forceinline__ void post_phase(const Params& p) {
    const int lane = threadIdx.x & 63, wid = threadIdx.x >> 6;
    const float* Y = (const float*)(p.ws + O_Y); const u16* V = (const u16*)(p.ws + O_V); const u16* ZG = (const u16*)(p.ws + O_ZG); const float* BON = (const float*)(p.ws + O_BON);
    u16* MIX = (u16*)(p.ws + O_HN); u16* PB = (u16*)(p.ws + O_AL);
    for (int t = blockIdx.x * 8 + wid; t < NTOK; t += gridDim.x * 8) {
        const int c = lane * 16; const size_t o = (size_t)t * RW + c;
        float y[16], v[16], g[16]; float s = 0.f;
#pragma unroll
        for (int j4 = 0; j4 < 4; ++j4) { const f32x4 a = *(const f32x4*)(Y + o + j4 * 4); y[j4 * 4] = a[0]; y[j4 * 4 + 1] = a[1]; y[j4 * 4 + 2] = a[2]; y[j4 * 4 + 3] = a[3]; s += a[0] + a[1] + a[2] + a[3]; }
        ld16bf(V + o, v); ld16bf(ZG + o, g);
        s += __shfl_xor(s, 1); s += __shfl_xor(s, 2); const float mu = s * (1.0f / 64.0f);
        float q = 0.f;
#pragma unroll
        for (int j = 0; j < 16; ++j) { y[j] -= mu; q += y[j] * y[j]; }
        q += __shfl_xor(q, 1); q += __shfl_xor(q, 2); const float rs = rsqrtf(q * (1.0f / 64.0f) + 64e-5f);
        const float bon = BON[(size_t)t * 16 + (lane >> 2)];
        float outv[16];
#pragma unroll
        for (int j4 = 0; j4 < 4; ++j4) { const f32x4 lw = *(const f32x4*)(p.lnx_w + c + j4 * 4), lb = *(const f32x4*)(p.lnx_b + c + j4 * 4);
#pragma unroll
            for (int j = 0; j < 4; ++j) { const int i = j4 * 4 + j; const float yn = y[i] * rs * lw[j] + lb[j]; outv[i] = (yn + bon * v[i]) * g[i] * sigmoidf_(g[i]); } }
        st16bf(MIX + (size_t)t * DM + c, outv);
        { const f32x4 pv = *(const f32x4*)(p.p + (size_t)t * 256 + lane * 4); u32x2 w; w.x = cvt_pk_bf16(pv[0], pv[1]); w.y = cvt_pk_bf16(pv[2], pv[3]); *(u32x2*)(PB + (size_t)t * 256 + lane * 4) = w; }
    }
}

__global__ void __launch_bounds__(NTHREADS, 2) mega(Params p) {
    extern __shared__ __attribute__((aligned(16))) unsigned char lds[];
    cg::grid_group grid = cg::this_grid();
    unsigned char* ws = p.ws;
#define PH_ON(n) (p.ph_lo <= (n) && (n) < p.ph_hi)
#define PH_END(n) do { if ((n) + 1 < p.ph_hi) grid.sync(); } while (0)
#ifndef PROBE_PH
#define PROBE_PH -1
#endif
#define RUN(n, ...) if (PH_ON(n)) { __VA_ARGS__ if (PROBE_PH == (n)) { __syncthreads(); __VA_ARGS__ } PH_END(n); }
    RUN(0,
        transpose_cvt(p.w_in, 2048, 8448, (u16*)(ws + O_W1T), 2048, (float*)lds);
        transpose_cvt(p.w_out, 2048, 2048, (u16*)(ws + O_W2T), 2048, (float*)lds);
        transpose_cvt(p.w_ple_gate, 2048, 2048, (u16*)(ws + O_W3T), 2048, (float*)lds);
        transpose_cvt(p.w_ple_proj, 256, 2048, (u16*)(ws + O_WPT), 256, (float*)lds);
        build_wlt(p);
        rownorm<true>(p.x, p.norm_mix_g, ws + O_HN);)
    RUN(1, {
        EpiZ e; e.zs = (u16*)(ws + O_ZS); e.zg = (u16*)(ws + O_ZG); e.qn = (u16*)p.out; e.kn = e.qn + (size_t)NTOK * RW; e.vt = e.kn + (size_t)NTOK * RW; e.gn = e.vt + (size_t)NTOK * RW;
        run_gemm(lds, (const u16*)(ws + O_HN), (const u16*)(ws + O_W1T), NTOK, 8448, 2048, e); })
    RUN(2, nat_phase(p); prep_phase(p);)
#define SCAN_DIR(d, pb) \
    RUN(pb, { \
        EpiLora e; e.w0 = p.decay_w0 + (d) * RW; e.a0 = p.iclr_a0 + (d) * RW; e.ka = p.k_a; e.A = (const float*)(ws + O_A); e.Kb = (const u16*)(ws + O_K); \
        e.Wd = p.out; e.Bd = p.out + (size_t)NTOK * RW; e.KD = (float*)(ws + O_KD); \
        run_gemm(lds, (const u16*)(ws + O_AL), (const u16*)(ws + O_WLT) + (size_t)(d) * 2048 * 256, NTOK, 2048, 256, e); }) \
    RUN(pb + 1, scan_pass1(p, d);) \
    RUN(pb + 2, scan_combine(p, (float*)lds);) \
    RUN(pb + 3, scan_pass2(p, d);)
    SCAN_DIR(0, 3)
    SCAN_DIR(1, 7)
    RUN(11, post_phase(p);)
    RUN(12, {
        EpiH e; e.X = p.x; e.H = p.out;
        run_gemm(lds, (const u16*)(ws + O_HN), (const u16*)(ws + O_W2T), NTOK, 2048, 2048, e);
        EpiBf e2; e2.O = (u16*)(ws + O_R); e2.ld = DM;
        run_gemm(lds, (const u16*)(ws + O_AL), (const u16*)(ws + O_WPT), NTOK, 2048, 256, e2); })
    RUN(13, rownorm<true>(p.out, p.ple_norm_g, ws + O_HN);)
    RUN(14, {
        EpiGate e; e.H = p.out; e.PP = (const u16*)(ws + O_R);
        run_gemm(lds, (const u16*)(ws + O_HN), (const u16*)(ws + O_W3T), NTOK, 2048, 2048, e); })
    RUN(15, rownorm<false>(p.out, p.final_g, p.out);)
}

extern "C" void kernel_launch(void* const* d_in, const int* in_sizes, int n_in, void* d_out, int out_size, void* d_ws, size_t ws_size, hipStream_t stream) {
    static int grid = 0;
    if (grid == 0) {
        if (n_in != 21 || out_size != NTOK * DM || ws_size < WS_END) { fprintf(stderr, "kernel_launch: unexpected shapes (n_in %d out %d ws %zu need %zu)\n", n_in, out_size, ws_size, (size_t)WS_END); grid = -1; return; }
        int dev = 0, cus = 0, per_cu = 0;
        hipGetDevice(&dev); hipDeviceGetAttribute(&cus, hipDeviceAttributeMultiprocessorCount, dev);
        hipFuncSetAttribute((const void*)mega, hipFuncAttributeMaxDynamicSharedMemorySize, LDS_BYTES);
        hipOccupancyMaxActiveBlocksPerMultiprocessor(&per_cu, (const void*)mega, NTHREADS, LDS_BYTES);
        if (per_cu < 1) { fprintf(stderr, "kernel_launch: occupancy query says %d blocks/CU\n", per_cu); grid = -1; return; }
        grid = cus;
    }
    if (grid < 0) return;
    Params p{};
    const float** f = (const float**)&p;
    for (int i = 0; i < 21; ++i) f[i] = (const float*)d_in[i];
    p.out = (float*)d_out; p.ws = (unsigned char*)d_ws;
#if MULTI_LAUNCH
    for (int ph = 0; ph < 16; ++ph) { p.ph_lo = ph; p.ph_hi = ph + 1; hipLaunchKernelGGL(mega, dim3(grid), dim3(NTHREADS), LDS_BYTES, stream, p); }
#else
    p.ph_lo = 0; p.ph_hi = 16;
    void* args[] = {&p};
    hipError_t e = hipLaunchCooperativeKernel((const void*)mega, dim3(grid), dim3(NTHREADS), args, LDS_BYTES, stream);
    if (e != hipSuccess) fprintf(stderr, "cooperative launch failed: %s (grid %d)\n", hipGetErrorString(e), grid);
#endif
}
```

```cpp
#include <hip/hip_runtime.h>
#include <hip/hip_cooperative_groups.h>
#include <cstdio>
namespace cg = cooperative_groups;

#ifndef MULTI_LAUNCH
#define MULTI_LAUNCH 0
#endif

#define LAS __attribute__((address_space(3)))
typedef unsigned short u16;
typedef short bf16x8 __attribute__((ext_vector_type(8)));
typedef float f32x4 __attribute__((ext_vector_type(4)));
typedef float f32x2 __attribute__((ext_vector_type(2)));
typedef unsigned u32x4 __attribute__((ext_vector_type(4)));
typedef unsigned u32x2 __attribute__((ext_vector_type(2)));
typedef const __attribute__((address_space(4))) f32x2* cf2p;

constexpr int SEQ = 16384, NTOK = 32768, DM = 2048, RW = 1024;
constexpr int NC = 64, LC = SEQ / NC;
constexpr int NTHREADS = 512, LDS_XB = 131072, LDS_BYTES = 131072 + 16;
constexpr float DECAY_SCALE = 0.6065306597126334f;

constexpr size_t MiB = 1ull << 20;
constexpr size_t O_W1T = 0, O_W2T = 33 * MiB, O_W3T = 41 * MiB, O_WPT = 49 * MiB, O_WLT = 50 * MiB;
constexpr size_t O_HN = 56 * MiB;
constexpr size_t O_ZS = 184 * MiB;
constexpr size_t O_KD = O_ZS, O_PT = O_ZS + 128 * MiB, O_SLT = O_ZS + 160 * MiB;
constexpr size_t O_ZG = 392 * MiB;
constexpr size_t O_R = 456 * MiB;
constexpr size_t O_A = 584 * MiB;
constexpr size_t O_V = 712 * MiB;
constexpr size_t O_K = 776 * MiB;
constexpr size_t O_AL = 840 * MiB;
constexpr size_t O_BON = 856 * MiB;
constexpr size_t O_Y = 858 * MiB;
constexpr size_t O_SIT = 986 * MiB;
constexpr size_t O_BAR = 1018 * MiB;
constexpr size_t WS_END = 1019 * MiB;

struct Params {
    const float *x, *p, *norm_mix_g, *w_in, *mu_prev, *mu_next, *decay_w0, *decay_w2, *iclr_a0, *iclr_a2, *k_k, *k_a, *r_k, *lnx_w, *lnx_b, *rpb, *w_out,
        *ple_norm_g, *w_ple_gate, *w_ple_proj, *final_g;
    float* out; unsigned char* ws;
    int ph_lo, ph_hi;
};

__device__ __forceinline__ float bf2f(u16 b) { return __uint_as_float(((unsigned)b) << 16); }
__device__ __forceinline__ float bflo(unsigned w) { return __uint_as_float(w << 16); }
__device__ __forceinline__ float bfhi(unsigned w) { return __uint_as_float(w & 0xffff0000u); }
__device__ __forceinline__ unsigned cvt_pk_bf16(float lo, float hi) { unsigned r; asm volatile("v_cvt_pk_bf16_f32 %0, %1, %2" : "=v"(r) : "v"(lo), "v"(hi)); return r; }
__device__ __forceinline__ float sigmoidf_(float x) { return __builtin_amdgcn_rcpf(1.0f + __expf(-x)); }
__device__ __forceinline__ f32x2 fma2(f32x2 a, f32x2 b, f32x2 c) { return __builtin_elementwise_fma(a, b, c); }

namespace pg8 {
constexpr int BM = 256, BK = 64, HALF = 128, HTB = HALF * BK * 2, NXCD = 8, WGM = 8;
__device__ __forceinline__ int lds_byte(int r, int c) { const int st = (r >> 4) * 2 + (c >> 5), rr = r & 15, cc = c & 31, ob = rr * 64 + cc * 2; return st * 1024 + (ob ^ (((ob >> 9) & 1) << 5)); }
__device__ __forceinline__ void stage_rc(int b, int& R, int& C) { const int st = b / 1024, sb = b % 1024, swz = sb ^ (((sb >> 9) & 1) << 5); R = (st >> 1) * 16 + swz / 64; C = (st & 1) * 32 + (swz % 64) / 2; }
__device__ __forceinline__ int perm32(int rho) { const int n = rho >> 4, i = rho & 15; return 8 * (i >> 2) + 4 * n + (i & 3); }
struct Unit { int pm, pn; };
struct Gemm { const u16* A; const u16* Bt; int M, N, K; };
struct StaticOrder {
    int nM, nN, nwg, G, c;
    __device__ void init(int M, int N, int G_, int c_) { nM = M / BM; nN = N / BM; nwg = nM * nN; G = G_; c = c_; }
    __device__ bool next(int i, Unit& u) const {
        const long L = (long)i * G + c; if (L >= nwg) return false;
        int wgid = (int)L; { const int q = nwg / NXCD, r = nwg % NXCD, xcd = wgid % NXCD, off = wgid / NXCD; wgid = (xcd < r ? xcd * (q + 1) : r * (q + 1) + (xcd - r) * q) + off; }
        const int nig = WGM * nN, gid = wgid / nig, fm = gid * WGM, gsz = (nM - fm) < WGM ? (nM - fm) : WGM;
        u.pm = fm + ((wgid % nig) % gsz); u.pn = (wgid % nig) / gsz; return true;
    }
};
template <class Epi>
__device__ __forceinline__ void gemm_phase(LAS unsigned char* lds, const Gemm g, const StaticOrder& S, const Epi& E) {
    const int tid = threadIdx.x, wid = __builtin_amdgcn_readfirstlane(tid >> 6), lane = tid & 63, wr = wid >> 2, wc = wid & 3, fr = lane & 15, fq = lane >> 4;
    const int K = g.K, nt = K / BK;
    unsigned voffA[2], voffB[2];
#pragma unroll
    for (int i = 0; i < 2; ++i) { int R, C; stage_rc(tid * 16 + i * 8192, R, C); const int Rb = Epi::PERM ? ((R & ~31) + perm32(R & 31)) : R;
        voffA[i] = (unsigned)(R * K + C) * 2u; voffB[i] = (unsigned)(Rb * K + C) * 2u; }
    const size_t kstep = (size_t)(BK * 2);
    const size_t hstep = (size_t)HALF * K * 2;
    const size_t tstep = 2 * hstep;
    const unsigned ldsw = (unsigned)wid * 1024u;
    const int aoff = lds_byte(wr * 64 + fr, fq * 8), boff = lds_byte(wc * 32 + fr, fq * 8);
#define PG8_SA(b, h) (((b) * 2 + (h)) * HTB)
#define PG8_SB(b, h) ((4 + (b) * 2 + (h)) * HTB)
#define PG8_STAGE(bufoff, gbase, voff) do { _Pragma("unroll") for (int _i = 0; _i < 2; ++_i) \
        __builtin_amdgcn_global_load_lds((const unsigned*)((const char*)(gbase) + (voff)[_i]), (LAS unsigned*)(lds + (bufoff) + ldsw + _i * 8192), 16, 0, 0); } while (0)
#define PG8_LDA(dst, b, h) do { _Pragma("unroll") for (int m = 0; m < 4; ++m) _Pragma("unroll") for (int k = 0; k < 2; ++k) dst[m][k] = *(const LAS bf16x8*)(lds + PG8_SA(b, h) + aoff + m * 2048 + k * 1024); } while (0)
#define PG8_LDB(dst, b, h) do { _Pragma("unroll") for (int n = 0; n < 2; ++n) _Pragma("unroll") for (int k = 0; k < 2; ++k) dst[n][k] = *(const LAS bf16x8*)(lds + PG8_SB(b, h) + boff + n * 2048 + k * 1024); } while (0)
#define PG8_MMA(ai, bj, At, Bt) do { __builtin_amdgcn_s_setprio(1); _Pragma("unroll") for (int m = 0; m < 4; ++m) _Pragma("unroll") for (int n = 0; n < 2; ++n) _Pragma("unroll") for (int k = 0; k < 2; ++k) \
        acc[ai][bj][m][n] = __builtin_amdgcn_mfma_f32_16x16x32_bf16(Bt[n][k], At[m][k], acc[ai][bj][m][n], 0, 0, 0); __builtin_amdgcn_s_setprio(0); } while (0)
#define PG8_WAIT_V(n) asm volatile("s_waitcnt vmcnt(" #n ")" ::: "memory")
#define PG8_WAIT_L(n) asm volatile("s_waitcnt lgkmcnt(" #n ")" ::: "memory")
#define PG8_BAR __builtin_amdgcn_s_barrier()
#define PG8_SCHED __builtin_amdgcn_sched_barrier(0)
    Unit cur, nxt; int ui = 0;
    if (!S.next(0, cur)) return;
    f32x4 acc[2][2][4][2];
#pragma unroll
    for (int a = 0; a < 2; ++a)
#pragma unroll
        for (int b = 0; b < 2; ++b)
#pragma unroll
            for (int m = 0; m < 4; ++m)
#pragma unroll
                for (int n = 0; n < 2; ++n) acc[a][b][m][n] = (f32x4){0.f, 0.f, 0.f, 0.f};
    bf16x8 At[4][2], B0[2][2], B1[2][2];
    const char* cA = (const char*)g.A + (size_t)cur.pm * tstep; const char* cB = (const char*)g.Bt + (size_t)cur.pn * tstep;
    PG8_STAGE(PG8_SB(0, 0), cB, voffB); PG8_STAGE(PG8_SA(0, 0), cA, voffA); PG8_STAGE(PG8_SB(0, 1), cB + hstep, voffB); PG8_STAGE(PG8_SA(0, 1), cA + hstep, voffA);
    if (wr == 1) PG8_BAR;
    PG8_WAIT_V(4); PG8_BAR;
    PG8_STAGE(PG8_SB(1, 0), cB + kstep, voffB); PG8_STAGE(PG8_SA(1, 0), cA + kstep, voffA); PG8_STAGE(PG8_SB(1, 1), cB + hstep + kstep, voffB);
    PG8_WAIT_V(6); PG8_BAR;
    for (;;) {
        const bool has_next = S.next(ui + 1, nxt);
        const char* nA = has_next ? (const char*)g.A + (size_t)nxt.pm * tstep : cA; const char* nB = has_next ? (const char*)g.Bt + (size_t)nxt.pn * tstep : cB;
        for (int t = 0; t < nt; t += 2) {
            const bool last = (t == nt - 2);
            const char* a1 = cA + (size_t)(t + 1) * kstep;
            const char* a2 = last ? nA : cA + (size_t)(t + 2) * kstep; const char* b2 = last ? nB : cB + (size_t)(t + 2) * kstep;
            const char* a3 = a2 + kstep; const char* b3 = b2 + kstep;
            PG8_LDB(B0, 0, 0); PG8_SCHED; PG8_LDA(At, 0, 0); PG8_STAGE(PG8_SA(1, 1), a1 + hstep, voffA);
            PG8_WAIT_L(8); PG8_BAR; PG8_WAIT_L(0); PG8_MMA(0, 0, At, B0); PG8_BAR; PG8_SCHED;
            PG8_LDB(B1, 0, 1); PG8_STAGE(PG8_SB(0, 0), b2, voffB);
            PG8_BAR; PG8_WAIT_L(0); PG8_MMA(0, 1, At, B1); PG8_BAR;
            PG8_LDA(At, 0, 1); PG8_STAGE(PG8_SA(0, 0), a2, voffA);
            PG8_BAR; PG8_WAIT_L(0); PG8_MMA(1, 0, At, B0); PG8_BAR; PG8_SCHED;
            PG8_STAGE(PG8_SB(0, 1), b2 + hstep, voffB);
            PG8_WAIT_V(6); PG8_BAR; PG8_MMA(1, 1, At, B1); PG8_BAR;
            PG8_LDB(B0, 1, 0); PG8_SCHED; PG8_LDA(At, 1, 0); PG8_STAGE(PG8_SA(0, 1), a2 + hstep, voffA);
            PG8_WAIT_L(8); PG8_BAR; PG8_WAIT_L(0); PG8_MMA(0, 0, At, B0); PG8_BAR; PG8_SCHED;
            PG8_LDB(B1, 1, 1); PG8_STAGE(PG8_SB(1, 0), b3, voffB);
            PG8_BAR; PG8_WAIT_L(0); PG8_MMA(0, 1, At, B1); PG8_BAR;
            PG8_LDA(At, 1, 1); PG8_STAGE(PG8_SA(1, 0), a3, voffA);
            PG8_BAR; PG8_WAIT_L(0); PG8_MMA(1, 0, At, B0); PG8_BAR; PG8_SCHED;
            PG8_STAGE(PG8_SB(1, 1), b3 + hstep, voffB);
            PG8_WAIT_V(6); PG8_BAR; PG8_MMA(1, 1, At, B1); PG8_BAR;
        }
        E(acc, cur, wr, wc, fr, fq);
        if (!has_next) break;
#pragma unroll
        for (int a = 0; a < 2; ++a)
#pragma unroll
            for (int b = 0; b < 2; ++b)
#pragma unroll
                for (int m = 0; m < 4; ++m)
#pragma unroll
                    for (int n = 0; n < 2; ++n) acc[a][b][m][n] = (f32x4){0.f, 0.f, 0.f, 0.f};
        cur = nxt; cA = nA; cB = nB; ++ui;
    }
    PG8_WAIT_V(0);
    if (wr == 0) PG8_BAR;
    PG8_BAR;
#undef PG8_SA
#undef PG8_SB
#undef PG8_STAGE
#undef PG8_LDA
#undef PG8_LDB
#undef PG8_MMA
#undef PG8_WAIT_V
#undef PG8_WAIT_L
#undef PG8_BAR
#undef PG8_SCHED
}
}
using pg8::Unit;
typedef f32x4 AccT[2][2][4][2];

struct EpiZ {
    static constexpr bool PERM = true;
    u16 *zs, *zg, *qn, *kn, *vt, *gn;
    __device__ __forceinline__ void operator()(const AccT& acc, const Unit& u, int wr, int wc, int fr, int fq) const {
        const int row0 = u.pm * 256 + wr * 64 + fr; const int pn = u.pn;
        if (pn >= 25 && pn < 29) {
            const int cb = (pn - 25) * 256 + wc * 32 + 8 * fq;
#pragma unroll
            for (int ai = 0; ai < 2; ++ai)
#pragma unroll
                for (int m = 0; m < 4; ++m) { const int row = row0 + ai * 128 + m * 16; const int b = row >> 14, tt = row & (SEQ - 1);
#pragma unroll
                    for (int bj = 0; bj < 2; ++bj)
#pragma unroll
                        for (int n = 0; n < 2; ++n)
#pragma unroll
                            for (int j = 0; j < 4; ++j) { const int ch = cb + bj * 128 + 4 * n + j;
                                vt[((size_t)(b * 1024 + ch)) * SEQ + tt] = (u16)(cvt_pk_bf16(acc[ai][bj][m][n][j], 0.f) & 0xffffu); } }
            return;
        }
        u16* base; int ld, colt;
        if (pn < 13) { base = zs; ld = 3328; colt = pn * 256; }
        else if (pn < 17) { base = zg; ld = 1024; colt = (pn - 13) * 256; }
        else if (pn < 21) { base = qn; ld = 1024; colt = (pn - 17) * 256; }
        else if (pn < 25) { base = kn; ld = 1024; colt = (pn - 21) * 256; }
        else { base = gn; ld = 1024; colt = (pn - 29) * 256; }
        const int col0 = colt + wc * 32 + 8 * fq;
#pragma unroll
        for (int ai = 0; ai < 2; ++ai)
#pragma unroll
            for (int m = 0; m < 4; ++m) { u16* rowp = base + (size_t)(row0 + ai * 128 + m * 16) * ld + col0;
#pragma unroll
                for (int bj = 0; bj < 2; ++bj) { const f32x4 v0 = acc[ai][bj][m][0], v1 = acc[ai][bj][m][1];
                    u32x4 w; w.x = cvt_pk_bf16(v0[0], v0[1]); w.y = cvt_pk_bf16(v0[2], v0[3]); w.z = cvt_pk_bf16(v1[0], v1[1]); w.w = cvt_pk_bf16(v1[2], v1[3]);
                    *(u32x4*)(rowp + bj * 128) = w; } }
    }
};
struct EpiBf {
    static constexpr bool PERM = true;
    u16* O; int ld;
    __device__ __forceinline__ void operator()(const AccT& acc, const Unit& u, int wr, int wc, int fr, int fq) const {
        const int row0 = u.pm * 256 + wr * 64 + fr, col0 = u.pn * 256 + wc * 32 + 8 * fq;
#pragma unroll
        for (int ai = 0; ai < 2; ++ai)
#pragma unroll
            for (int m = 0; m < 4; ++m) { u16* rowp = O + (size_t)(row0 + ai * 128 + m * 16) * ld + col0;
#pragma unroll
                for (int bj = 0; bj < 2; ++bj) { const f32x4 v0 = acc[ai][bj][m][0], v1 = acc[ai][bj][m][1];
                    u32x4 w; w.x = cvt_pk_bf16(v0[0], v0[1]); w.y = cvt_pk_bf16(v0[2], v0[3]); w.z = cvt_pk_bf16(v1[0], v1[1]); w.w = cvt_pk_bf16(v1[2], v1[3]);
                    *(u32x4*)(rowp + bj * 128) = w; } }
    }
};
struct EpiLora {
    static constexpr bool PERM = false;
    const float *w0, *a0, *ka; const float* A; const u16* Kb; float *Wd, *Bd, *KD;
    __device__ __forceinline__ void operator()(const AccT& acc, const Unit& u, int wr, int wc, int fr, int fq) const {
        const int row0 = u.pm * 256 + wr * 64 + fr, col0 = u.pn * 256 + wc * 32 + 4 * fq;
        if (u.pn < 4) {
#pragma unroll
            for (int bj = 0; bj < 2; ++bj)
#pragma unroll
                for (int n = 0; n < 2; ++n) { const int col = col0 + bj * 128 + n * 16; const f32x4 wv = *(const f32x4*)(w0 + col);
#pragma unroll
                    for (int ai = 0; ai < 2; ++ai)
#pragma unroll
                        for (int m = 0; m < 4; ++m) { const int row = row0 + ai * 128 + m * 16; f32x4 o;
#pragma unroll
                            for (int j = 0; j < 4; ++j) o[j] = __expf(-DECAY_SCALE * sigmoidf_(wv[j] + acc[ai][bj][m][n][j]));
                            *(f32x4*)(Wd + (size_t)row * RW + col) = o; asm volatile("" ::: "memory"); } }
        } else {
#pragma unroll
            for (int bj = 0; bj < 2; ++bj)
#pragma unroll
                for (int n = 0; n < 2; ++n) { const int col = col0 - 1024 + bj * 128 + n * 16; const f32x4 av0 = *(const f32x4*)(a0 + col), kav = *(const f32x4*)(ka + col);
#pragma unroll
                    for (int ai = 0; ai < 2; ++ai)
#pragma unroll
                        for (int m = 0; m < 4; ++m) { const int row = row0 + ai * 128 + m * 16; const size_t off = (size_t)row * RW + col;
                            const f32x4 aa = *(const f32x4*)(A + off); const u32x2 kw = *(const u32x2*)(Kb + off);
                            const float kf[4] = {bflo(kw.x), bfhi(kw.x), bflo(kw.y), bfhi(kw.y)}; f32x4 ob, ok;
#pragma unroll
                            for (int j = 0; j < 4; ++j) { const float ic = sigmoidf_(av0[j] + acc[ai][bj][m][n][j]); ob[j] = -aa[j] * ic; ok[j] = kf[j] * (1.0f + (ic - 1.0f) * kav[j]); }
                            *(f32x4*)(Bd + off) = ob; *(f32x4*)(KD + off) = ok; asm volatile("" ::: "memory"); } }
        }
    }
};
struct EpiH {
    static constexpr bool PERM = false;
    const float* X; float* H;
    __device__ __forceinline__ void operator()(const AccT& acc, const Unit& u, int wr, int wc, int fr, int fq) const {
        const int row0 = u.pm * 256 + wr * 64 + fr, col0 = u.pn * 256 + wc * 32 + 4 * fq;
#pragma unroll
        for (int ai = 0; ai < 2; ++ai)
#pragma unroll
            for (int m = 0; m < 4; ++m) { const size_t ro = (size_t)(row0 + ai * 128 + m * 16) * DM + col0;
#pragma unroll
                for (int bj = 0; bj < 2; ++bj)
#pragma unroll
                    for (int n = 0; n < 2; ++n) { const size_t o = ro + bj * 128 + n * 16; *(f32x4*)(H + o) = acc[ai][bj][m][n] + *(const f32x4*)(X + o); } asm volatile("" ::: "memory"); }
    }
};
struct EpiGate {
    static constexpr bool PERM = false;
    float* H; const u16* PP;
    __device__ __forceinline__ void operator()(const AccT& acc, const Unit& u, int wr, int wc, int fr, int fq) const {
        const int row0 = u.pm * 256 + wr * 64 + fr, col0 = u.pn * 256 + wc * 32 + 4 * fq;
#pragma unroll
        for (int ai = 0; ai < 2; ++ai)
#pragma unroll
            for (int m = 0; m < 4; ++m) { const size_t ro = (size_t)(row0 + ai * 128 + m * 16) * DM + col0;
#pragma unroll
                for (int bj = 0; bj < 2; ++bj)
#pragma unroll
                    for (int n = 0; n < 2; ++n) { const size_t o = ro + bj * 128 + n * 16; const f32x4 h = *(const f32x4*)(H + o); const u32x2 pw = *(const u32x2*)(PP + o);
                        const f32x4 a = acc[ai][bj][m][n]; f32x4 r;
                        r[0] = h[0] + bflo(pw.x) * sigmoidf_(a[0]); r[1] = h[1] + bfhi(pw.x) * sigmoidf_(a[1]); r[2] = h[2] + bflo(pw.y) * sigmoidf_(a[2]); r[3] = h[3] + bfhi(pw.y) * sigmoidf_(a[3]);
                        *(f32x4*)(H + o) = r; asm volatile("" ::: "memory"); } }
    }
};

template <class Epi> __device__ __forceinline__ void run_gemm(unsigned char* lds, const u16* A, const u16* Bt, int M, int N, int K, const Epi& E) {
    pg8::Gemm g; g.A = A; g.Bt = Bt; g.M = M; g.N = N; g.K = K;
    pg8::StaticOrder S; S.init(M, N, gridDim.x, blockIdx.x);
    pg8::gemm_phase<Epi>((LAS unsigned char*)lds, g, S, E);
    __syncthreads();
}

__device__ __forceinline__ void transpose_cvt(const float* __restrict__ src, int K, int N, u16* __restrict__ dst, int ldd, float* tile) {
    const int tid = threadIdx.x, tn = N / 64, ntile = (K / 64) * tn;
    for (int t = blockIdx.x; t < ntile; t += gridDim.x) {
        const int k0 = (t / tn) * 64, n0 = (t % tn) * 64;
#pragma unroll
        for (int ps = 0; ps < 2; ++ps) { const int r = (tid >> 4) + ps * 32, c4 = (tid & 15) * 4; const f32x4 v = *(const f32x4*)(src + (size_t)(k0 + r) * N + n0 + c4);
            tile[r * 65 + c4] = v[0]; tile[r * 65 + c4 + 1] = v[1]; tile[r * 65 + c4 + 2] = v[2]; tile[r * 65 + c4 + 3] = v[3]; }
        __syncthreads();
        { const int n = tid >> 3, ks = (tid & 7) * 8; u32x4 w;
          w.x = cvt_pk_bf16(tile[(ks + 0) * 65 + n], tile[(ks + 1) * 65 + n]); w.y = cvt_pk_bf16(tile[(ks + 2) * 65 + n], tile[(ks + 3) * 65 + n]);
          w.z = cvt_pk_bf16(tile[(ks + 4) * 65 + n], tile[(ks + 5) * 65 + n]); w.w = cvt_pk_bf16(tile[(ks + 6) * 65 + n], tile[(ks + 7) * 65 + n]);
          *(u32x4*)(dst + (size_t)(n0 + n) * ldd + k0 + ks) = w; }
        __syncthreads();
    }
}
__device__ __forceinline__ void build_wlt(const Params& p) {
    u16* W = (u16*)(p.ws + O_WLT);
    for (int i = blockIdx.x * NTHREADS + threadIdx.x; i < 2 * 2048 * 256; i += gridDim.x * NTHREADS) {
        const int k = i & 255, n = (i >> 8) & 2047, d = i >> 19; float v = 0.f;
        if (n < 1024) { if ((k >> 6) == d) v = p.decay_w2[((size_t)d * 64 + (k & 63)) * RW + n]; }
        else { if ((k >> 6) == 2 + d) v = p.iclr_a2[((size_t)d * 64 + (k & 63)) * RW + (n - 1024)]; }
        W[i] = (u16)(cvt_pk_bf16(v, 0.f) & 0xffffu);
    }
}
template <bool BF> __device__ __forceinline__ void rownorm(const float* src, const float* __restrict__ g, void* dst) {
    const int lane = threadIdx.x & 63, wid = threadIdx.x >> 6;
    for (int row = blockIdx.x * 8 + wid; row < NTOK; row += gridDim.x * 8) {
        const float* s = src + (size_t)row * DM + lane * 4; f32x4 v[8]; float ss = 0.f;
#pragma unroll
        for (int i = 0; i < 8; ++i) { v[i] = *(const f32x4*)(s + i * 256); ss += v[i][0] * v[i][0] + v[i][1] * v[i][1] + v[i][2] * v[i][2] + v[i][3] * v[i][3]; }
#pragma unroll
        for (int o = 32; o >= 1; o >>= 1) ss += __shfl_xor(ss, o);
        const float sc = rsqrtf(ss * (1.0f / DM) + 1e-6f);
#pragma unroll
        for (int i = 0; i < 8; ++i) { const f32x4 gv = *(const f32x4*)(g + lane * 4 + i * 256); const f32x4 o = v[i] * sc * gv;
            if (BF) { u32x2 w; w.x = cvt_pk_bf16(o[0], o[1]); w.y = cvt_pk_bf16(o[2], o[3]); *(u32x2*)((u16*)dst + (size_t)row * DM + lane * 4 + i * 256) = w; }
            else *(f32x4*)((float*)dst + (size_t)row * DM + lane * 4 + i * 256) = o; }
    }
}

__device__ __forceinline__ void ld16bf(const u16* p, float* o) {
    const u32x4 a = *(const u32x4*)p, b = *(const u32x4*)(p + 8);
    o[0] = bflo(a.x); o[1] = bfhi(a.x); o[2] = bflo(a.y); o[3] = bfhi(a.y); o[4] = bflo(a.z); o[5] = bfhi(a.z); o[6] = bflo(a.w); o[7] = bfhi(a.w);
    o[8] = bflo(b.x); o[9] = bfhi(b.x); o[10] = bflo(b.y); o[11] = bfhi(b.y); o[12] = bflo(b.z); o[13] = bfhi(b.z); o[14] = bflo(b.w); o[15] = bfhi(b.w);
}
__device__ __forceinline__ void st16bf(u16* p, const float* v) {
    u32x4 a, b; a.x = cvt_pk_bf16(v[0], v[1]); a.y = cvt_pk_bf16(v[2], v[3]); a.z = cvt_pk_bf16(v[4], v[5]); a.w = cvt_pk_bf16(v[6], v[7]);
    b.x = cvt_pk_bf16(v[8], v[9]); b.y = cvt_pk_bf16(v[10], v[11]); b.z = cvt_pk_bf16(v[12], v[13]); b.w = cvt_pk_bf16(v[14], v[15]);
    *(u32x4*)p = a; *(u32x4*)(p + 8) = b;
}
__device__ __forceinline__ void shift16(const u16* zc, bool hp, bool hn, const float* __restrict__ mp, const float* __restrict__ mn, int c, float* o) {
    float z[16], zp[16], zn[16]; ld16bf(zc + c, z);
    if (hp) ld16bf(zc - 3328 + c, zp); else {
#pragma unroll
        for (int j = 0; j < 16; ++j) zp[j] = 0.f; }
    if (hn) ld16bf(zc + 3328 + c, zn); else {
#pragma unroll
        for (int j = 0; j < 16; ++j) zn[j] = 0.f; }
#pragma unroll
    for (int j4 = 0; j4 < 4; ++j4) { const f32x4 a = *(const f32x4*)(mp + c + j4 * 4), b = *(const f32x4*)(mn + c + j4 * 4);
#pragma unroll
        for (int j = 0; j < 4; ++j) { const int q = j4 * 4 + j; o[q] = z[q] + a[j] * (zp[q] - z[q]) + b[j] * (zn[q] - z[q]); } }
}
__device__ __forceinline__ void prep_phase(const Params& p) {
    const int lane = threadIdx.x & 63, wid = threadIdx.x >> 6;
    const u16* ZS = (const u16*)(p.ws + O_ZS);
    float* R = (float*)(p.ws + O_R); float* A = (float*)(p.ws + O_A); u16* V = (u16*)(p.ws + O_V); u16* Kb = (u16*)(p.ws + O_K); u16* AL = (u16*)(p.ws + O_AL); float* BON = (float*)(p.ws + O_BON);
    for (int t = blockIdx.x * 8 + wid; t < NTOK; t += gridDim.x * 8) {
        const int tt = t & (SEQ - 1); const bool hp = tt > 0, hn = tt < SEQ - 1;
        const u16* zc = ZS + (size_t)t * 3328; const int c = lane * 16;
        float r[16], k[16], v[16];
        shift16(zc, hp, hn, p.mu_prev, p.mu_next, c, r);
        shift16(zc, hp, hn, p.mu_prev, p.mu_next, 1024 + c, k);
        shift16(zc, hp, hn, p.mu_prev, p.mu_next, 2048 + c, v);
        float kk[16], s2 = 0.f, bs = 0.f;
#pragma unroll
        for (int j4 = 0; j4 < 4; ++j4) { const f32x4 kkv = *(const f32x4*)(p.k_k + c + j4 * 4), rkv = *(const f32x4*)(p.r_k + c + j4 * 4);
#pragma unroll
            for (int j = 0; j < 4; ++j) { const int q = j4 * 4 + j; kk[q] = k[q] * kkv[j]; s2 += kk[q] * kk[q]; bs += r[q] * k[q] * rkv[j]; } }
        s2 += __shfl_xor(s2, 1); s2 += __shfl_xor(s2, 2); bs += __shfl_xor(bs, 1); bs += __shfl_xor(bs, 2);
        const float inv = -1.0f / fmaxf(sqrtf(s2), 1e-12f);
        const size_t o = (size_t)t * RW + c;
#pragma unroll
        for (int j4 = 0; j4 < 4; ++j4) { *(f32x4*)(R + o + j4 * 4) = (f32x4){r[j4 * 4], r[j4 * 4 + 1], r[j4 * 4 + 2], r[j4 * 4 + 3]};
            *(f32x4*)(A + o + j4 * 4) = (f32x4){kk[j4 * 4] * inv, kk[j4 * 4 + 1] * inv, kk[j4 * 4 + 2] * inv, kk[j4 * 4 + 3] * inv}; }
        st16bf(Kb + o, k); st16bf(V + o, v);
        if ((lane & 3) == 0) BON[(size_t)t * 16 + (lane >> 2)] = bs;
        { const int cl = 3072 + lane * 4; const u32x2 zw = *(const u32x2*)(zc + cl); u32x2 pw = {0u, 0u}, nw = {0u, 0u};
          if (hp) pw = *(const u32x2*)(zc - 3328 + cl); if (hn) nw = *(const u32x2*)(zc + 3328 + cl);
          const f32x4 a = *(const f32x4*)(p.mu_prev + cl), b = *(const f32x4*)(p.mu_next + cl);
          const float z4[4] = {bflo(zw.x), bfhi(zw.x), bflo(zw.y), bfhi(zw.y)}, p4[4] = {bflo(pw.x), bfhi(pw.x), bflo(pw.y), bfhi(pw.y)}, n4[4] = {bflo(nw.x), bfhi(nw.x), bflo(nw.y), bfhi(nw.y)};
          float o4[4];
#pragma unroll
          for (int j = 0; j < 4; ++j) { float s = z4[j] + a[j] * (p4[j] - z4[j]) + b[j] * (n4[j] - z4[j]); o4[j] = (lane < 32) ? tanhf(s) : s; }
          u32x2 w; w.x = cvt_pk_bf16(o4[0], o4[1]); w.y = cvt_pk_bf16(o4[2], o4[3]); *(u32x2*)(AL + (size_t)t * 256 + lane * 4) = w; }
    }
}

__device__ __forceinline__ void nat_phase(const Params& p, float* ldsf) {
    const int lane = threadIdx.x & 63, wid = __builtin_amdgcn_readfirstlane(threadIdx.x >> 6), l15 = lane & 15, lq = lane >> 4;
    const u16* Qn = (const u16*)p.out; const u16* Kn = Qn + (size_t)NTOK * RW; const u16* VT = Kn + (size_t)NTOK * RW; const u16* Gn = VT + (size_t)NTOK * RW;
    u16* MIX = (u16*)(p.ws + O_HN);
    for (int item = blockIdx.x * 8 + wid; item < 8192; item += gridDim.x * 8) {
        const int r = item & 255, h = (item >> 8) & 15, b = item >> 12;
        const int rs = min(max(r - 4, 0), 248);
        const u16* Qb = Qn + (size_t)(b * SEQ + r * 64) * RW + h * 64;
        const u16* Kb = Kn + (size_t)(b * SEQ + rs * 64) * RW + h * 64;
        const u16* Vb = VT + (size_t)((b * 16 + h) * 64) * SEQ + rs * 64;
        float* tb = ldsf + wid * 256;
        { const float* rpb = p.rpb + h * 465 + (rs - r + 7) * 31;
#pragma unroll
          for (int q = 0; q < 4; ++q) { const int e = lane + q * 64; if (e < 248) tb[e] = rpb[e]; } }
#pragma unroll 1
        for (int qt = 0; qt < 4; ++qt) {
            const int c0 = qt * 16, cs0 = (qt == 0) ? 0 : (qt == 1 ? 8 : (qt == 2 ? 24 : 32));
            const int c = c0 + l15, csq = min(max(c - 8, 0), 48);
            const bf16x8 bq0 = *(const bf16x8*)(Qb + (size_t)c * RW + lq * 8), bq1 = *(const bf16x8*)(Qb + (size_t)c * RW + 32 + lq * 8);
            f32x4 sc[8][2];
#pragma unroll
            for (int i = 0; i < 8; ++i)
#pragma unroll
                for (int hf = 0; hf < 2; ++hf) { const u16* kp = Kb + (size_t)(i * 64 + cs0 + (l15 >> 2) * 8 + hf * 4 + (l15 & 3)) * RW + lq * 8;
                    const bf16x8 a0 = *(const bf16x8*)kp, a1 = *(const bf16x8*)(kp + 32); f32x4 z = {0.f, 0.f, 0.f, 0.f};
                    z = __builtin_amdgcn_mfma_f32_16x16x32_bf16(a0, bq0, z, 0, 0, 0); z = __builtin_amdgcn_mfma_f32_16x16x32_bf16(a1, bq1, z, 0, 0, 0); sc[i][hf] = z; }
            float mx = -1e30f;
#pragma unroll
            for (int i = 0; i < 8; ++i)
#pragma unroll
                for (int hf = 0; hf < 2; ++hf)
#pragma unroll
                    for (int j = 0; j < 4; ++j) { const int kc = cs0 + lq * 8 + hf * 4 + j; const bool valid = (kc >= csq) && (kc < csq + 16); const int bc = valid ? (kc - c + 15) : 0;
                        const float s = valid ? sc[i][hf][j] * 0.125f + tb[i * 31 + bc] : -1e30f; sc[i][hf][j] = s; mx = fmaxf(mx, s); }
            mx = fmaxf(mx, __shfl_xor(mx, 16)); mx = fmaxf(mx, __shfl_xor(mx, 32));
            float sum = 0.f;
#pragma unroll
            for (int i = 0; i < 8; ++i)
#pragma unroll
                for (int hf = 0; hf < 2; ++hf)
#pragma unroll
                    for (int j = 0; j < 4; ++j) { const float e = __expf(sc[i][hf][j] - mx); sc[i][hf][j] = e; sum += e; }
            sum += __shfl_xor(sum, 16); sum += __shfl_xor(sum, 32);
            const float inv = 1.0f / sum;
            f32x4 o[4];
#pragma unroll
            for (int mt = 0; mt < 4; ++mt) o[mt] = (f32x4){0.f, 0.f, 0.f, 0.f};
#pragma unroll
            for (int i = 0; i < 8; ++i) {
                u32x4 pw; pw.x = cvt_pk_bf16(sc[i][0][0] * inv, sc[i][0][1] * inv); pw.y = cvt_pk_bf16(sc[i][0][2] * inv, sc[i][0][3] * inv);
                pw.z = cvt_pk_bf16(sc[i][1][0] * inv, sc[i][1][1] * inv); pw.w = cvt_pk_bf16(sc[i][1][2] * inv, sc[i][1][3] * inv);
                const bf16x8 bp = __builtin_bit_cast(bf16x8, pw);
#pragma unroll
                for (int mt = 0; mt < 4; ++mt) { const u16* vp = Vb + (size_t)(mt * 16 + l15) * SEQ + i * 64 + cs0 + lq * 8;
                    o[mt] = __builtin_amdgcn_mfma_f32_16x16x32_bf16(*(const bf16x8*)vp, bp, o[mt], 0, 0, 0); }
            }
            const size_t tok = (size_t)(b * SEQ + r * 64 + c);
#pragma unroll
            for (int mt = 0; mt < 4; ++mt) { const int ch = h * 64 + mt * 16 + lq * 4; const u32x2 gw = *(const u32x2*)(Gn + tok * RW + ch);
                const float g0 = bflo(gw.x), g1 = bfhi(gw.x), g2 = bflo(gw.y), g3 = bfhi(gw.y);
                u32x2 w; w.x = cvt_pk_bf16(o[mt][0] * g0 * sigmoidf_(g0), o[mt][1] * g1 * sigmoidf_(g1)); w.y = cvt_pk_bf16(o[mt][2] * g2 * sigmoidf_(g2), o[mt][3] * g3 * sigmoidf_(g3));
                *(u32x2*)(MIX + tok * DM + 1024 + ch) = w; }
        }
    }
}

template <int N> __device__ __forceinline__ void fmac_bc(float& d, float bsrc, float o) { asm volatile("v_fmac_f32_dpp %0, %1, %2 row_newbcast:%3 row_mask:0xf bank_mask:0xf" : "+v"(d) : "v"(bsrc), "v"(o), "n"(N)); }
template <int N> __device__ __forceinline__ float mul_bc(float bsrc, float o) { float d; asm volatile("v_mul_f32_dpp %0, %1, %2 row_newbcast:%3 row_mask:0xf bank_mask:0xf" : "=v"(d) : "v"(bsrc), "v"(o), "n"(N)); return d; }
struct In1 { f32x4 w, a, b, kd; unsigned v; };
struct In2 { f32x4 w, a, b, kd, r; unsigned v; float yo; };
#define BC(x, k) x[(k) & 3]
template <int K> struct ScanK {
    static constexpr int N0 = K >> 2, N1 = (K + 1) >> 2;
    static __device__ __forceinline__ void dot(const float (&S)[64], const f32x4& a, float& s0, float& s1) {
        fmac_bc<N0>(s0, BC(a, K), S[K]); fmac_bc<N1>(s1, BC(a, K + 1), S[K + 1]);
        if constexpr (K + 2 < 64) ScanK<K + 2>::dot(S, a, s0, s1);
    }
    static __device__ __forceinline__ void upd(float (&S)[64], const In2& in, float sa, float vv, float& y0, float& y1) {
        float t0 = mul_bc<N0>(BC(in.kd, K), vv); float t1 = mul_bc<N1>(BC(in.kd, K + 1), vv);
        fmac_bc<N0>(t0, BC(in.w, K), S[K]); fmac_bc<N1>(t1, BC(in.w, K + 1), S[K + 1]);
        fmac_bc<N0>(t0, BC(in.b, K), sa); fmac_bc<N1>(t1, BC(in.b, K + 1), sa);
        S[K] = t0; S[K + 1] = t1;
        fmac_bc<N0>(y0, BC(in.r, K), t0); fmac_bc<N1>(y1, BC(in.r, K + 1), t1);
        if constexpr (K + 2 < 64) ScanK<K + 2>::upd(S, in, sa, vv, y0, y1);
    }
    static __device__ __forceinline__ void updS(float (&S)[64], const In1& in, float sa, float vv) {
        float t0 = mul_bc<N0>(BC(in.kd, K), vv); float t1 = mul_bc<N1>(BC(in.kd, K + 1), vv);
        fmac_bc<N0>(t0, BC(in.w, K), S[K]); fmac_bc<N1>(t1, BC(in.w, K + 1), S[K + 1]);
        fmac_bc<N0>(t0, BC(in.b, K), sa); fmac_bc<N1>(t1, BC(in.b, K + 1), sa);
        S[K] = t0; S[K + 1] = t1;
        if constexpr (K + 2 < 64) ScanK<K + 2>::updS(S, in, sa, vv);
    }
    static __device__ __forceinline__ void updP(float (&P)[64], const In1& in, float sa) {
        float u0 = mul_bc<N0>(BC(in.w, K), P[K]); float u1 = mul_bc<N1>(BC(in.w, K + 1), P[K + 1]);
        fmac_bc<N0>(u0, BC(in.b, K), sa); fmac_bc<N1>(u1, BC(in.b, K + 1), sa);
        P[K] = u0; P[K + 1] = u1;
        if constexpr (K + 2 < 64) ScanK<K + 2>::updP(P, in, sa);
    }
};
__device__ __forceinline__ void scan_pass1(const Params& p, int d) {
    const int lane = threadIdx.x & 63, wid = __builtin_amdgcn_readfirstlane(threadIdx.x >> 6); const unsigned lo16 = (lane & 15) * 16, lo2 = lane * 2;
    const float* Wd = p.out; const float* Bd = p.out + (size_t)NTOK * RW; const float* KD = (const float*)(p.ws + O_KD); const float* A = (const float*)(p.ws + O_A);
    const u16* V = (const u16*)(p.ws + O_V); float* PT = (float*)(p.ws + O_PT); float* SLT = (float*)(p.ws + O_SLT);
    constexpr int NS = 32 * (NC - 1);
    for (int item = blockIdx.x * 8 + wid; item < 2 * NS; item += gridDim.x * 8) {
        const bool isP = item >= NS; const int idx = isP ? item - NS : item;
        const int bh = idx / (NC - 1), c = idx - bh * (NC - 1), b = bh >> 4, h = bh & 15;
        const int t0 = d ? (SEQ - 1 - c * LC) : c * LC;
        const size_t off0 = ((size_t)(b * SEQ + t0)) * RW + h * 64; const long stp = d ? -(long)RW : (long)RW;
        const float *wq = Wd + off0, *aq = A + off0, *bq = Bd + off0, *kq = KD + off0; const u16* vq = V + off0;
        float S[64]; int ln = lane; asm volatile("" : "+v"(ln));
#define SB __builtin_amdgcn_sched_barrier(0)
#define LDX(base, o_) (*(const f32x4*)((const char*)((base) + (o_)) + lo16))
        if (!isP) {
#pragma unroll
            for (int i = 0; i < 64; ++i) S[i] = 0.f;
#define LD1(set, s) { const long o_ = (long)min((int)(s), LC - 1) * stp; set.w = LDX(wq, o_); set.a = LDX(aq, o_); set.b = LDX(bq, o_); set.kd = LDX(kq, o_); set.v = *(const u16*)((const char*)(vq + o_) + lo2); }
#define TOUCH1(set) asm volatile("" :: "v"(set.w), "v"(set.a), "v"(set.b), "v"(set.kd), "v"(set.v))
#define ST1(set) { float s0 = 0.f, s1 = 0.f; ScanK<0>::dot(S, set.a, s0, s1); ScanK<0>::updS(S, set, s0 + s1, __uint_as_float(set.v << 16)); }
            In1 i0, i1; LD1(i0, 0);
#pragma unroll 1
            for (int s = 0; s < LC; s += 2) { TOUCH1(i0); SB; LD1(i1, s + 1); SB; ST1(i0); TOUCH1(i1); SB; LD1(i0, s + 2); SB; ST1(i1); }
#undef LD1
#undef TOUCH1
#undef ST1
        } else {
#pragma unroll
            for (int i = 0; i < 64; ++i) S[i] = (ln == i) ? 1.f : 0.f;
#define LD1(set, s) { const long o_ = (long)min((int)(s), LC - 1) * stp; set.w = LDX(wq, o_); set.a = LDX(aq, o_); set.b = LDX(bq, o_); }
#define TOUCH1(set) asm volatile("" :: "v"(set.w), "v"(set.a), "v"(set.b))
#define ST1(set) { float s0 = 0.f, s1 = 0.f; ScanK<0>::dot(S, set.a, s0, s1); ScanK<0>::updP(S, set, s0 + s1); }
            In1 i0, i1; LD1(i0, 0);
#pragma unroll 1
            for (int s = 0; s < LC; s += 2) { TOUCH1(i0); SB; LD1(i1, s + 1); SB; ST1(i0); TOUCH1(i1); SB; LD1(i0, s + 2); SB; ST1(i1); }
#undef LD1
#undef TOUCH1
#undef ST1
        }
        float* po = (isP ? PT : SLT) + ((size_t)(bh * NC + c)) * 4096 + lane;
#pragma unroll
        for (int i = 0; i < 64; ++i) { *po = S[i]; po += 64; asm volatile("" : "+v"(po)); }
    }
}
__device__ __forceinline__ void scan_combine(const Params& p, float* sl) {
    const int tid = threadIdx.x, vl = tid & 7, k = tid >> 3;
    const float* PT = (const float*)(p.ws + O_PT); const float* SLT = (const float*)(p.ws + O_SLT); float* SIT = (float*)(p.ws + O_SIT);
    for (int item = blockIdx.x; item < 256; item += gridDim.x) {
        const int bh = item >> 3, g = item & 7;
        const float* pt = PT + (size_t)bh * NC * 4096 + k * 64; const float* st = SLT + (size_t)bh * NC * 4096 + k * 64 + g * 8 + vl; float* si = SIT + (size_t)bh * NC * 4096 + k * 64 + g * 8 + vl;
        __syncthreads();
        sl[tid] = 0.f;
        f32x4 Pa[16], Pb[16]; float sla = st[0], slb = 0.f;
#pragma unroll
        for (int i = 0; i < 16; ++i) Pa[i] = *(const f32x4*)(pt + i * 4);
        __syncthreads();
#define CSTEP(Pc, slcur, Pnx, slnx, c) { \
            if ((c) + 1 < NC - 1) { slnx = st[(size_t)((c) + 1) * 4096]; \
                _Pragma("unroll") for (int i = 0; i < 16; ++i) Pnx[i] = *(const f32x4*)(pt + (size_t)((c) + 1) * 4096 + i * 4); } \
            float acc = slcur; \
            _Pragma("unroll") for (int i = 0; i < 16; ++i) { const f32x4 sv = *(const f32x4*)(sl + vl * 64 + i * 4); acc += sv[0] * Pc[i][0] + sv[1] * Pc[i][1] + sv[2] * Pc[i][2] + sv[3] * Pc[i][3]; } \
            __syncthreads(); \
            sl[vl * 64 + k] = acc; si[(size_t)((c) + 1) * 4096] = acc; \
            __syncthreads(); }
#pragma unroll 1
        for (int c = 0; c < NC - 1; c += 2) {
            CSTEP(Pa, sla, Pb, slb, c);
            if (c + 1 < NC - 1) CSTEP(Pb, slb, Pa, sla, c + 1);
        }
#undef CSTEP
    }
}
__device__ __forceinline__ void scan_pass2(const Params& p, int d) {
    const int lane = threadIdx.x & 63, wid = __builtin_amdgcn_readfirstlane(threadIdx.x >> 6); const unsigned lo16 = (lane & 15) * 16, lo2 = lane * 2, lo4b = lane * 4;
    const float* Wd = p.out; const float* Bd = p.out + (size_t)NTOK * RW; const float* KD = (const float*)(p.ws + O_KD); const float* A = (const float*)(p.ws + O_A); const float* R = (const float*)(p.ws + O_R);
    const u16* V = (const u16*)(p.ws + O_V); const float* SIT = (const float*)(p.ws + O_SIT); float* Y = (float*)(p.ws + O_Y);
    for (int item = blockIdx.x * 8 + wid; item < 32 * NC; item += gridDim.x * 8) {
        const int bh = item / NC, c = item - bh * NC, b = bh >> 4, h = bh & 15;
        const int t0 = d ? (SEQ - 1 - c * LC) : c * LC;
        const size_t off0 = ((size_t)(b * SEQ + t0)) * RW + h * 64; const long stp = d ? -(long)RW : (long)RW;
        const float *wq = Wd + off0, *aq = A + off0, *bq = Bd + off0, *kq = KD + off0, *rq = R + off0; const u16* vq = V + off0; float* yq = Y + off0;
        float S[64];
        if (c == 0) {
#pragma unroll
            for (int i = 0; i < 64; ++i) S[i] = 0.f;
        } else { const float* si = SIT + ((size_t)(bh * NC + c)) * 4096 + lane;
#pragma unroll
            for (int i = 0; i < 64; ++i) { S[i] = *si; si += 64; asm volatile("" : "+v"(si)); } }
#define LD2(set, s) { const long o_ = (long)min((int)(s), LC - 1) * stp; set.w = LDX(wq, o_); set.a = LDX(aq, o_); set.b = LDX(bq, o_); set.kd = LDX(kq, o_); \
            set.r = LDX(rq, o_); set.v = *(const u16*)((const char*)(vq + o_) + lo2); set.yo = d ? *(const float*)((const char*)(yq + o_) + lo4b) : 0.f; }
#define ST2(set, s) { float s0 = 0.f, s1 = 0.f; ScanK<0>::dot(S, set.a, s0, s1); float y0 = set.yo, y1 = 0.f; ScanK<0>::upd(S, set, s0 + s1, __uint_as_float(set.v << 16), y0, y1); *(float*)((char*)(yq + (long)(s) * stp) + lo4b) = y0 + y1; }
#define TOUCH2(set) asm volatile("" :: "v"(set.w), "v"(set.a), "v"(set.b), "v"(set.kd), "v"(set.r), "v"(set.v), "v"(set.yo))
        In2 i0, i1; LD2(i0, 0);
#pragma unroll 1
        for (int s = 0; s < LC; s += 2) { TOUCH2(i0); SB; LD2(i1, s + 1); SB; ST2(i0, s); TOUCH2(i1); SB; LD2(i0, s + 2); SB; ST2(i1, s + 1); }
#undef LD2
#undef ST2
    }
}

__device__ __forceinline__ void post_phase(const Params& p) {
    const int lane = threadIdx.x & 63, wid = threadIdx.x >> 6;
    const float* Y = (const float*)(p.ws + O_Y); const u16* V = (const u16*)(p.ws + O_V); const u16* ZG = (const u16*)(p.ws + O_ZG); const float* BON = (const float*)(p.ws + O_BON);
    u16* MIX = (u16*)(p.ws + O_HN); u16* PB = (u16*)(p.ws + O_AL);
    for (int t = blockIdx.x * 8 + wid; t < NTOK; t += gridDim.x * 8) {
        const int c = lane * 16; const size_t o = (size_t)t * RW + c;
        float y[16], v[16], g[16]; float s = 0.f;
#pragma unroll
        for (int j4 = 0; j4 < 4; ++j4) { const f32x4 a = *(const f32x4*)(Y + o + j4 * 4); y[j4 * 4] = a[0]; y[j4 * 4 + 1] = a[1]; y[j4 * 4 + 2] = a[2]; y[j4 * 4 + 3] = a[3]; s += a[0] + a[1] + a[2] + a[3]; }
        ld16bf(V + o, v); ld16bf(ZG + o, g);
        s += __shfl_xor(s, 1); s += __shfl_xor(s, 2); const float mu = s * (1.0f / 64.0f);
        float q = 0.f;
#pragma unroll
        for (int j = 0; j < 16; ++j) { y[j] -= mu; q += y[j] * y[j]; }
        q += __shfl_xor(q, 1); q += __shfl_xor(q, 2); const float rs = rsqrtf(q * (1.0f / 64.0f) + 64e-5f);
        const float bon = BON[(size_t)t * 16 + (lane >> 2)];
        float outv[16];
#pragma unroll
        for (int j4 = 0; j4 < 4; ++j4) { const f32x4 lw = *(const f32x4*)(p.lnx_w + c + j4 * 4), lb = *(const f32x4*)(p.lnx_b + c + j4 * 4);
#pragma unroll
            for (int j = 0; j < 4; ++j) { const int i = j4 * 4 + j; const float yn = y[i] * rs * lw[j] + lb[j]; outv[i] = (yn + bon * v[i]) * g[i] * sigmoidf_(g[i]); } }
        st16bf(MIX + (size_t)t * DM + c, outv);
        { const f32x4 pv = *(const f32x4*)(p.p + (size_t)t * 256 + lane * 4); u32x2 w; w.x = cvt_pk_bf16(pv[0], pv[1]); w.y = cvt_pk_bf16(pv[2], pv[3]); *(u32x2*)(PB + (size_t)t * 256 + lane * 4) = w; }
    }
}

#define XB_TMO      128
#define XB_XCNT(j)  (256  + 64 * (j))
#define XB_XSUB(j)  (1280 + 64 * (j))
#define XB_XGEN(j)  (2304 + 64 * (j))
#define XB_TOP      3328
#define XB_TOPGEN   3392
#define XCD_BAR_WORDS 3456
#define XB_SPIN_CAP (1u << 18)
__device__ __forceinline__ unsigned xb_ld(unsigned* p)              { return __hip_atomic_load(p, __ATOMIC_RELAXED, __HIP_MEMORY_SCOPE_AGENT); }
__device__ __forceinline__ unsigned xb_add(unsigned* p, unsigned v) { return __hip_atomic_fetch_add(p, v, __ATOMIC_RELAXED, __HIP_MEMORY_SCOPE_AGENT); }
__device__ __forceinline__ unsigned xb_xcc_id() { return (unsigned)__builtin_amdgcn_s_getreg((3 << 11) | 20) & 0xFu; }
#define XB_SPIN(cond, bar) do { unsigned _sp = 0; while (cond) { __builtin_amdgcn_s_sleep(1); \
    if ((++_sp & 255u) == 0u) { if (xb_ld(&(bar)[XB_TMO])) break; if (_sp > XB_SPIN_CAP) { atomicAdd(&(bar)[XB_TMO], 1u); break; } } } } while (0)
struct XcdBarrier { unsigned* bar; unsigned x; volatile LAS unsigned* st; };
__device__ __forceinline__ XcdBarrier xcd_barrier_post(unsigned* bar, volatile LAS unsigned* st) {
    XcdBarrier b; b.bar = bar; b.x = xb_xcc_id(); b.st = st;
    if (threadIdx.x == 0) (void)xb_add(&bar[XB_XCNT(b.x)], 1u);
    return b;
}
__device__ __forceinline__ void xcd_barrier_complete(unsigned* bar, unsigned x, unsigned& nloc, unsigned& nx) {
    const unsigned G = gridDim.x * gridDim.y * gridDim.z;
    unsigned sum, cnt, mine, sp = 0u;
    for (;;) {
        sum = 0u; cnt = 0u; mine = 0u;
#pragma unroll
        for (unsigned j = 0; j < 16; ++j) { const unsigned c = xb_ld(&bar[XB_XCNT(j)]); sum += c; cnt += (c > 0u) ? 1u : 0u; mine = (j == x) ? c : mine; }
        if (sum == G) break;
        __builtin_amdgcn_s_sleep(1);
        if ((++sp & 255u) == 0u) { if (xb_ld(&bar[XB_TMO])) break; if (sp > XB_SPIN_CAP) { atomicAdd(&bar[XB_TMO], 1u); break; } }
    }
    nloc = mine > 0u ? mine : 1u; nx = cnt > 0u ? cnt : 1u;
}
__device__ __forceinline__ void xcd_barrier(const XcdBarrier& b) {
    asm volatile("s_waitcnt vmcnt(0)" ::: "memory");
    __syncthreads();
    if (threadIdx.x == 0) {
        unsigned* bar = b.bar;
        __builtin_amdgcn_s_waitcnt(0);
        unsigned nloc = b.st[0], nx = b.st[1];
        if (nloc == 0u) { xcd_barrier_complete(bar, b.x, nloc, nx); b.st[0] = nloc; b.st[1] = nx; }
        const unsigned old = xb_add(&bar[XB_XSUB(b.x)], 1u);
        const unsigned gen = old / nloc;
        if (old + 1u == (gen + 1u) * nloc) {
            __builtin_amdgcn_fence(__ATOMIC_RELEASE, "agent");
            asm volatile("s_waitcnt vmcnt(0)" ::: "memory");
            const unsigned og = xb_add(&bar[XB_TOP], 1u);
            const unsigned tg = og / nx;
            if (og + 1u == (tg + 1u) * nx) xb_add(&bar[XB_TOPGEN], 1u);
            else XB_SPIN(xb_ld(&bar[XB_TOPGEN]) == tg, bar);
            __builtin_amdgcn_fence(__ATOMIC_ACQUIRE, "agent");
            xb_add(&bar[XB_XGEN(b.x)], 1u);
            asm volatile("s_waitcnt vmcnt(0)" ::: "memory");
        } else {
            XB_SPIN(xb_ld(&bar[XB_XGEN(b.x)]) == gen, bar);
            __builtin_amdgcn_fence(__ATOMIC_ACQUIRE, "agent");
            asm volatile("s_waitcnt vmcnt(0)" ::: "memory");
        }
    }
    __syncthreads();
}

__global__ void __launch_bounds__(NTHREADS, 2) mega(Params p) {
    extern __shared__ __attribute__((aligned(16))) unsigned char lds[];
    cg::grid_group grid = cg::this_grid();
    unsigned char* ws = p.ws;
    volatile LAS unsigned* xbw = (volatile LAS unsigned*)((LAS unsigned char*)lds + LDS_XB);
    if (threadIdx.x < 4) xbw[threadIdx.x] = 0u;
    __syncthreads();
    const XcdBarrier xbar = xcd_barrier_post((unsigned*)(ws + O_BAR), xbw);
#define PH_ON(n) (p.ph_lo <= (n) && (n) < p.ph_hi)
#define PH_END(n) do { if ((n) + 1 < p.ph_hi) { if ((n) == 0) grid.sync(); else xcd_barrier(xbar); } } while (0)
#ifndef PROBE_PH
#define PROBE_PH -1
#endif
#define RUN(n, ...) if (PH_ON(n)) { __VA_ARGS__ if (PROBE_PH == (n)) { __syncthreads(); __VA_ARGS__ } PH_END(n); }
    RUN(0,
        transpose_cvt(p.w_in, 2048, 8448, (u16*)(ws + O_W1T), 2048, (float*)lds);
        transpose_cvt(p.w_out, 2048, 2048, (u16*)(ws + O_W2T), 2048, (float*)lds);
        transpose_cvt(p.w_ple_gate, 2048, 2048, (u16*)(ws + O_W3T), 2048, (float*)lds);
        transpose_cvt(p.w_ple_proj, 256, 2048, (u16*)(ws + O_WPT), 256, (float*)lds);
        build_wlt(p);
        rownorm<true>(p.x, p.norm_mix_g, ws + O_HN);)
    RUN(1, {
        EpiZ e; e.zs = (u16*)(ws + O_ZS); e.zg = (u16*)(ws + O_ZG); e.qn = (u16*)p.out; e.kn = e.qn + (size_t)NTOK * RW; e.vt = e.kn + (size_t)NTOK * RW; e.gn = e.vt + (size_t)NTOK * RW;
        run_gemm(lds, (const u16*)(ws + O_HN), (const u16*)(ws + O_W1T), NTOK, 8448, 2048, e); })
    RUN(2, nat_phase(p, (float*)lds); if (PROBE_PH == 102) { __syncthreads(); nat_phase(p, (float*)lds); } prep_phase(p);)
#define SCAN_DIR(d, pb) \
    RUN(pb, { \
        EpiLora e; e.w0 = p.decay_w0 + (d) * RW; e.a0 = p.iclr_a0 + (d) * RW; e.ka = p.k_a; e.A = (const float*)(ws + O_A); e.Kb = (const u16*)(ws + O_K); \
        e.Wd = p.out; e.Bd = p.out + (size_t)NTOK * RW; e.KD = (float*)(ws + O_KD); \
        run_gemm(lds, (const u16*)(ws + O_AL), (const u16*)(ws + O_WLT) + (size_t)(d) * 2048 * 256, NTOK, 2048, 256, e); }) \
    RUN(pb + 1, scan_pass1(p, d);) \
    RUN(pb + 2, scan_combine(p, (float*)lds);) \
    RUN(pb + 3, scan_pass2(p, d);)
    SCAN_DIR(0, 3)
    SCAN_DIR(1, 7)
    RUN(11, post_phase(p);)
    RUN(12, {
        EpiH e; e.X = p.x; e.H = p.out;
        run_gemm(lds, (const u16*)(ws + O_HN), (const u16*)(ws + O_W2T), NTOK, 2048, 2048, e);
        EpiBf e2; e2.O = (u16*)(ws + O_R); e2.ld = DM;
        run_gemm(lds, (const u16*)(ws + O_AL), (const u16*)(ws + O_WPT), NTOK, 2048, 256, e2); })
    RUN(13, rownorm<true>(p.out, p.ple_norm_g, ws + O_HN);)
    RUN(14, {
        EpiGate e; e.H = p.out; e.PP = (const u16*)(ws + O_R);
        run_gemm(lds, (const u16*)(ws + O_HN), (const u16*)(ws + O_W3T), NTOK, 2048, 2048, e); })
    RUN(15, rownorm<false>(p.out, p.final_g, p.out);)
}

extern "C" void kernel_launch(void* const* d_in, const int* in_sizes, int n_in, void* d_out, int out_size, void* d_ws, size_t ws_size, hipStream_t stream) {
    static int grid = 0;
    if (grid == 0) {
        if (n_in != 21 || out_size != NTOK * DM || ws_size < WS_END) { fprintf(stderr, "kernel_launch: unexpected shapes (n_in %d out %d ws %zu need %zu)\n", n_in, out_size, ws_size, (size_t)WS_END); grid = -1; return; }
        int dev = 0, cus = 0, per_cu = 0;
        hipGetDevice(&dev); hipDeviceGetAttribute(&cus, hipDeviceAttributeMultiprocessorCount, dev);
        hipFuncSetAttribute((const void*)mega, hipFuncAttributeMaxDynamicSharedMemorySize, LDS_BYTES);
        hipOccupancyMaxActiveBlocksPerMultiprocessor(&per_cu, (const void*)mega, NTHREADS, LDS_BYTES);
        if (per_cu < 1) { fprintf(stderr, "kernel_launch: occupancy query says %d blocks/CU\n", per_cu); grid = -1; return; }
        grid = cus;
    }
    if (grid < 0) return;
    Params p{};
    const float** f = (const float**)&p;
    for (int i = 0; i < 21; ++i) f[i] = (const float*)d_in[i];
    p.out = (float*)d_out; p.ws = (unsigned char*)d_ws;
    hipMemsetAsync((unsigned char*)d_ws + O_BAR, 0, XCD_BAR_WORDS * sizeof(unsigned), stream);
#if MULTI_LAUNCH
    for (int ph = 0; ph < 16; ++ph) { p.ph_lo = ph; p.ph_hi = ph + 1; hipLaunchKernelGGL(mega, dim3(grid), dim3(NTHREADS), LDS_BYTES, stream, p); }
#else
    p.ph_lo = 0; p.ph_hi = 16;
    void* args[] = {&p};
    hipError_t e = hipLaunchCooperativeKernel((const void*)mega, dim3(grid), dim3(NTHREADS), args, LDS_BYTES, stream);
    if (e != hipSuccess) fprintf(stderr, "cooperative launch failed: %s (grid %d)\n", hipGetErrorString(e), grid);
#endif
}
```

```cpp
#include <hip/hip_runtime.h>
#include <hip/hip_cooperative_groups.h>
#include <cstdio>
namespace cg = cooperative_groups;

#ifndef MULTI_LAUNCH
#define MULTI_LAUNCH 0
#endif

#define LAS __attribute__((address_space(3)))
typedef unsigned short u16;
typedef short bf16x8 __attribute__((ext_vector_type(8)));
typedef float f32x4 __attribute__((ext_vector_type(4)));
typedef float f32x2 __attribute__((ext_vector_type(2)));
typedef unsigned u32x4 __attribute__((ext_vector_type(4)));
typedef unsigned u32x2 __attribute__((ext_vector_type(2)));
typedef const __attribute__((address_space(4))) f32x2* cf2p;

constexpr int SEQ = 16384, NTOK = 32768, DM = 2048, RW = 1024;
constexpr int NC = 64, LC = SEQ / NC;
constexpr int NTHREADS = 512, LDS_XB = 131072, LDS_BYTES = 131072 + 16;
constexpr float DECAY_SCALE = 0.6065306597126334f;

constexpr size_t MiB = 1ull << 20;
constexpr size_t O_W1T = 0, O_W2T = 33 * MiB, O_W3T = 41 * MiB, O_WPT = 49 * MiB, O_WLT = 50 * MiB;
constexpr size_t O_HN = 56 * MiB;
constexpr size_t O_ZS = 184 * MiB;
constexpr size_t O_KD = O_ZS, O_PT = O_ZS + 128 * MiB, O_SLT = O_ZS + 160 * MiB;
constexpr size_t O_ZG = 392 * MiB;
constexpr size_t O_R = 456 * MiB;
constexpr size_t O_A = 584 * MiB;
constexpr size_t O_V = 712 * MiB;
constexpr size_t O_K = 776 * MiB;
constexpr size_t O_AL = 840 * MiB;
constexpr size_t O_BON = 856 * MiB;
constexpr size_t O_Y = 858 * MiB;
constexpr size_t O_SIT = 986 * MiB;
constexpr size_t O_BAR = 1018 * MiB;
constexpr size_t WS_END = 1019 * MiB;

struct Params {
    const float *x, *p, *norm_mix_g, *w_in, *mu_prev, *mu_next, *decay_w0, *decay_w2, *iclr_a0, *iclr_a2, *k_k, *k_a, *r_k, *lnx_w, *lnx_b, *rpb, *w_out,
        *ple_norm_g, *w_ple_gate, *w_ple_proj, *final_g;
    float* out; unsigned char* ws;
    int ph_lo, ph_hi;
};

__device__ __forceinline__ float bf2f(u16 b) { return __uint_as_float(((unsigned)b) << 16); }
__device__ __forceinline__ float bflo(unsigned w) { return __uint_as_float(w << 16); }
__device__ __forceinline__ float bfhi(unsigned w) { return __uint_as_float(w & 0xffff0000u); }
__device__ __forceinline__ unsigned cvt_pk_bf16(float lo, float hi) { unsigned r; asm volatile("v_cvt_pk_bf16_f32 %0, %1, %2" : "=v"(r) : "v"(lo), "v"(hi)); return r; }
__device__ __forceinline__ float sigmoidf_(float x) { return __builtin_amdgcn_rcpf(1.0f + __expf(-x)); }
__device__ __forceinline__ f32x2 fma2(f32x2 a, f32x2 b, f32x2 c) { return __builtin_elementwise_fma(a, b, c); }

namespace pg8 {
constexpr int BM = 256, BK = 64, HALF = 128, HTB = HALF * BK * 2, NXCD = 8, WGM = 8;
__device__ __forceinline__ int lds_byte(int r, int c) { const int st = (r >> 4) * 2 + (c >> 5), rr = r & 15, cc = c & 31, ob = rr * 64 + cc * 2; return st * 1024 + (ob ^ (((ob >> 9) & 1) << 5)); }
__device__ __forceinline__ void stage_rc(int b, int& R, int& C) { const int st = b / 1024, sb = b % 1024, swz = sb ^ (((sb >> 9) & 1) << 5); R = (st >> 1) * 16 + swz / 64; C = (st & 1) * 32 + (swz % 64) / 2; }
__device__ __forceinline__ int perm32(int rho) { const int n = rho >> 4, i = rho & 15; return 8 * (i >> 2) + 4 * n + (i & 3); }
struct Unit { int pm, pn; };
struct Gemm { const u16* A; const u16* Bt; int M, N, K; };
struct StaticOrder {
    int nM, nN, nwg, G, c;
    __device__ void init(int M, int N, int G_, int c_) { nM = M / BM; nN = N / BM; nwg = nM * nN; G = G_; c = c_; }
    __device__ bool next(int i, Unit& u) const {
        const long L = (long)i * G + c; if (L >= nwg) return false;
        int wgid = (int)L; { const int q = nwg / NXCD, r = nwg % NXCD, xcd = wgid % NXCD, off = wgid / NXCD; wgid = (xcd < r ? xcd * (q + 1) : r * (q + 1) + (xcd - r) * q) + off; }
        const int nig = WGM * nN, gid = wgid / nig, fm = gid * WGM, gsz = (nM - fm) < WGM ? (nM - fm) : WGM;
        u.pm = fm + ((wgid % nig) % gsz); u.pn = (wgid % nig) / gsz; return true;
    }
};
template <class Epi>
__device__ __forceinline__ void gemm_phase(LAS unsigned char* lds, const Gemm g, const StaticOrder& S, const Epi& E) {
    const int tid = threadIdx.x, wid = __builtin_amdgcn_readfirstlane(tid >> 6), lane = tid & 63, wr = wid >> 2, wc = wid & 3, fr = lane & 15, fq = lane >> 4;
    const int K = g.K, nt = K / BK;
    unsigned voffA[2], voffB[2];
#pragma unroll
    for (int i = 0; i < 2; ++i) { int R, C; stage_rc(tid * 16 + i * 8192, R, C); const int Rb = Epi::PERM ? ((R & ~31) + perm32(R & 31)) : R;
        voffA[i] = (unsigned)(R * K + C) * 2u; voffB[i] = (unsigned)(Rb * K + C) * 2u; }
    const size_t kstep = (size_t)(BK * 2);
    const size_t hstep = (size_t)HALF * K * 2;
    const size_t tstep = 2 * hstep;
    const unsigned ldsw = (unsigned)wid * 1024u;
    const int aoff = lds_byte(wr * 64 + fr, fq * 8), boff = lds_byte(wc * 32 + fr, fq * 8);
#define PG8_SA(b, h) (((b) * 2 + (h)) * HTB)
#define PG8_SB(b, h) ((4 + (b) * 2 + (h)) * HTB)
#define PG8_STAGE(bufoff, gbase, voff) do { _Pragma("unroll") for (int _i = 0; _i < 2; ++_i) \
        __builtin_amdgcn_global_load_lds((const unsigned*)((const char*)(gbase) + (voff)[_i]), (LAS unsigned*)(lds + (bufoff) + ldsw + _i * 8192), 16, 0, 0); } while (0)
#define PG8_LDA(dst, b, h) do { _Pragma("unroll") for (int m = 0; m < 4; ++m) _Pragma("unroll") for (int k = 0; k < 2; ++k) dst[m][k] = *(const LAS bf16x8*)(lds + PG8_SA(b, h) + aoff + m * 2048 + k * 1024); } while (0)
#define PG8_LDB(dst, b, h) do { _Pragma("unroll") for (int n = 0; n < 2; ++n) _Pragma("unroll") for (int k = 0; k < 2; ++k) dst[n][k] = *(const LAS bf16x8*)(lds + PG8_SB(b, h) + boff + n * 2048 + k * 1024); } while (0)
#define PG8_MMA(ai, bj, At, Bt) do { __builtin_amdgcn_s_setprio(1); _Pragma("unroll") for (int m = 0; m < 4; ++m) _Pragma("unroll") for (int n = 0; n < 2; ++n) _Pragma("unroll") for (int k = 0; k < 2; ++k) \
        acc[ai][bj][m][n] = __builtin_amdgcn_mfma_f32_16x16x32_bf16(Bt[n][k], At[m][k], acc[ai][bj][m][n], 0, 0, 0); __builtin_amdgcn_s_setprio(0); } while (0)
#define PG8_WAIT_V(n) asm volatile("s_waitcnt vmcnt(" #n ")" ::: "memory")
#define PG8_WAIT_L(n) asm volatile("s_waitcnt lgkmcnt(" #n ")" ::: "memory")
#define PG8_BAR __builtin_amdgcn_s_barrier()
#define PG8_SCHED __builtin_amdgcn_sched_barrier(0)
    Unit cur, nxt; int ui = 0;
    if (!S.next(0, cur)) return;
    f32x4 acc[2][2][4][2];
#pragma unroll
    for (int a = 0; a < 2; ++a)
#pragma unroll
        for (int b = 0; b < 2; ++b)
#pragma unroll
            for (int m = 0; m < 4; ++m)
#pragma unroll
                for (int n = 0; n < 2; ++n) acc[a][b][m][n] = (f32x4){0.f, 0.f, 0.f, 0.f};
    bf16x8 At[4][2], B0[2][2], B1[2][2];
    const char* cA = (const char*)g.A + (size_t)cur.pm * tstep; const char* cB = (const char*)g.Bt + (size_t)cur.pn * tstep;
    PG8_STAGE(PG8_SB(0, 0), cB, voffB); PG8_STAGE(PG8_SA(0, 0), cA, voffA); PG8_STAGE(PG8_SB(0, 1), cB + hstep, voffB); PG8_STAGE(PG8_SA(0, 1), cA + hstep, voffA);
    if (wr == 1) PG8_BAR;
    PG8_WAIT_V(4); PG8_BAR;
    PG8_STAGE(PG8_SB(1, 0), cB + kstep, voffB); PG8_STAGE(PG8_SA(1, 0), cA + kstep, voffA); PG8_STAGE(PG8_SB(1, 1), cB + hstep + kstep, voffB);
    PG8_WAIT_V(6); PG8_BAR;
    for (;;) {
        const bool has_next = S.next(ui + 1, nxt);
        const char* nA = has_next ? (const char*)g.A + (size_t)nxt.pm * tstep : cA; const char* nB = has_next ? (const char*)g.Bt + (size_t)nxt.pn * tstep : cB;
        for (int t = 0; t < nt; t += 2) {
            const bool last = (t == nt - 2);
            const char* a1 = cA + (size_t)(t + 1) * kstep;
            const char* a2 = last ? nA : cA + (size_t)(t + 2) * kstep; const char* b2 = last ? nB : cB + (size_t)(t + 2) * kstep;
            const char* a3 = a2 + kstep; const char* b3 = b2 + kstep;
            PG8_LDB(B0, 0, 0); PG8_SCHED; PG8_LDA(At, 0, 0); PG8_STAGE(PG8_SA(1, 1), a1 + hstep, voffA);
            PG8_WAIT_L(8); PG8_BAR; PG8_WAIT_L(0); PG8_MMA(0, 0, At, B0); PG8_BAR; PG8_SCHED;
            PG8_LDB(B1, 0, 1); PG8_STAGE(PG8_SB(0, 0), b2, voffB);
            PG8_BAR; PG8_WAIT_L(0); PG8_MMA(0, 1, At, B1); PG8_BAR;
            PG8_LDA(At, 0, 1); PG8_STAGE(PG8_SA(0, 0), a2, voffA);
            PG8_BAR; PG8_WAIT_L(0); PG8_MMA(1, 0, At, B0); PG8_BAR; PG8_SCHED;
            PG8_STAGE(PG8_SB(0, 1), b2 + hstep, voffB);
            PG8_WAIT_V(6); PG8_BAR; PG8_MMA(1, 1, At, B1); PG8_BAR;
            PG8_LDB(B0, 1, 0); PG8_SCHED; PG8_LDA(At, 1, 0); PG8_STAGE(PG8_SA(0, 1), a2 + hstep, voffA);
            PG8_WAIT_L(8); PG8_BAR; PG8_WAIT_L(0); PG8_MMA(0, 0, At, B0); PG8_BAR; PG8_SCHED;
            PG8_LDB(B1, 1, 1); PG8_STAGE(PG8_SB(1, 0), b3, voffB);
            PG8_BAR; PG8_WAIT_L(0); PG8_MMA(0, 1, At, B1); PG8_BAR;
            PG8_LDA(At, 1, 1); PG8_STAGE(PG8_SA(1, 0), a3, voffA);
            PG8_BAR; PG8_WAIT_L(0); PG8_MMA(1, 0, At, B0); PG8_BAR; PG8_SCHED;
            PG8_STAGE(PG8_SB(1, 1), b3 + hstep, voffB);
            PG8_WAIT_V(6); PG8_BAR; PG8_MMA(1, 1, At, B1); PG8_BAR;
        }
        E(acc, cur, wr, wc, fr, fq);
        if (!has_next) break;
#pragma unroll
        for (int a = 0; a < 2; ++a)
#pragma unroll
            for (int b = 0; b < 2; ++b)
#pragma unroll
                for (int m = 0; m < 4; ++m)
#pragma unroll
                    for (int n = 0; n < 2; ++n) acc[a][b][m][n] = (f32x4){0.f, 0.f, 0.f, 0.f};
        cur = nxt; cA = nA; cB = nB; ++ui;
    }
    PG8_WAIT_V(0);
    if (wr == 0) PG8_BAR;
    PG8_BAR;
#undef PG8_SA
#undef PG8_SB
#undef PG8_STAGE
#undef PG8_LDA
#undef PG8_LDB
#undef PG8_MMA
#undef PG8_WAIT_V
#undef PG8_WAIT_L
#undef PG8_BAR
#undef PG8_SCHED
}
}
using pg8::Unit;
typedef f32x4 AccT[2][2][4][2];

struct EpiZ {
    static constexpr bool PERM = true;
    u16 *zs, *zg, *qn, *kn, *vt, *gn;
    __device__ __forceinline__ void operator()(const AccT& acc, const Unit& u, int wr, int wc, int fr, int fq) const {
        const int row0 = u.pm * 256 + wr * 64 + fr; const int pn = u.pn;
        if (pn >= 25 && pn < 29) {
            const int cb = (pn - 25) * 256 + wc * 32 + 8 * fq;
#pragma unroll
            for (int ai = 0; ai < 2; ++ai)
#pragma unroll
                for (int m = 0; m < 4; ++m) { const int row = row0 + ai * 128 + m * 16; const int b = row >> 14, tt = row & (SEQ - 1);
#pragma unroll
                    for (int bj = 0; bj < 2; ++bj)
#pragma unroll
                        for (int n = 0; n < 2; ++n)
#pragma unroll
                            for (int j = 0; j < 4; ++j) { const int ch = cb + bj * 128 + 4 * n + j;
                                vt[((size_t)(b * 1024 + ch)) * SEQ + tt] = (u16)(cvt_pk_bf16(acc[ai][bj][m][n][j], 0.f) & 0xffffu); } }
            return;
        }
        u16* base; int ld, colt;
        if (pn < 13) { base = zs; ld = 3328; colt = pn * 256; }
        else if (pn < 17) { base = zg; ld = 1024; colt = (pn - 13) * 256; }
        else if (pn < 21) { base = qn; ld = 1024; colt = (pn - 17) * 256; }
        else if (pn < 25) { base = kn; ld = 1024; colt = (pn - 21) * 256; }
        else { base = gn; ld = 1024; colt = (pn - 29) * 256; }
        const int col0 = colt + wc * 32 + 8 * fq;
#pragma unroll
        for (int ai = 0; ai < 2; ++ai)
#pragma unroll
            for (int m = 0; m < 4; ++m) { u16* rowp = base + (size_t)(row0 + ai * 128 + m * 16) * ld + col0;
#pragma unroll
                for (int bj = 0; bj < 2; ++bj) { const f32x4 v0 = acc[ai][bj][m][0], v1 = acc[ai][bj][m][1];
                    u32x4 w; w.x = cvt_pk_bf16(v0[0], v0[1]); w.y = cvt_pk_bf16(v0[2], v0[3]); w.z = cvt_pk_bf16(v1[0], v1[1]); w.w = cvt_pk_bf16(v1[2], v1[3]);
                    *(u32x4*)(rowp + bj * 128) = w; } }
    }
};
struct EpiBf {
    static constexpr bool PERM = true;
    u16* O; int ld;
    __device__ __forceinline__ void operator()(const AccT& acc, const Unit& u, int wr, int wc, int fr, int fq) const {
        const int row0 = u.pm * 256 + wr * 64 + fr, col0 = u.pn * 256 + wc * 32 + 8 * fq;
#pragma unroll
        for (int ai = 0; ai < 2; ++ai)
#pragma unroll
            for (int m = 0; m < 4; ++m) { u16* rowp = O + (size_t)(row0 + ai * 128 + m * 16) * ld + col0;
#pragma unroll
                for (int bj = 0; bj < 2; ++bj) { const f32x4 v0 = acc[ai][bj][m][0], v1 = acc[ai][bj][m][1];
                    u32x4 w; w.x = cvt_pk_bf16(v0[0], v0[1]); w.y = cvt_pk_bf16(v0[2], v0[3]); w.z = cvt_pk_bf16(v1[0], v1[1]); w.w = cvt_pk_bf16(v1[2], v1[3]);
                    *(u32x4*)(rowp + bj * 128) = w; } }
    }
};
struct EpiLora {
    static constexpr bool PERM = false;
    const float *w0, *a0; float *Wd, *IC;
    __device__ __forceinline__ void operator()(const AccT& acc, const Unit& u, int wr, int wc, int fr, int fq) const {
        const int row0 = u.pm * 256 + wr * 64 + fr, col0 = u.pn * 256 + wc * 32 + 4 * fq;
        if (u.pn < 4) {
#pragma unroll
            for (int bj = 0; bj < 2; ++bj)
#pragma unroll
                for (int n = 0; n < 2; ++n) { const int col = col0 + bj * 128 + n * 16; const f32x4 wv = *(const f32x4*)(w0 + col);
#pragma unroll
                    for (int ai = 0; ai < 2; ++ai)
#pragma unroll
                        for (int m = 0; m < 4; ++m) { const int row = row0 + ai * 128 + m * 16; f32x4 o;
#pragma unroll
                            for (int j = 0; j < 4; ++j) o[j] = __expf(-DECAY_SCALE * sigmoidf_(wv[j] + acc[ai][bj][m][n][j]));
                            *(f32x4*)(Wd + (size_t)row * RW + col) = o; asm volatile("" ::: "memory"); } }
        } else {
#pragma unroll
            for (int bj = 0; bj < 2; ++bj)
#pragma unroll
                for (int n = 0; n < 2; ++n) { const int col = col0 - 1024 + bj * 128 + n * 16; const f32x4 av0 = *(const f32x4*)(a0 + col);
#pragma unroll
                    for (int ai = 0; ai < 2; ++ai)
#pragma unroll
                        for (int m = 0; m < 4; ++m) { const int row = row0 + ai * 128 + m * 16; f32x4 o;
#pragma unroll
                            for (int j = 0; j < 4; ++j) o[j] = sigmoidf_(av0[j] + acc[ai][bj][m][n][j]);
                            *(f32x4*)(IC + (size_t)row * RW + col) = o; asm volatile("" ::: "memory"); } }
        }
    }
};
struct EpiH {
    static constexpr bool PERM = false;
    const float* X; float* H;
    __device__ __forceinline__ void operator()(const AccT& acc, const Unit& u, int wr, int wc, int fr, int fq) const {
        const int row0 = u.pm * 256 + wr * 64 + fr, col0 = u.pn * 256 + wc * 32 + 4 * fq;
#pragma unroll
        for (int ai = 0; ai < 2; ++ai)
#pragma unroll
            for (int m = 0; m < 4; ++m) { const size_t ro = (size_t)(row0 + ai * 128 + m * 16) * DM + col0;
#pragma unroll
                for (int bj = 0; bj < 2; ++bj)
#pragma unroll
                    for (int n = 0; n < 2; ++n) { const size_t o = ro + bj * 128 + n * 16; *(f32x4*)(H + o) = acc[ai][bj][m][n] + *(const f32x4*)(X + o); } asm volatile("" ::: "memory"); }
    }
};
struct EpiGate {
    static constexpr bool PERM = false;
    float* H; const u16* PP;
    __device__ __forceinline__ void operator()(const AccT& acc, const Unit& u, int wr, int wc, int fr, int fq) const {
        const int row0 = u.pm * 256 + wr * 64 + fr, col0 = u.pn * 256 + wc * 32 + 4 * fq;
#pragma unroll
        for (int ai = 0; ai < 2; ++ai)
#pragma unroll
            for (int m = 0; m < 4; ++m) { const size_t ro = (size_t)(row0 + ai * 128 + m * 16) * DM + col0;
#pragma unroll
                for (int bj = 0; bj < 2; ++bj)
#pragma unroll
                    for (int n = 0; n < 2; ++n) { const size_t o = ro + bj * 128 + n * 16; const f32x4 h = *(const f32x4*)(H + o); const u32x2 pw = *(const u32x2*)(PP + o);
                        const f32x4 a = acc[ai][bj][m][n]; f32x4 r;
                        r[0] = h[0] + bflo(pw.x) * sigmoidf_(a[0]); r[1] = h[1] + bfhi(pw.x) * sigmoidf_(a[1]); r[2] = h[2] + bflo(pw.y) * sigmoidf_(a[2]); r[3] = h[3] + bfhi(pw.y) * sigmoidf_(a[3]);
                        *(f32x4*)(H + o) = r; asm volatile("" ::: "memory"); } }
    }
};

template <class Epi> __device__ __forceinline__ void run_gemm(unsigned char* lds, const u16* A, const u16* Bt, int M, int N, int K, const Epi& E) {
    pg8::Gemm g; g.A = A; g.Bt = Bt; g.M = M; g.N = N; g.K = K;
    pg8::StaticOrder S; S.init(M, N, gridDim.x, blockIdx.x);
    pg8::gemm_phase<Epi>((LAS unsigned char*)lds, g, S, E);
    __syncthreads();
}

__device__ __forceinline__ void transpose_cvt(const float* __restrict__ src, int K, int N, u16* __restrict__ dst, int ldd, float* tile) {
    const int tid = threadIdx.x, tn = N / 64, ntile = (K / 64) * tn;
    for (int t = blockIdx.x; t < ntile; t += gridDim.x) {
        const int k0 = (t / tn) * 64, n0 = (t % tn) * 64;
#pragma unroll
        for (int ps = 0; ps < 2; ++ps) { const int r = (tid >> 4) + ps * 32, c4 = (tid & 15) * 4; const f32x4 v = *(const f32x4*)(src + (size_t)(k0 + r) * N + n0 + c4);
            tile[r * 65 + c4] = v[0]; tile[r * 65 + c4 + 1] = v[1]; tile[r * 65 + c4 + 2] = v[2]; tile[r * 65 + c4 + 3] = v[3]; }
        __syncthreads();
        { const int n = tid >> 3, ks = (tid & 7) * 8; u32x4 w;
          w.x = cvt_pk_bf16(tile[(ks + 0) * 65 + n], tile[(ks + 1) * 65 + n]); w.y = cvt_pk_bf16(tile[(ks + 2) * 65 + n], tile[(ks + 3) * 65 + n]);
          w.z = cvt_pk_bf16(tile[(ks + 4) * 65 + n], tile[(ks + 5) * 65 + n]); w.w = cvt_pk_bf16(tile[(ks + 6) * 65 + n], tile[(ks + 7) * 65 + n]);
          *(u32x4*)(dst + (size_t)(n0 + n) * ldd + k0 + ks) = w; }
        __syncthreads();
    }
}
__device__ __forceinline__ void build_wlt(const Params& p) {
    u16* W = (u16*)(p.ws + O_WLT);
    for (int i = blockIdx.x * NTHREADS + threadIdx.x; i < 2 * 2048 * 256; i += gridDim.x * NTHREADS) {
        const int k = i & 255, n = (i >> 8) & 2047, d = i >> 19; float v = 0.f;
        if (n < 1024) { if ((k >> 6) == d) v = p.decay_w2[((size_t)d * 64 + (k & 63)) * RW + n]; }
        else { if ((k >> 6) == 2 + d) v = p.iclr_a2[((size_t)d * 64 + (k & 63)) * RW + (n - 1024)]; }
        W[i] = (u16)(cvt_pk_bf16(v, 0.f) & 0xffffu);
    }
}
template <bool BF> __device__ __forceinline__ void rownorm(const float* src, const float* __restrict__ g, void* dst) {
    const int lane = threadIdx.x & 63, wid = threadIdx.x >> 6;
    for (int row = blockIdx.x * 8 + wid; row < NTOK; row += gridDim.x * 8) {
        const float* s = src + (size_t)row * DM + lane * 4; f32x4 v[8]; float ss = 0.f;
#pragma unroll
        for (int i = 0; i < 8; ++i) { v[i] = *(const f32x4*)(s + i * 256); ss += v[i][0] * v[i][0] + v[i][1] * v[i][1] + v[i][2] * v[i][2] + v[i][3] * v[i][3]; }
#pragma unroll
        for (int o = 32; o >= 1; o >>= 1) ss += __shfl_xor(ss, o);
        const float sc = rsqrtf(ss * (1.0f / DM) + 1e-6f);
#pragma unroll
        for (int i = 0; i < 8; ++i) { const f32x4 gv = *(const f32x4*)(g + lane * 4 + i * 256); const f32x4 o = v[i] * sc * gv;
            if (BF) { u32x2 w; w.x = cvt_pk_bf16(o[0], o[1]); w.y = cvt_pk_bf16(o[2], o[3]); *(u32x2*)((u16*)dst + (size_t)row * DM + lane * 4 + i * 256) = w; }
            else *(f32x4*)((float*)dst + (size_t)row * DM + lane * 4 + i * 256) = o; }
    }
}

__device__ __forceinline__ void ld16bf(const u16* p, float* o) {
    const u32x4 a = *(const u32x4*)p, b = *(const u32x4*)(p + 8);
    o[0] = bflo(a.x); o[1] = bfhi(a.x); o[2] = bflo(a.y); o[3] = bfhi(a.y); o[4] = bflo(a.z); o[5] = bfhi(a.z); o[6] = bflo(a.w); o[7] = bfhi(a.w);
    o[8] = bflo(b.x); o[9] = bfhi(b.x); o[10] = bflo(b.y); o[11] = bfhi(b.y); o[12] = bflo(b.z); o[13] = bfhi(b.z); o[14] = bflo(b.w); o[15] = bfhi(b.w);
}
__device__ __forceinline__ void st16bf(u16* p, const float* v) {
    u32x4 a, b; a.x = cvt_pk_bf16(v[0], v[1]); a.y = cvt_pk_bf16(v[2], v[3]); a.z = cvt_pk_bf16(v[4], v[5]); a.w = cvt_pk_bf16(v[6], v[7]);
    b.x = cvt_pk_bf16(v[8], v[9]); b.y = cvt_pk_bf16(v[10], v[11]); b.z = cvt_pk_bf16(v[12], v[13]); b.w = cvt_pk_bf16(v[14], v[15]);
    *(u32x4*)p = a; *(u32x4*)(p + 8) = b;
}
__device__ __forceinline__ void shift16(const u16* zc, bool hp, bool hn, const float* __restrict__ mp, const float* __restrict__ mn, int c, float* o) {
    float z[16], zp[16], zn[16]; ld16bf(zc + c, z);
    if (hp) ld16bf(zc - 3328 + c, zp); else {
#pragma unroll
        for (int j = 0; j < 16; ++j) zp[j] = 0.f; }
    if (hn) ld16bf(zc + 3328 + c, zn); else {
#pragma unroll
        for (int j = 0; j < 16; ++j) zn[j] = 0.f; }
#pragma unroll
    for (int j4 = 0; j4 < 4; ++j4) { const f32x4 a = *(const f32x4*)(mp + c + j4 * 4), b = *(const f32x4*)(mn + c + j4 * 4);
#pragma unroll
        for (int j = 0; j < 4; ++j) { const int q = j4 * 4 + j; o[q] = z[q] + a[j] * (zp[q] - z[q]) + b[j] * (zn[q] - z[q]); } }
}
__device__ __forceinline__ void prep_phase(const Params& p) {
    const int lane = threadIdx.x & 63, wid = threadIdx.x >> 6;
    const u16* ZS = (const u16*)(p.ws + O_ZS);
    float* R = (float*)(p.ws + O_R); float* A = (float*)(p.ws + O_A); u16* V = (u16*)(p.ws + O_V); u16* Kb = (u16*)(p.ws + O_K); u16* AL = (u16*)(p.ws + O_AL); float* BON = (float*)(p.ws + O_BON);
    for (int t = blockIdx.x * 8 + wid; t < NTOK; t += gridDim.x * 8) {
        const int tt = t & (SEQ - 1); const bool hp = tt > 0, hn = tt < SEQ - 1;
        const u16* zc = ZS + (size_t)t * 3328; const int c = lane * 16;
        float r[16], k[16], v[16];
        shift16(zc, hp, hn, p.mu_prev, p.mu_next, c, r);
        shift16(zc, hp, hn, p.mu_prev, p.mu_next, 1024 + c, k);
        shift16(zc, hp, hn, p.mu_prev, p.mu_next, 2048 + c, v);
        float kk[16], s2 = 0.f, bs = 0.f;
#pragma unroll
        for (int j4 = 0; j4 < 4; ++j4) { const f32x4 kkv = *(const f32x4*)(p.k_k + c + j4 * 4), rkv = *(const f32x4*)(p.r_k + c + j4 * 4);
#pragma unroll
            for (int j = 0; j < 4; ++j) { const int q = j4 * 4 + j; kk[q] = k[q] * kkv[j]; s2 += kk[q] * kk[q]; bs += r[q] * k[q] * rkv[j]; } }
        s2 += __shfl_xor(s2, 1); s2 += __shfl_xor(s2, 2); bs += __shfl_xor(bs, 1); bs += __shfl_xor(bs, 2);
        const float inv = -1.0f / fmaxf(sqrtf(s2), 1e-12f);
        const size_t o = (size_t)t * RW + c;
#pragma unroll
        for (int j4 = 0; j4 < 4; ++j4) { *(f32x4*)(R + o + j4 * 4) = (f32x4){r[j4 * 4], r[j4 * 4 + 1], r[j4 * 4 + 2], r[j4 * 4 + 3]};
            *(f32x4*)(A + o + j4 * 4) = (f32x4){kk[j4 * 4] * inv, kk[j4 * 4 + 1] * inv, kk[j4 * 4 + 2] * inv, kk[j4 * 4 + 3] * inv}; }
        st16bf(Kb + o, k); st16bf(V + o, v);
        if ((lane & 3) == 0) BON[(size_t)t * 16 + (lane >> 2)] = bs;
        { const int cl = 3072 + lane * 4; const u32x2 zw = *(const u32x2*)(zc + cl); u32x2 pw = {0u, 0u}, nw = {0u, 0u};
          if (hp) pw = *(const u32x2*)(zc - 3328 + cl); if (hn) nw = *(const u32x2*)(zc + 3328 + cl);
          const f32x4 a = *(const f32x4*)(p.mu_prev + cl), b = *(const f32x4*)(p.mu_next + cl);
          const float z4[4] = {bflo(zw.x), bfhi(zw.x), bflo(zw.y), bfhi(zw.y)}, p4[4] = {bflo(pw.x), bfhi(pw.x), bflo(pw.y), bfhi(pw.y)}, n4[4] = {bflo(nw.x), bfhi(nw.x), bflo(nw.y), bfhi(nw.y)};
          float o4[4];
#pragma unroll
          for (int j = 0; j < 4; ++j) { float s = z4[j] + a[j] * (p4[j] - z4[j]) + b[j] * (n4[j] - z4[j]); o4[j] = (lane < 32) ? tanhf(s) : s; }
          u32x2 w; w.x = cvt_pk_bf16(o4[0], o4[1]); w.y = cvt_pk_bf16(o4[2], o4[3]); *(u32x2*)(AL + (size_t)t * 256 + lane * 4) = w; }
    }
}

__device__ __forceinline__ void nat_phase(const Params& p, float* ldsf) {
    const int lane = threadIdx.x & 63, wid = __builtin_amdgcn_readfirstlane(threadIdx.x >> 6), l15 = lane & 15, lq = lane >> 4;
    const u16* Qn = (const u16*)p.out; const u16* Kn = Qn + (size_t)NTOK * RW; const u16* VT = Kn + (size_t)NTOK * RW; const u16* Gn = VT + (size_t)NTOK * RW;
    u16* MIX = (u16*)(p.ws + O_HN);
    for (int item = blockIdx.x * 8 + wid; item < 8192; item += gridDim.x * 8) {
        const int r = item & 255, h = (item >> 8) & 15, b = item >> 12;
        const int rs = min(max(r - 4, 0), 248);
        const u16* Qb = Qn + (size_t)(b * SEQ + r * 64) * RW + h * 64;
        const u16* Kb = Kn + (size_t)(b * SEQ + rs * 64) * RW + h * 64;
        const u16* Vb = VT + (size_t)((b * 16 + h) * 64) * SEQ + rs * 64;
        float* tb = ldsf + wid * 256;
        { const float* rpb = p.rpb + h * 465 + (rs - r + 7) * 31;
#pragma unroll
          for (int q = 0; q < 4; ++q) { const int e = lane + q * 64; if (e < 248) tb[e] = rpb[e]; } }
#pragma unroll 1
        for (int qt = 0; qt < 4; ++qt) {
            const int c0 = qt * 16, cs0 = (qt == 0) ? 0 : (qt == 1 ? 8 : (qt == 2 ? 24 : 32));
            const int c = c0 + l15, csq = min(max(c - 8, 0), 48);
            const bf16x8 bq0 = *(const bf16x8*)(Qb + (size_t)c * RW + lq * 8), bq1 = *(const bf16x8*)(Qb + (size_t)c * RW + 32 + lq * 8);
            f32x4 sc[8][2];
#pragma unroll
            for (int i = 0; i < 8; ++i)
#pragma unroll
                for (int hf = 0; hf < 2; ++hf) { const u16* kp = Kb + (size_t)(i * 64 + cs0 + (l15 >> 2) * 8 + hf * 4 + (l15 & 3)) * RW + lq * 8;
                    const bf16x8 a0 = *(const bf16x8*)kp, a1 = *(const bf16x8*)(kp + 32); f32x4 z = {0.f, 0.f, 0.f, 0.f};
                    z = __builtin_amdgcn_mfma_f32_16x16x32_bf16(a0, bq0, z, 0, 0, 0); z = __builtin_amdgcn_mfma_f32_16x16x32_bf16(a1, bq1, z, 0, 0, 0); sc[i][hf] = z; }
            float mx = -1e30f;
#pragma unroll
            for (int i = 0; i < 8; ++i)
#pragma unroll
                for (int hf = 0; hf < 2; ++hf)
#pragma unroll
                    for (int j = 0; j < 4; ++j) { const int kc = cs0 + lq * 8 + hf * 4 + j; const bool valid = (kc >= csq) && (kc < csq + 16); const int bc = valid ? (kc - c + 15) : 0;
                        const float s = valid ? sc[i][hf][j] * 0.125f + tb[i * 31 + bc] : -1e30f; sc[i][hf][j] = s; mx = fmaxf(mx, s); }
            mx = fmaxf(mx, __shfl_xor(mx, 16)); mx = fmaxf(mx, __shfl_xor(mx, 32));
            float sum = 0.f;
#pragma unroll
            for (int i = 0; i < 8; ++i)
#pragma unroll
                for (int hf = 0; hf < 2; ++hf)
#pragma unroll
                    for (int j = 0; j < 4; ++j) { const float e = __expf(sc[i][hf][j] - mx); sc[i][hf][j] = e; sum += e; }
            sum += __shfl_xor(sum, 16); sum += __shfl_xor(sum, 32);
            const float inv = 1.0f / sum;
            f32x4 o[4];
#pragma unroll
            for (int mt = 0; mt < 4; ++mt) o[mt] = (f32x4){0.f, 0.f, 0.f, 0.f};
#pragma unroll
            for (int i = 0; i < 8; ++i) {
                u32x4 pw; pw.x = cvt_pk_bf16(sc[i][0][0] * inv, sc[i][0][1] * inv); pw.y = cvt_pk_bf16(sc[i][0][2] * inv, sc[i][0][3] * inv);
                pw.z = cvt_pk_bf16(sc[i][1][0] * inv, sc[i][1][1] * inv); pw.w = cvt_pk_bf16(sc[i][1][2] * inv, sc[i][1][3] * inv);
                const bf16x8 bp = __builtin_bit_cast(bf16x8, pw);
#pragma unroll
                for (int mt = 0; mt < 4; ++mt) { const u16* vp = Vb + (size_t)(mt * 16 + l15) * SEQ + i * 64 + cs0 + lq * 8;
                    o[mt] = __builtin_amdgcn_mfma_f32_16x16x32_bf16(*(const bf16x8*)vp, bp, o[mt], 0, 0, 0); }
            }
            const size_t tok = (size_t)(b * SEQ + r * 64 + c);
#pragma unroll
            for (int mt = 0; mt < 4; ++mt) { const int ch = h * 64 + mt * 16 + lq * 4; const u32x2 gw = *(const u32x2*)(Gn + tok * RW + ch);
                const float g0 = bflo(gw.x), g1 = bfhi(gw.x), g2 = bflo(gw.y), g3 = bfhi(gw.y);
                u32x2 w; w.x = cvt_pk_bf16(o[mt][0] * g0 * sigmoidf_(g0), o[mt][1] * g1 * sigmoidf_(g1)); w.y = cvt_pk_bf16(o[mt][2] * g2 * sigmoidf_(g2), o[mt][3] * g3 * sigmoidf_(g3));
                *(u32x2*)(MIX + tok * DM + 1024 + ch) = w; }
        }
    }
}

template <int N> __device__ __forceinline__ void fmac_bc(float& d, float bsrc, float o) { asm volatile("v_fmac_f32_dpp %0, %1, %2 row_newbcast:%3 row_mask:0xf bank_mask:0xf" : "+v"(d) : "v"(bsrc), "v"(o), "n"(N)); }
template <int N> __device__ __forceinline__ float mul_bc(float bsrc, float o) { float d; asm volatile("v_mul_f32_dpp %0, %1, %2 row_newbcast:%3 row_mask:0xf bank_mask:0xf" : "=v"(d) : "v"(bsrc), "v"(o), "n"(N)); return d; }
struct In1 { f32x4 w, a, b, kd; unsigned v; u32x2 kw; };
struct In2 { f32x4 w, a, b, kd, r; unsigned v; float yo; u32x2 kw; };
#define DERIVE_B(set) { set.b = -set.a * set.b; asm volatile("" : "+v"(set.b)); }
#define DERIVE_BK(set) { const f32x4 f_ = set.b * ka4 + c04; set.b = -set.a * set.b; const f32x4 k_ = {bflo(set.kw.x), bfhi(set.kw.x), bflo(set.kw.y), bfhi(set.kw.y)}; set.kd = k_ * f_; asm volatile("" : "+v"(set.b), "+v"(set.kd)); }
#define BC(x, k) x[(k) & 3]
template <int K> struct ScanK {
    static constexpr int N0 = K >> 2, N1 = (K + 1) >> 2;
    static __device__ __forceinline__ void dot(const float (&S)[64], const f32x4& a, float& s0, float& s1) {
        fmac_bc<N0>(s0, BC(a, K), S[K]); fmac_bc<N1>(s1, BC(a, K + 1), S[K + 1]);
        if constexpr (K + 2 < 64) ScanK<K + 2>::dot(S, a, s0, s1);
    }
    static __device__ __forceinline__ void upd(float (&S)[64], const In2& in, float sa, float vv, float& y0, float& y1) {
        float t0 = mul_bc<N0>(BC(in.kd, K), vv); float t1 = mul_bc<N1>(BC(in.kd, K + 1), vv);
        fmac_bc<N0>(t0, BC(in.w, K), S[K]); fmac_bc<N1>(t1, BC(in.w, K + 1), S[K + 1]);
        fmac_bc<N0>(t0, BC(in.b, K), sa); fmac_bc<N1>(t1, BC(in.b, K + 1), sa);
        S[K] = t0; S[K + 1] = t1;
        fmac_bc<N0>(y0, BC(in.r, K), t0); fmac_bc<N1>(y1, BC(in.r, K + 1), t1);
        if constexpr (K + 2 < 64) ScanK<K + 2>::upd(S, in, sa, vv, y0, y1);
    }
    static __device__ __forceinline__ void updS(float (&S)[64], const In1& in, float sa, float vv) {
        float t0 = mul_bc<N0>(BC(in.kd, K), vv); float t1 = mul_bc<N1>(BC(in.kd, K + 1), vv);
        fmac_bc<N0>(t0, BC(in.w, K), S[K]); fmac_bc<N1>(t1, BC(in.w, K + 1), S[K + 1]);
        fmac_bc<N0>(t0, BC(in.b, K), sa); fmac_bc<N1>(t1, BC(in.b, K + 1), sa);
        S[K] = t0; S[K + 1] = t1;
        if constexpr (K + 2 < 64) ScanK<K + 2>::updS(S, in, sa, vv);
    }
    static __device__ __forceinline__ void updP(float (&P)[64], const In1& in, float sa) {
        float u0 = mul_bc<N0>(BC(in.w, K), P[K]); float u1 = mul_bc<N1>(BC(in.w, K + 1), P[K + 1]);
        fmac_bc<N0>(u0, BC(in.b, K), sa); fmac_bc<N1>(u1, BC(in.b, K + 1), sa);
        P[K] = u0; P[K + 1] = u1;
        if constexpr (K + 2 < 64) ScanK<K + 2>::updP(P, in, sa);
    }
};
__device__ __forceinline__ void scan_pass1(const Params& p, int d) {
    const int lane = threadIdx.x & 63, wid = __builtin_amdgcn_readfirstlane(threadIdx.x >> 6); const unsigned lo16 = (lane & 15) * 16, lo2 = lane * 2;
    const float* Wd = p.out; const float* Bd = p.out + (size_t)NTOK * RW; const u16* KB = (const u16*)(p.ws + O_K); const float* A = (const float*)(p.ws + O_A);
    const u16* V = (const u16*)(p.ws + O_V); float* PT = (float*)(p.ws + O_PT); float* SLT = (float*)(p.ws + O_SLT); const unsigned lo8 = (lane & 15) * 8;
    constexpr int NS = 32 * (NC - 1);
    for (int item = blockIdx.x * 8 + wid; item < 2 * NS; item += gridDim.x * 8) {
        const bool isP = item >= NS; const int idx = isP ? item - NS : item;
        const int bh = idx / (NC - 1), c = idx - bh * (NC - 1), b = bh >> 4, h = bh & 15;
        const int t0 = d ? (SEQ - 1 - c * LC) : c * LC;
        const size_t off0 = ((size_t)(b * SEQ + t0)) * RW + h * 64; const long stp = d ? -(long)RW : (long)RW;
        const float *wq = Wd + off0, *aq = A + off0, *bq = Bd + off0; const u16* kq = KB + off0; const u16* vq = V + off0;
        const f32x4 ka4 = *(const f32x4*)(p.k_a + h * 64 + (lane & 15) * 4), c04 = 1.0f - ka4;
        float S[64]; int ln = lane; asm volatile("" : "+v"(ln));
#define SB __builtin_amdgcn_sched_barrier(0)
#define LDX(base, o_) (*(const f32x4*)((const char*)((base) + (o_)) + lo16))
        if (!isP) {
#pragma unroll
            for (int i = 0; i < 64; ++i) S[i] = 0.f;
#define LD1(set, s) { const long o_ = (long)min((int)(s), LC - 1) * stp; set.w = LDX(wq, o_); set.a = LDX(aq, o_); set.b = LDX(bq, o_); set.kw = *(const u32x2*)((const char*)(kq + o_) + lo8); set.v = *(const u16*)((const char*)(vq + o_) + lo2); }
#define TOUCH1(set) asm volatile("" :: "v"(set.w), "v"(set.a), "v"(set.b), "v"(set.kw), "v"(set.v))
#define ST1(set) { DERIVE_BK(set); float s0 = 0.f, s1 = 0.f; ScanK<0>::dot(S, set.a, s0, s1); ScanK<0>::updS(S, set, s0 + s1, __uint_as_float(set.v << 16)); }
            In1 i0, i1; LD1(i0, 0);
#pragma unroll 1
            for (int s = 0; s < LC; s += 2) { TOUCH1(i0); SB; LD1(i1, s + 1); SB; ST1(i0); TOUCH1(i1); SB; LD1(i0, s + 2); SB; ST1(i1); }
#undef LD1
#undef TOUCH1
#undef ST1
        } else {
#pragma unroll
            for (int i = 0; i < 64; ++i) S[i] = (ln == i) ? 1.f : 0.f;
#define LD1(set, s) { const long o_ = (long)min((int)(s), LC - 1) * stp; set.w = LDX(wq, o_); set.a = LDX(aq, o_); set.b = LDX(bq, o_); }
#define TOUCH1(set) asm volatile("" :: "v"(set.w), "v"(set.a), "v"(set.b))
#define ST1(set) { DERIVE_B(set); float s0 = 0.f, s1 = 0.f; ScanK<0>::dot(S, set.a, s0, s1); ScanK<0>::updP(S, set, s0 + s1); }
            In1 i0, i1; LD1(i0, 0);
#pragma unroll 1
            for (int s = 0; s < LC; s += 2) { TOUCH1(i0); SB; LD1(i1, s + 1); SB; ST1(i0); TOUCH1(i1); SB; LD1(i0, s + 2); SB; ST1(i1); }
#undef LD1
#undef TOUCH1
#undef ST1
        }
        float* po = (isP ? PT : SLT) + ((size_t)(bh * NC + c)) * 4096 + lane * 64;
#pragma unroll
        for (int i = 0; i < 16; ++i) *(f32x4*)(po + 4 * i) = (f32x4){S[4 * i], S[4 * i + 1], S[4 * i + 2], S[4 * i + 3]};
    }
}
template <int J> struct CombJ {
    static __device__ __forceinline__ void run(const LAS float* pl, float srow, float (&acc)[4]) {
        const f32x4 q = *(const LAS f32x4*)(pl + J * 64);
        fmac_bc<J>(acc[0], srow, q[0]); fmac_bc<J>(acc[1], srow, q[1]); fmac_bc<J>(acc[2], srow, q[2]); fmac_bc<J>(acc[3], srow, q[3]);
        if constexpr (J + 1 < 16) CombJ<J + 1>::run(pl, srow, acc);
    }
};
__device__ __forceinline__ void scan_combine(const Params& p, unsigned char* lds) {
    const int tid = threadIdx.x, lane = tid & 63, wid = __builtin_amdgcn_readfirstlane(tid >> 6), lq = lane >> 4, k4 = lane & 15;
    const float* PT = (const float*)(p.ws + O_PT); const float* SLT = (const float*)(p.ws + O_SLT); float* SIT = (float*)(p.ws + O_SIT);
    LAS float* pbuf = (LAS float*)(LAS unsigned char*)lds;
    LAS float* rowb = pbuf + 8192 + wid * 64;
    for (int item = blockIdx.x; item < 256; item += gridDim.x) {
        const int bh = item >> 3, row = (item & 7) * 8 + wid;
        const float* pt = PT + (size_t)bh * NC * 4096 + tid * 8; const float* st = SLT + (size_t)bh * NC * 4096 + row * 64 + k4 * 4; float* si = SIT + (size_t)bh * NC * 4096 + row * 64 + k4 * 4;
        __syncthreads();
        { const f32x4 pa = *(const f32x4*)pt, pb = *(const f32x4*)(pt + 4); *(LAS f32x4*)(pbuf + tid * 8) = pa; *(LAS f32x4*)(pbuf + tid * 8 + 4) = pb; }
#define PLD(A, B, ci) { const size_t o_ = (size_t)min((int)(ci), NC - 2) * 4096; A = *(const f32x4*)(pt + o_); B = *(const f32x4*)(pt + o_ + 4); }
#define SLD(Sv, ci) { Sv = *(const f32x4*)(st + (size_t)min((int)(ci), NC - 2) * 4096); }
        f32x4 pa0, pb0, pa1, pb1, pa2, pb2, sl0, sl1, sl2;
        PLD(pa0, pb0, 1); PLD(pa1, pb1, 2); PLD(pa2, pb2, 3); SLD(sl0, 0); SLD(sl1, 1); SLD(sl2, 2);
        float srow = 0.f;
        __syncthreads();
#define CSTEP(c, PA, PB, SLV) { \
            const LAS float* pl = pbuf + ((c) & 1) * 4096 + (lq * 16) * 64 + k4 * 4; \
            float ac[4] = {0.f, 0.f, 0.f, 0.f}; \
            CombJ<0>::run(pl, srow, ac); \
            _Pragma("unroll") for (int q = 0; q < 4; ++q) { ac[q] += __shfl_xor(ac[q], 16); ac[q] += __shfl_xor(ac[q], 32); } \
            const f32x4 acc = (f32x4){ac[0], ac[1], ac[2], ac[3]} + SLV; \
            if (lq == 0) { *(LAS f32x4*)(rowb + k4 * 4) = acc; *(f32x4*)(si + (size_t)((c) + 1) * 4096) = acc; } \
            srow = rowb[lane]; \
            { LAS float* pn = pbuf + (((c) + 1) & 1) * 4096 + tid * 8; *(LAS f32x4*)pn = PA; *(LAS f32x4*)(pn + 4) = PB; } \
            PLD(PA, PB, (c) + 4); SLD(SLV, (c) + 3); \
            __syncthreads(); }
#pragma unroll 1
        for (int c = 0; c < NC - 1; c += 3) { CSTEP(c, pa0, pb0, sl0); CSTEP(c + 1, pa1, pb1, sl1); CSTEP(c + 2, pa2, pb2, sl2); }
#undef CSTEP
#undef PLD
#undef SLD
    }
}
__device__ __forceinline__ void scan_pass2(const Params& p, int d) {
    const int lane = threadIdx.x & 63, wid = __builtin_amdgcn_readfirstlane(threadIdx.x >> 6); const unsigned lo16 = (lane & 15) * 16, lo2 = lane * 2, lo4b = lane * 4;
    const float* Wd = p.out; const float* Bd = p.out + (size_t)NTOK * RW; const u16* KB = (const u16*)(p.ws + O_K); const float* A = (const float*)(p.ws + O_A); const float* R = (const float*)(p.ws + O_R); const unsigned lo8 = (lane & 15) * 8;
    const u16* V = (const u16*)(p.ws + O_V); const float* SIT = (const float*)(p.ws + O_SIT); float* Y = (float*)(p.ws + O_Y);
    for (int item = blockIdx.x * 8 + wid; item < 32 * NC; item += gridDim.x * 8) {
        const int bh = item / NC, c = item - bh * NC, b = bh >> 4, h = bh & 15;
        const int t0 = d ? (SEQ - 1 - c * LC) : c * LC;
        const size_t off0 = ((size_t)(b * SEQ + t0)) * RW + h * 64; const long stp = d ? -(long)RW : (long)RW;
        const float *wq = Wd + off0, *aq = A + off0, *bq = Bd + off0, *rq = R + off0; const u16* kq = KB + off0; const u16* vq = V + off0; float* yq = Y + off0;
        const f32x4 ka4 = *(const f32x4*)(p.k_a + h * 64 + (lane & 15) * 4), c04 = 1.0f - ka4;
        float S[64];
        if (c == 0) {
#pragma unroll
            for (int i = 0; i < 64; ++i) S[i] = 0.f;
        } else { const float* si = SIT + ((size_t)(bh * NC + c)) * 4096 + lane * 64;
#pragma unroll
            for (int i = 0; i < 16; ++i) { const f32x4 q = *(const f32x4*)(si + 4 * i); S[4 * i] = q[0]; S[4 * i + 1] = q[1]; S[4 * i + 2] = q[2]; S[4 * i + 3] = q[3]; } }
#define LD2(set, s) { const long o_ = (long)min((int)(s), LC - 1) * stp; set.w = LDX(wq, o_); set.a = LDX(aq, o_); set.b = LDX(bq, o_); set.kw = *(const u32x2*)((const char*)(kq + o_) + lo8); \
            set.r = LDX(rq, o_); set.v = *(const u16*)((const char*)(vq + o_) + lo2); set.yo = d ? *(const float*)((const char*)(yq + o_) + lo4b) : 0.f; }
#define ST2(set, s) { DERIVE_BK(set); float s0 = 0.f, s1 = 0.f; ScanK<0>::dot(S, set.a, s0, s1); float y0 = set.yo, y1 = 0.f; ScanK<0>::upd(S, set, s0 + s1, __uint_as_float(set.v << 16), y0, y1); *(float*)((char*)(yq + (long)(s) * stp) + lo4b) = y0 + y1; }
#define TOUCH2(set) asm volatile("" :: "v"(set.w), "v"(set.a), "v"(set.b), "v"(set.kw), "v"(set.r), "v"(set.v), "v"(set.yo))
        In2 i0, i1; LD2(i0, 0);
#pragma unroll 1
        for (int s = 0; s < LC; s += 2) { TOUCH2(i0); SB; LD2(i1, s + 1); SB; ST2(i0, s); TOUCH2(i1); SB; LD2(i0, s + 2); SB; ST2(i1, s + 1); }
#undef LD2
#undef ST2
    }
}

__device__ __forceinline__ void post_phase(const Params& p) {
    const int lane = threadIdx.x & 63, wid = threadIdx.x >> 6;
    const float* Y = (const float*)(p.ws + O_Y); const u16* V = (const u16*)(p.ws + O_V); const u16* ZG = (const u16*)(p.ws + O_ZG); const float* BON = (const float*)(p.ws + O_BON);
    u16* MIX = (u16*)(p.ws + O_HN); u16* PB = (u16*)(p.ws + O_AL);
    for (int t = blockIdx.x * 8 + wid; t < NTOK; t += gridDim.x * 8) {
        const int c = lane * 16; const size_t o = (size_t)t * RW + c;
        float y[16], v[16], g[16]; float s = 0.f;
#pragma unroll
        for (int j4 = 0; j4 < 4; ++j4) { const f32x4 a = *(const f32x4*)(Y + o + j4 * 4); y[j4 * 4] = a[0]; y[j4 * 4 + 1] = a[1]; y[j4 * 4 + 2] = a[2]; y[j4 * 4 + 3] = a[3]; s += a[0] + a[1] + a[2] + a[3]; }
        ld16bf(V + o, v); ld16bf(ZG + o, g);
        s += __shfl_xor(s, 1); s += __shfl_xor(s, 2); const float mu = s * (1.0f / 64.0f);
        float q = 0.f;
#pragma unroll
        for (int j = 0; j < 16; ++j) { y[j] -= mu; q += y[j] * y[j]; }
        q += __shfl_xor(q, 1); q += __shfl_xor(q, 2); const float rs = rsqrtf(q * (1.0f / 64.0f) + 64e-5f);
        const float bon = BON[(size_t)t * 16 + (lane >> 2)];
        float outv[16];
#pragma unroll
        for (int j4 = 0; j4 < 4; ++j4) { const f32x4 lw = *(const f32x4*)(p.lnx_w + c + j4 * 4), lb = *(const f32x4*)(p.lnx_b + c + j4 * 4);
#pragma unroll
            for (int j = 0; j < 4; ++j) { const int i = j4 * 4 + j; const float yn = y[i] * rs * lw[j] + lb[j]; outv[i] = (yn + bon * v[i]) * g[i] * sigmoidf_(g[i]); } }
        st16bf(MIX + (size_t)t * DM + c, outv);
        { const f32x4 pv = *(const f32x4*)(p.p + (size_t)t * 256 + lane * 4); u32x2 w; w.x = cvt_pk_bf16(pv[0], pv[1]); w.y = cvt_pk_bf16(pv[2], pv[3]); *(u32x2*)(PB + (size_t)t * 256 + lane * 4) = w; }
    }
}

#define XB_TMO      128
#define XB_XCNT(j)  (256  + 64 * (j))
#define XB_XSUB(j)  (1280 + 64 * (j))
#define XB_XGEN(j)  (2304 + 64 * (j))
#define XB_TOP      3328
#define XB_TOPGEN   3392
#define XCD_BAR_WORDS 3456
#define XB_SPIN_CAP (1u << 18)
__device__ __forceinline__ unsigned xb_ld(unsigned* p)              { return __hip_atomic_load(p, __ATOMIC_RELAXED, __HIP_MEMORY_SCOPE_AGENT); }
__device__ __forceinline__ unsigned xb_add(unsigned* p, unsigned v) { return __hip_atomic_fetch_add(p, v, __ATOMIC_RELAXED, __HIP_MEMORY_SCOPE_AGENT); }
__device__ __forceinline__ unsigned xb_xcc_id() { return (unsigned)__builtin_amdgcn_s_getreg((3 << 11) | 20) & 0xFu; }
#define XB_SPIN(cond, bar) do { unsigned _sp = 0; while (cond) { __builtin_amdgcn_s_sleep(1); \
    if ((++_sp & 255u) == 0u) { if (xb_ld(&(bar)[XB_TMO])) break; if (_sp > XB_SPIN_CAP) { atomicAdd(&(bar)[XB_TMO], 1u); break; } } } } while (0)
struct XcdBarrier { unsigned* bar; unsigned x; volatile LAS unsigned* st; };
__device__ __forceinline__ XcdBarrier xcd_barrier_post(unsigned* bar, volatile LAS unsigned* st) {
    XcdBarrier b; b.bar = bar; b.x = xb_xcc_id(); b.st = st;
    if (threadIdx.x == 0) (void)xb_add(&bar[XB_XCNT(b.x)], 1u);
    return b;
}
__device__ __forceinline__ void xcd_barrier_complete(unsigned* bar, unsigned x, unsigned& nloc, unsigned& nx) {
    const unsigned G = gridDim.x * gridDim.y * gridDim.z;
    unsigned sum, cnt, mine, sp = 0u;
    for (;;) {
        sum = 0u; cnt = 0u; mine = 0u;
#pragma unroll
        for (unsigned j = 0; j < 16; ++j) { const unsigned c = xb_ld(&bar[XB_XCNT(j)]); sum += c; cnt += (c > 0u) ? 1u : 0u; mine = (j == x) ? c : mine; }
        if (sum == G) break;
        __builtin_amdgcn_s_sleep(1);
        if ((++sp & 255u) == 0u) { if (xb_ld(&bar[XB_TMO])) break; if (sp > XB_SPIN_CAP) { atomicAdd(&bar[XB_TMO], 1u); break; } }
    }
    nloc = mine > 0u ? mine : 1u; nx = cnt > 0u ? cnt : 1u;
}
__device__ __forceinline__ void xcd_barrier(const XcdBarrier& b) {
    asm volatile("s_waitcnt vmcnt(0)" ::: "memory");
    __syncthreads();
    if (threadIdx.x == 0) {
        unsigned* bar = b.bar;
        __builtin_amdgcn_s_waitcnt(0);
        unsigned nloc = b.st[0], nx = b.st[1];
        if (nloc == 0u) { xcd_barrier_complete(bar, b.x, nloc, nx); b.st[0] = nloc; b.st[1] = nx; }
        const unsigned old = xb_add(&bar[XB_XSUB(b.x)], 1u);
        const unsigned gen = old / nloc;
        if (old + 1u == (gen + 1u) * nloc) {
            __builtin_amdgcn_fence(__ATOMIC_RELEASE, "agent");
            asm volatile("s_waitcnt vmcnt(0)" ::: "memory");
            const unsigned og = xb_add(&bar[XB_TOP], 1u);
            const unsigned tg = og / nx;
            if (og + 1u == (tg + 1u) * nx) xb_add(&bar[XB_TOPGEN], 1u);
            else XB_SPIN(xb_ld(&bar[XB_TOPGEN]) == tg, bar);
            __builtin_amdgcn_fence(__ATOMIC_ACQUIRE, "agent");
            xb_add(&bar[XB_XGEN(b.x)], 1u);
            asm volatile("s_waitcnt vmcnt(0)" ::: "memory");
        } else {
            XB_SPIN(xb_ld(&bar[XB_XGEN(b.x)]) == gen, bar);
            __builtin_amdgcn_fence(__ATOMIC_ACQUIRE, "agent");
            asm volatile("s_waitcnt vmcnt(0)" ::: "memory");
        }
    }
    __syncthreads();
}

__global__ void __launch_bounds__(NTHREADS, 2) mega(Params p) {
    extern __shared__ __attribute__((aligned(16))) unsigned char lds[];
    cg::grid_group grid = cg::this_grid();
    unsigned char* ws = p.ws;
    volatile LAS unsigned* xbw = (volatile LAS unsigned*)((LAS unsigned char*)lds + LDS_XB);
    if (threadIdx.x < 4) xbw[threadIdx.x] = 0u;
    __syncthreads();
    const XcdBarrier xbar = xcd_barrier_post((unsigned*)(ws + O_BAR), xbw);
#define PH_ON(n) (p.ph_lo <= (n) && (n) < p.ph_hi)
#define PH_END(n) do { if ((n) + 1 < p.ph_hi) { if ((n) == 0) grid.sync(); else xcd_barrier(xbar); } } while (0)
#ifndef PROBE_PH
#define PROBE_PH -1
#endif
#define RUN(n, ...) if (PH_ON(n)) { __VA_ARGS__ if (PROBE_PH == (n)) { __syncthreads(); __VA_ARGS__ } PH_END(n); }
    RUN(0,
        transpose_cvt(p.w_in, 2048, 8448, (u16*)(ws + O_W1T), 2048, (float*)lds);
        transpose_cvt(p.w_out, 2048, 2048, (u16*)(ws + O_W2T), 2048, (float*)lds);
        transpose_cvt(p.w_ple_gate, 2048, 2048, (u16*)(ws + O_W3T), 2048, (float*)lds);
        transpose_cvt(p.w_ple_proj, 256, 2048, (u16*)(ws + O_WPT), 256, (float*)lds);
        build_wlt(p);
        rownorm<true>(p.x, p.norm_mix_g, ws + O_HN);)
    RUN(1, {
        EpiZ e; e.zs = (u16*)(ws + O_ZS); e.zg = (u16*)(ws + O_ZG); e.qn = (u16*)p.out; e.kn = e.qn + (size_t)NTOK * RW; e.vt = e.kn + (size_t)NTOK * RW; e.gn = e.vt + (size_t)NTOK * RW;
        run_gemm(lds, (const u16*)(ws + O_HN), (const u16*)(ws + O_W1T), NTOK, 8448, 2048, e); })
    RUN(2, if (threadIdx.x < 256) { nat_phase(p, (float*)lds); prep_phase(p); } else { prep_phase(p); nat_phase(p, (float*)lds); })
#define SCAN_DIR(d, pb) \
    RUN(pb, { \
        EpiLora e; e.w0 = p.decay_w0 + (d) * RW; e.a0 = p.iclr_a0 + (d) * RW; e.Wd = p.out; e.IC = p.out + (size_t)NTOK * RW; \
        run_gemm(lds, (const u16*)(ws + O_AL), (const u16*)(ws + O_WLT) + (size_t)(d) * 2048 * 256, NTOK, 2048, 256, e); }) \
    RUN(pb + 1, scan_pass1(p, d);) \
    RUN(pb + 2, scan_combine(p, lds);) \
    RUN(pb + 3, scan_pass2(p, d);)
    SCAN_DIR(0, 3)
    SCAN_DIR(1, 7)
    RUN(11, post_phase(p);)
    RUN(12, {
        EpiH e; e.X = p.x; e.H = p.out;
        run_gemm(lds, (const u16*)(ws + O_HN), (const u16*)(ws + O_W2T), NTOK, 2048, 2048, e);
        EpiBf e2; e2.O = (u16*)(ws + O_R); e2.ld = DM;
        run_gemm(lds, (const u16*)(ws + O_AL), (const u16*)(ws + O_WPT), NTOK, 2048, 256, e2); })
    RUN(13, rownorm<true>(p.out, p.ple_norm_g, ws + O_HN);)
    RUN(14, {
        EpiGate e; e.H = p.out; e.PP = (const u16*)(ws + O_R);
        run_gemm(lds, (const u16*)(ws + O_HN), (const u16*)(ws + O_W3T), NTOK, 2048, 2048, e); })
    RUN(15, rownorm<false>(p.out, p.final_g, p.out);)
}

extern "C" void kernel_launch(void* const* d_in, const int* in_sizes, int n_in, void* d_out, int out_size, void* d_ws, size_t ws_size, hipStream_t stream) {
    static int grid = 0;
    if (grid == 0) {
        if (n_in != 21 || out_size != NTOK * DM || ws_size < WS_END) { fprintf(stderr, "kernel_launch: unexpected shapes (n_in %d out %d ws %zu need %zu)\n", n_in, out_size, ws_size, (size_t)WS_END); grid = -1; return; }
        int dev = 0, cus = 0, per_cu = 0;
        hipGetDevice(&dev); hipDeviceGetAttribute(&cus, hipDeviceAttributeMultiprocessorCount, dev);
        hipFuncSetAttribute((const void*)mega, hipFuncAttributeMaxDynamicSharedMemorySize, LDS_BYTES);
        hipOccupancyMaxActiveBlocksPerMultiprocessor(&per_cu, (const void*)mega, NTHREADS, LDS_BYTES);
        if (per_cu < 1) { fprintf(stderr, "kernel_launch: occupancy query says %d blocks/CU\n", per_cu); grid = -1; return; }
        grid = cus;
    }
    if (grid < 0) return;
    Params p{};
    const float** f = (const float**)&p;
    for (int i = 0; i < 21; ++i) f[i] = (const float*)d_in[i];
    p.out = (float*)d_out; p.ws = (unsigned char*)d_ws;
    hipMemsetAsync((unsigned char*)d_ws + O_BAR, 0, XCD_BAR_WORDS * sizeof(unsigned), stream);
#if MULTI_LAUNCH
    for (int ph = 0; ph < 16; ++ph) { p.ph_lo = ph; p.ph_hi = ph + 1; hipLaunchKernelGGL(mega, dim3(grid), dim3(NTHREADS), LDS_BYTES, stream, p); }
#else
    p.ph_lo = 0; p.ph_hi = 16;
    void* args[] = {&p};
    hipError_t e = hipLaunchCooperativeKernel((const void*)mega, dim3(grid), dim3(NTHREADS), args, LDS_BYTES, stream);
    if (e != hipSuccess) fprintf(stderr, "cooperative launch failed: %s (grid %d)\n", hipGetErrorString(e), grid);
#endif
}
```

```cpp
#include <hip/hip_runtime.h>
#include <hip/hip_cooperative_groups.h>
#include <cstdio>
namespace cg = cooperative_groups;

#ifndef MULTI_LAUNCH
#define MULTI_LAUNCH 0
#endif

#define LAS __attribute__((address_space(3)))
typedef unsigned short u16;
typedef short bf16x8 __attribute__((ext_vector_type(8)));
typedef float f32x4 __attribute__((ext_vector_type(4)));
typedef float f32x2 __attribute__((ext_vector_type(2)));
typedef unsigned u32x4 __attribute__((ext_vector_type(4)));
typedef unsigned u32x2 __attribute__((ext_vector_type(2)));
typedef const __attribute__((address_space(4))) f32x2* cf2p;

constexpr int SEQ = 16384, NTOK = 32768, DM = 2048, RW = 1024;
constexpr int NC = 64, LC = SEQ / NC;
constexpr int NTHREADS = 512, LDS_XB = 131072, LDS_BYTES = 131072 + 16;
constexpr float DECAY_SCALE = 0.6065306597126334f;

constexpr size_t MiB = 1ull << 20;
constexpr size_t O_W1T = 0, O_W2T = 33 * MiB, O_W3T = 41 * MiB, O_WPT = 49 * MiB, O_WLT = 50 * MiB;
constexpr size_t O_HN = 56 * MiB;
constexpr size_t O_ZS = 184 * MiB;
constexpr size_t O_KD = O_ZS, O_PT = O_ZS + 128 * MiB, O_SLT = O_ZS + 160 * MiB;
constexpr size_t O_ZG = 392 * MiB;
constexpr size_t O_R = 456 * MiB;
constexpr size_t O_A = 584 * MiB;
constexpr size_t O_V = 712 * MiB;
constexpr size_t O_K = 776 * MiB;
constexpr size_t O_AL = 840 * MiB;
constexpr size_t O_BON = 856 * MiB;
constexpr size_t O_Y = 858 * MiB;
constexpr size_t O_SIT = 986 * MiB;
constexpr size_t O_BAR = 1018 * MiB;
constexpr size_t WS_END = 1019 * MiB;

struct Params {
    const float *x, *p, *norm_mix_g, *w_in, *mu_prev, *mu_next, *decay_w0, *decay_w2, *iclr_a0, *iclr_a2, *k_k, *k_a, *r_k, *lnx_w, *lnx_b, *rpb, *w_out,
        *ple_norm_g, *w_ple_gate, *w_ple_proj, *final_g;
    float* out; unsigned char* ws;
    int ph_lo, ph_hi;
};

__device__ __forceinline__ float bf2f(u16 b) { return __uint_as_float(((unsigned)b) << 16); }
__device__ __forceinline__ float bflo(unsigned w) { return __uint_as_float(w << 16); }
__device__ __forceinline__ float bfhi(unsigned w) { return __uint_as_float(w & 0xffff0000u); }
__device__ __forceinline__ unsigned cvt_pk_bf16(float lo, float hi) { unsigned r; asm volatile("v_cvt_pk_bf16_f32 %0, %1, %2" : "=v"(r) : "v"(lo), "v"(hi)); return r; }
__device__ __forceinline__ float sigmoidf_(float x) { return __builtin_amdgcn_rcpf(1.0f + __expf(-x)); }
__device__ __forceinline__ f32x2 fma2(f32x2 a, f32x2 b, f32x2 c) { return __builtin_elementwise_fma(a, b, c); }

namespace pg8 {
constexpr int BM = 256, BK = 64, HALF = 128, HTB = HALF * BK * 2, NXCD = 8, WGM = 8;
__device__ __forceinline__ int lds_byte(int r, int c) { const int st = (r >> 4) * 2 + (c >> 5), rr = r & 15, cc = c & 31, ob = rr * 64 + cc * 2; return st * 1024 + (ob ^ (((ob >> 9) & 1) << 5)); }
__device__ __forceinline__ void stage_rc(int b, int& R, int& C) { const int st = b / 1024, sb = b % 1024, swz = sb ^ (((sb >> 9) & 1) << 5); R = (st >> 1) * 16 + swz / 64; C = (st & 1) * 32 + (swz % 64) / 2; }
__device__ __forceinline__ int perm32(int rho) { const int n = rho >> 4, i = rho & 15; return 8 * (i >> 2) + 4 * n + (i & 3); }
struct Unit { int pm, pn; };
struct Gemm { const u16* A; const u16* Bt; int M, N, K; };
struct StaticOrder {
    int nM, nN, nwg, G, c;
    __device__ void init(int M, int N, int G_, int c_) { nM = M / BM; nN = N / BM; nwg = nM * nN; G = G_; c = c_; }
    __device__ bool next(int i, Unit& u) const {
        const long L = (long)i * G + c; if (L >= nwg) return false;
        int wgid = (int)L; { const int q = nwg / NXCD, r = nwg % NXCD, xcd = wgid % NXCD, off = wgid / NXCD; wgid = (xcd < r ? xcd * (q + 1) : r * (q + 1) + (xcd - r) * q) + off; }
        const int nig = WGM * nN, gid = wgid / nig, fm = gid * WGM, gsz = (nM - fm) < WGM ? (nM - fm) : WGM;
        u.pm = fm + ((wgid % nig) % gsz); u.pn = (wgid % nig) / gsz; return true;
    }
};
template <class Epi>
__device__ __forceinline__ void gemm_phase(LAS unsigned char* lds, const Gemm g, const StaticOrder& S, const Epi& E) {
    const int tid = threadIdx.x, wid = __builtin_amdgcn_readfirstlane(tid >> 6), lane = tid & 63, wr = wid >> 2, wc = wid & 3, fr = lane & 15, fq = lane >> 4;
    const int K = g.K, nt = K / BK;
    unsigned voffA[2], voffB[2];
#pragma unroll
    for (int i = 0; i < 2; ++i) { int R, C; stage_rc(tid * 16 + i * 8192, R, C); const int Rb = Epi::PERM ? ((R & ~31) + perm32(R & 31)) : R;
        voffA[i] = (unsigned)(R * K + C) * 2u; voffB[i] = (unsigned)(Rb * K + C) * 2u; }
    const size_t kstep = (size_t)(BK * 2);
    const size_t hstep = (size_t)HALF * K * 2;
    const size_t tstep = 2 * hstep;
    const unsigned ldsw = (unsigned)wid * 1024u;
    const int aoff = lds_byte(wr * 64 + fr, fq * 8), boff = lds_byte(wc * 32 + fr, fq * 8);
#define PG8_SA(b, h) (((b) * 2 + (h)) * HTB)
#define PG8_SB(b, h) ((4 + (b) * 2 + (h)) * HTB)
#define PG8_STAGE(bufoff, gbase, voff) do { _Pragma("unroll") for (int _i = 0; _i < 2; ++_i) \
        __builtin_amdgcn_global_load_lds((const unsigned*)((const char*)(gbase) + (voff)[_i]), (LAS unsigned*)(lds + (bufoff) + ldsw + _i * 8192), 16, 0, 0); } while (0)
#define PG8_LDA(dst, b, h) do { _Pragma("unroll") for (int m = 0; m < 4; ++m) _Pragma("unroll") for (int k = 0; k < 2; ++k) dst[m][k] = *(const LAS bf16x8*)(lds + PG8_SA(b, h) + aoff + m * 2048 + k * 1024); } while (0)
#define PG8_LDB(dst, b, h) do { _Pragma("unroll") for (int n = 0; n < 2; ++n) _Pragma("unroll") for (int k = 0; k < 2; ++k) dst[n][k] = *(const LAS bf16x8*)(lds + PG8_SB(b, h) + boff + n * 2048 + k * 1024); } while (0)
#define PG8_MMA(ai, bj, At, Bt) do { __builtin_amdgcn_s_setprio(1); _Pragma("unroll") for (int m = 0; m < 4; ++m) _Pragma("unroll") for (int n = 0; n < 2; ++n) _Pragma("unroll") for (int k = 0; k < 2; ++k) \
        acc[ai][bj][m][n] = __builtin_amdgcn_mfma_f32_16x16x32_bf16(Bt[n][k], At[m][k], acc[ai][bj][m][n], 0, 0, 0); __builtin_amdgcn_s_setprio(0); } while (0)
#define PG8_WAIT_V(n) asm volatile("s_waitcnt vmcnt(" #n ")" ::: "memory")
#define PG8_WAIT_L(n) asm volatile("s_waitcnt lgkmcnt(" #n ")" ::: "memory")
#define PG8_BAR __builtin_amdgcn_s_barrier()
#define PG8_SCHED __builtin_amdgcn_sched_barrier(0)
    Unit cur, nxt; int ui = 0;
    if (!S.next(0, cur)) return;
    f32x4 acc[2][2][4][2];
#pragma unroll
    for (int a = 0; a < 2; ++a)
#pragma unroll
        for (int b = 0; b < 2; ++b)
#pragma unroll
            for (int m = 0; m < 4; ++m)
#pragma unroll
                for (int n = 0; n < 2; ++n) acc[a][b][m][n] = (f32x4){0.f, 0.f, 0.f, 0.f};
    bf16x8 At[4][2], B0[2][2], B1[2][2];
    const char* cA = (const char*)g.A + (size_t)cur.pm * tstep; const char* cB = (const char*)g.Bt + (size_t)cur.pn * tstep;
    PG8_STAGE(PG8_SB(0, 0), cB, voffB); PG8_STAGE(PG8_SA(0, 0), cA, voffA); PG8_STAGE(PG8_SB(0, 1), cB + hstep, voffB); PG8_STAGE(PG8_SA(0, 1), cA + hstep, voffA);
    if (wr == 1) PG8_BAR;
    PG8_WAIT_V(4); PG8_BAR;
    PG8_STAGE(PG8_SB(1, 0), cB + kstep, voffB); PG8_STAGE(PG8_SA(1, 0), cA + kstep, voffA); PG8_STAGE(PG8_SB(1, 1), cB + hstep + kstep, voffB);
    PG8_WAIT_V(6); PG8_BAR;
    for (;;) {
        const bool has_next = S.next(ui + 1, nxt);
        const char* nA = has_next ? (const char*)g.A + (size_t)nxt.pm * tstep : cA; const char* nB = has_next ? (const char*)g.Bt + (size_t)nxt.pn * tstep : cB;
        for (int t = 0; t < nt; t += 2) {
            const bool last = (t == nt - 2);
            const char* a1 = cA + (size_t)(t + 1) * kstep;
            const char* a2 = last ? nA : cA + (size_t)(t + 2) * kstep; const char* b2 = last ? nB : cB + (size_t)(t + 2) * kstep;
            const char* a3 = a2 + kstep; const char* b3 = b2 + kstep;
            PG8_LDB(B0, 0, 0); PG8_SCHED; PG8_LDA(At, 0, 0); PG8_STAGE(PG8_SA(1, 1), a1 + hstep, voffA);
            PG8_WAIT_L(8); PG8_BAR; PG8_WAIT_L(0); PG8_MMA(0, 0, At, B0); PG8_BAR; PG8_SCHED;
            PG8_LDB(B1, 0, 1); PG8_STAGE(PG8_SB(0, 0), b2, voffB);
            PG8_BAR; PG8_WAIT_L(0); PG8_MMA(0, 1, At, B1); PG8_BAR;
            PG8_LDA(At, 0, 1); PG8_STAGE(PG8_SA(0, 0), a2, voffA);
            PG8_BAR; PG8_WAIT_L(0); PG8_MMA(1, 0, At, B0); PG8_BAR; PG8_SCHED;
            PG8_STAGE(PG8_SB(0, 1), b2 + hstep, voffB);
            PG8_WAIT_V(6); PG8_BAR; PG8_MMA(1, 1, At, B1); PG8_BAR;
            PG8_LDB(B0, 1, 0); PG8_SCHED; PG8_LDA(At, 1, 0); PG8_STAGE(PG8_SA(0, 1), a2 + hstep, voffA);
            PG8_WAIT_L(8); PG8_BAR; PG8_WAIT_L(0); PG8_MMA(0, 0, At, B0); PG8_BAR; PG8_SCHED;
            PG8_LDB(B1, 1, 1); PG8_STAGE(PG8_SB(1, 0), b3, voffB);
            PG8_BAR; PG8_WAIT_L(0); PG8_MMA(0, 1, At, B1); PG8_BAR;
            PG8_LDA(At, 1, 1); PG8_STAGE(PG8_SA(1, 0), a3, voffA);
            PG8_BAR; PG8_WAIT_L(0); PG8_MMA(1, 0, At, B0); PG8_BAR; PG8_SCHED;
            PG8_STAGE(PG8_SB(1, 1), b3 + hstep, voffB);
            PG8_WAIT_V(6); PG8_BAR; PG8_MMA(1, 1, At, B1); PG8_BAR;
        }
        E(acc, cur, wr, wc, fr, fq);
        if (!has_next) break;
#pragma unroll
        for (int a = 0; a < 2; ++a)
#pragma unroll
            for (int b = 0; b < 2; ++b)
#pragma unroll
                for (int m = 0; m < 4; ++m)
#pragma unroll
                    for (int n = 0; n < 2; ++n) acc[a][b][m][n] = (f32x4){0.f, 0.f, 0.f, 0.f};
        cur = nxt; cA = nA; cB = nB; ++ui;
    }
    PG8_WAIT_V(0);
    if (wr == 0) PG8_BAR;
    PG8_BAR;
#undef PG8_SA
#undef PG8_SB
#undef PG8_STAGE
#undef PG8_LDA
#undef PG8_LDB
#undef PG8_MMA
#undef PG8_WAIT_V
#undef PG8_WAIT_L
#undef PG8_BAR
#undef PG8_SCHED
}
}
using pg8::Unit;
typedef f32x4 AccT[2][2][4][2];

struct EpiZ {
    static constexpr bool PERM = true;
    u16 *zs, *zg, *qn, *kn, *vt, *gn;
    __device__ __forceinline__ void operator()(const AccT& acc, const Unit& u, int wr, int wc, int fr, int fq) const {
        const int row0 = u.pm * 256 + wr * 64 + fr; const int pn = u.pn;
        if (pn >= 25 && pn < 29) {
            const int cb = (pn - 25) * 256 + wc * 32 + 8 * fq;
#pragma unroll
            for (int ai = 0; ai < 2; ++ai)
#pragma unroll
                for (int m = 0; m < 4; ++m) { const int row = row0 + ai * 128 + m * 16; const int b = row >> 14, tt = row & (SEQ - 1);
#pragma unroll
                    for (int bj = 0; bj < 2; ++bj)
#pragma unroll
                        for (int n = 0; n < 2; ++n)
#pragma unroll
                            for (int j = 0; j < 4; ++j) { const int ch = cb + bj * 128 + 4 * n + j;
                                vt[((size_t)(b * 1024 + ch)) * SEQ + tt] = (u16)(cvt_pk_bf16(acc[ai][bj][m][n][j], 0.f) & 0xffffu); } }
            return;
        }
        u16* base; int ld, colt;
        if (pn < 13) { base = zs; ld = 3328; colt = pn * 256; }
        else if (pn < 17) { base = zg; ld = 1024; colt = (pn - 13) * 256; }
        else if (pn < 21) { base = qn; ld = 1024; colt = (pn - 17) * 256; }
        else if (pn < 25) { base = kn; ld = 1024; colt = (pn - 21) * 256; }
        else { base = gn; ld = 1024; colt = (pn - 29) * 256; }
        const int col0 = colt + wc * 32 + 8 * fq;
#pragma unroll
        for (int ai = 0; ai < 2; ++ai)
#pragma unroll
            for (int m = 0; m < 4; ++m) { u16* rowp = base + (size_t)(row0 + ai * 128 + m * 16) * ld + col0;
#pragma unroll
                for (int bj = 0; bj < 2; ++bj) { const f32x4 v0 = acc[ai][bj][m][0], v1 = acc[ai][bj][m][1];
                    u32x4 w; w.x = cvt_pk_bf16(v0[0], v0[1]); w.y = cvt_pk_bf16(v0[2], v0[3]); w.z = cvt_pk_bf16(v1[0], v1[1]); w.w = cvt_pk_bf16(v1[2], v1[3]);
                    *(u32x4*)(rowp + bj * 128) = w; } }
    }
};
struct EpiBf {
    static constexpr bool PERM = true;
    u16* O; int ld;
    __device__ __forceinline__ void operator()(const AccT& acc, const Unit& u, int wr, int wc, int fr, int fq) const {
        const int row0 = u.pm * 256 + wr * 64 + fr, col0 = u.pn * 256 + wc * 32 + 8 * fq;
#pragma unroll
        for (int ai = 0; ai < 2; ++ai)
#pragma unroll
            for (int m = 0; m < 4; ++m) { u16* rowp = O + (size_t)(row0 + ai * 128 + m * 16) * ld + col0;
#pragma unroll
                for (int bj = 0; bj < 2; ++bj) { const f32x4 v0 = acc[ai][bj][m][0], v1 = acc[ai][bj][m][1];
                    u32x4 w; w.x = cvt_pk_bf16(v0[0], v0[1]); w.y = cvt_pk_bf16(v0[2], v0[3]); w.z = cvt_pk_bf16(v1[0], v1[1]); w.w = cvt_pk_bf16(v1[2], v1[3]);
                    *(u32x4*)(rowp + bj * 128) = w; } }
    }
};
struct EpiLora {
    static constexpr bool PERM = false;
    const float *w0, *a0; float *Wd, *IC;
    __device__ __forceinline__ void operator()(const AccT& acc, const Unit& u, int wr, int wc, int fr, int fq) const {
        const int row0 = u.pm * 256 + wr * 64 + fr, col0 = u.pn * 256 + wc * 32 + 4 * fq;
        if (u.pn < 4) {
#pragma unroll
            for (int bj = 0; bj < 2; ++bj)
#pragma unroll
                for (int n = 0; n < 2; ++n) { const int col = col0 + bj * 128 + n * 16; const f32x4 wv = *(const f32x4*)(w0 + col);
#pragma unroll
                    for (int ai = 0; ai < 2; ++ai)
#pragma unroll
                        for (int m = 0; m < 4; ++m) { const int row = row0 + ai * 128 + m * 16; f32x4 o;
#pragma unroll
                            for (int j = 0; j < 4; ++j) o[j] = __expf(-DECAY_SCALE * sigmoidf_(wv[j] + acc[ai][bj][m][n][j]));
                            *(f32x4*)(Wd + (size_t)row * RW + col) = o; asm volatile("" ::: "memory"); } }
        } else {
#pragma unroll
            for (int bj = 0; bj < 2; ++bj)
#pragma unroll
                for (int n = 0; n < 2; ++n) { const int col = col0 - 1024 + bj * 128 + n * 16; const f32x4 av0 = *(const f32x4*)(a0 + col);
#pragma unroll
                    for (int ai = 0; ai < 2; ++ai)
#pragma unroll
                        for (int m = 0; m < 4; ++m) { const int row = row0 + ai * 128 + m * 16; f32x4 o;
#pragma unroll
                            for (int j = 0; j < 4; ++j) o[j] = sigmoidf_(av0[j] + acc[ai][bj][m][n][j]);
                            *(f32x4*)(IC + (size_t)row * RW + col) = o; asm volatile("" ::: "memory"); } }
        }
    }
};
struct EpiH {
    static constexpr bool PERM = false;
    const float* X; float* H;
    __device__ __forceinline__ void operator()(const AccT& acc, const Unit& u, int wr, int wc, int fr, int fq) const {
        const int row0 = u.pm * 256 + wr * 64 + fr, col0 = u.pn * 256 + wc * 32 + 4 * fq;
#pragma unroll
        for (int ai = 0; ai < 2; ++ai)
#pragma unroll
            for (int m = 0; m < 4; ++m) { const size_t ro = (size_t)(row0 + ai * 128 + m * 16) * DM + col0;
#pragma unroll
                for (int bj = 0; bj < 2; ++bj)
#pragma unroll
                    for (int n = 0; n < 2; ++n) { const size_t o = ro + bj * 128 + n * 16; *(f32x4*)(H + o) = acc[ai][bj][m][n] + *(const f32x4*)(X + o); } asm volatile("" ::: "memory"); }
    }
};
struct EpiGate {
    static constexpr bool PERM = false;
    float* H; const u16* PP;
    __device__ __forceinline__ void operator()(const AccT& acc, const Unit& u, int wr, int wc, int fr, int fq) const {
        const int row0 = u.pm * 256 + wr * 64 + fr, col0 = u.pn * 256 + wc * 32 + 4 * fq;
#pragma unroll
        for (int ai = 0; ai < 2; ++ai)
#pragma unroll
            for (int m = 0; m < 4; ++m) { const size_t ro = (size_t)(row0 + ai * 128 + m * 16) * DM + col0;
#pragma unroll
                for (int bj = 0; bj < 2; ++bj)
#pragma unroll
                    for (int n = 0; n < 2; ++n) { const size_t o = ro + bj * 128 + n * 16; const f32x4 h = *(const f32x4*)(H + o); const u32x2 pw = *(const u32x2*)(PP + o);
                        const f32x4 a = acc[ai][bj][m][n]; f32x4 r;
                        r[0] = h[0] + bflo(pw.x) * sigmoidf_(a[0]); r[1] = h[1] + bfhi(pw.x) * sigmoidf_(a[1]); r[2] = h[2] + bflo(pw.y) * sigmoidf_(a[2]); r[3] = h[3] + bfhi(pw.y) * sigmoidf_(a[3]);
                        *(f32x4*)(H + o) = r; asm volatile("" ::: "memory"); } }
    }
};

template <class Epi> __device__ __forceinline__ void run_gemm(unsigned char* lds, const u16* A, const u16* Bt, int M, int N, int K, const Epi& E) {
    pg8::Gemm g; g.A = A; g.Bt = Bt; g.M = M; g.N = N; g.K = K;
    pg8::StaticOrder S; S.init(M, N, gridDim.x, blockIdx.x);
    pg8::gemm_phase<Epi>((LAS unsigned char*)lds, g, S, E);
    __syncthreads();
}

__device__ __forceinline__ void transpose_cvt(const float* __restrict__ src, int K, int N, u16* __restrict__ dst, int ldd, float* tile) {
    const int tid = threadIdx.x, tn = N / 64, ntile = (K / 64) * tn;
    for (int t = blockIdx.x; t < ntile; t += gridDim.x) {
        const int k0 = (t / tn) * 64, n0 = (t % tn) * 64;
#pragma unroll
        for (int ps = 0; ps < 2; ++ps) { const int r = (tid >> 4) + ps * 32, c4 = (tid & 15) * 4; const f32x4 v = *(const f32x4*)(src + (size_t)(k0 + r) * N + n0 + c4);
            tile[r * 65 + c4] = v[0]; tile[r * 65 + c4 + 1] = v[1]; tile[r * 65 + c4 + 2] = v[2]; tile[r * 65 + c4 + 3] = v[3]; }
        __syncthreads();
        { const int n = tid >> 3, ks = (tid & 7) * 8; u32x4 w;
          w.x = cvt_pk_bf16(tile[(ks + 0) * 65 + n], tile[(ks + 1) * 65 + n]); w.y = cvt_pk_bf16(tile[(ks + 2) * 65 + n], tile[(ks + 3) * 65 + n]);
          w.z = cvt_pk_bf16(tile[(ks + 4) * 65 + n], tile[(ks + 5) * 65 + n]); w.w = cvt_pk_bf16(tile[(ks + 6) * 65 + n], tile[(ks + 7) * 65 + n]);
          *(u32x4*)(dst + (size_t)(n0 + n) * ldd + k0 + ks) = w; }
        __syncthreads();
    }
}
__device__ __forceinline__ void build_wlt(const Params& p) {
    u16* W = (u16*)(p.ws + O_WLT);
    for (int i = blockIdx.x * NTHREADS + threadIdx.x; i < 2 * 2048 * 256; i += gridDim.x * NTHREADS) {
        const int k = i & 255, n = (i >> 8) & 2047, d = i >> 19; float v = 0.f;
        if (n < 1024) { if ((k >> 6) == d) v = p.decay_w2[((size_t)d * 64 + (k & 63)) * RW + n]; }
        else { if ((k >> 6) == 2 + d) v = p.iclr_a2[((size_t)d * 64 + (k & 63)) * RW + (n - 1024)]; }
        W[i] = (u16)(cvt_pk_bf16(v, 0.f) & 0xffffu);
    }
}
template <bool BF> __device__ __forceinline__ void rownorm(const float* src, const float* __restrict__ g, void* dst) {
    const int lane = threadIdx.x & 63, wid = threadIdx.x >> 6;
    for (int row = blockIdx.x * 8 + wid; row < NTOK; row += gridDim.x * 8) {
        const float* s = src + (size_t)row * DM + lane * 4; f32x4 v[8]; float ss = 0.f;
#pragma unroll
        for (int i = 0; i < 8; ++i) { v[i] = *(const f32x4*)(s + i * 256); ss += v[i][0] * v[i][0] + v[i][1] * v[i][1] + v[i][2] * v[i][2] + v[i][3] * v[i][3]; }
#pragma unroll
        for (int o = 32; o >= 1; o >>= 1) ss += __shfl_xor(ss, o);
        const float sc = rsqrtf(ss * (1.0f / DM) + 1e-6f);
#pragma unroll
        for (int i = 0; i < 8; ++i) { const f32x4 gv = *(const f32x4*)(g + lane * 4 + i * 256); const f32x4 o = v[i] * sc * gv;
            if (BF) { u32x2 w; w.x = cvt_pk_bf16(o[0], o[1]); w.y = cvt_pk_bf16(o[2], o[3]); *(u32x2*)((u16*)dst + (size_t)row * DM + lane * 4 + i * 256) = w; }
            else *(f32x4*)((float*)dst + (size_t)row * DM + lane * 4 + i * 256) = o; }
    }
}

__device__ __forceinline__ void ld16bf(const u16* p, float* o) {
    const u32x4 a = *(const u32x4*)p, b = *(const u32x4*)(p + 8);
    o[0] = bflo(a.x); o[1] = bfhi(a.x); o[2] = bflo(a.y); o[3] = bfhi(a.y); o[4] = bflo(a.z); o[5] = bfhi(a.z); o[6] = bflo(a.w); o[7] = bfhi(a.w);
    o[8] = bflo(b.x); o[9] = bfhi(b.x); o[10] = bflo(b.y); o[11] = bfhi(b.y); o[12] = bflo(b.z); o[13] = bfhi(b.z); o[14] = bflo(b.w); o[15] = bfhi(b.w);
}
__device__ __forceinline__ void st16bf(u16* p, const float* v) {
    u32x4 a, b; a.x = cvt_pk_bf16(v[0], v[1]); a.y = cvt_pk_bf16(v[2], v[3]); a.z = cvt_pk_bf16(v[4], v[5]); a.w = cvt_pk_bf16(v[6], v[7]);
    b.x = cvt_pk_bf16(v[8], v[9]); b.y = cvt_pk_bf16(v[10], v[11]); b.z = cvt_pk_bf16(v[12], v[13]); b.w = cvt_pk_bf16(v[14], v[15]);
    *(u32x4*)p = a; *(u32x4*)(p + 8) = b;
}
__device__ __forceinline__ void shift16(const u16* zc, bool hp, bool hn, const float* __restrict__ mp, const float* __restrict__ mn, int c, float* o) {
    float z[16], zp[16], zn[16]; ld16bf(zc + c, z);
    if (hp) ld16bf(zc - 3328 + c, zp); else {
#pragma unroll
        for (int j = 0; j < 16; ++j) zp[j] = 0.f; }
    if (hn) ld16bf(zc + 3328 + c, zn); else {
#pragma unroll
        for (int j = 0; j < 16; ++j) zn[j] = 0.f; }
#pragma unroll
    for (int j4 = 0; j4 < 4; ++j4) { const f32x4 a = *(const f32x4*)(mp + c + j4 * 4), b = *(const f32x4*)(mn + c + j4 * 4);
#pragma unroll
        for (int j = 0; j < 4; ++j) { const int q = j4 * 4 + j; o[q] = z[q] + a[j] * (zp[q] - z[q]) + b[j] * (zn[q] - z[q]); } }
}
struct Z16 { u32x4 a, b; };
__device__ __forceinline__ Z16 ldz(const u16* p) { Z16 z; z.a = *(const u32x4*)p; z.b = *(const u32x4*)(p + 8); return z; }
__device__ __forceinline__ Z16 zz() { Z16 z; z.a = (u32x4){0u, 0u, 0u, 0u}; z.b = z.a; return z; }
__device__ __forceinline__ void unz(const Z16& z, float* o) {
    o[0] = bflo(z.a.x); o[1] = bfhi(z.a.x); o[2] = bflo(z.a.y); o[3] = bfhi(z.a.y); o[4] = bflo(z.a.z); o[5] = bfhi(z.a.z); o[6] = bflo(z.a.w); o[7] = bfhi(z.a.w);
    o[8] = bflo(z.b.x); o[9] = bfhi(z.b.x); o[10] = bflo(z.b.y); o[11] = bfhi(z.b.y); o[12] = bflo(z.b.z); o[13] = bfhi(z.b.z); o[14] = bflo(z.b.w); o[15] = bfhi(z.b.w);
}
__device__ __forceinline__ void ld16f(const float* p, float* o) {
#pragma unroll
    for (int j = 0; j < 4; ++j) { const f32x4 v = *(const f32x4*)(p + 4 * j); o[4 * j] = v[0]; o[4 * j + 1] = v[1]; o[4 * j + 2] = v[2]; o[4 * j + 3] = v[3]; }
}
__device__ __forceinline__ void mix16(const Z16& zp, const Z16& zc, const Z16& zn, const float* mp, const float* mn, float* o) {
    float p_[16], c_[16], n_[16]; unz(zp, p_); unz(zc, c_); unz(zn, n_);
#pragma unroll
    for (int q = 0; q < 16; ++q) o[q] = c_[q] + mp[q] * (p_[q] - c_[q]) + mn[q] * (n_[q] - c_[q]);
}
__device__ __forceinline__ void prep_phase(const Params& p) {
    const int lane = threadIdx.x & 63, wid = threadIdx.x >> 6, c = lane * 16;
    const u16* ZS = (const u16*)(p.ws + O_ZS);
    float* R = (float*)(p.ws + O_R); float* A = (float*)(p.ws + O_A); u16* V = (u16*)(p.ws + O_V); u16* Kb = (u16*)(p.ws + O_K); u16* AL = (u16*)(p.ws + O_AL); float* BON = (float*)(p.ws + O_BON);
    for (int t0 = (blockIdx.x * 8 + wid) * 16; t0 < NTOK; t0 += gridDim.x * 8 * 16) {
        const int tt0 = t0 & (SEQ - 1);
        {
            float mpk[16], mnk[16], kkc[16]; ld16f(p.mu_prev + 1024 + c, mpk); ld16f(p.mu_next + 1024 + c, mnk); ld16f(p.k_k + c, kkc);
            const u16* zc = ZS + (size_t)t0 * 3328 + 1024 + c;
            Z16 kp = tt0 > 0 ? ldz(zc - 3328) : zz(), kc = ldz(zc);
#pragma unroll 2
            for (int i = 0; i < 16; ++i) {
                const bool hn = (tt0 + i) < SEQ - 1; const Z16 kn = hn ? ldz(zc + (size_t)(i + 1) * 3328) : zz();
                float k[16], kk[16]; mix16(kp, kc, kn, mpk, mnk, k);
                float s2 = 0.f;
#pragma unroll
                for (int q = 0; q < 16; ++q) { kk[q] = k[q] * kkc[q]; s2 += kk[q] * kk[q]; }
                s2 += __shfl_xor(s2, 1); s2 += __shfl_xor(s2, 2);
                const float inv = -1.0f / fmaxf(sqrtf(s2), 1e-12f);
                const size_t o = (size_t)(t0 + i) * RW + c;
#pragma unroll
                for (int j4 = 0; j4 < 4; ++j4) *(f32x4*)(A + o + j4 * 4) = (f32x4){kk[j4 * 4] * inv, kk[j4 * 4 + 1] * inv, kk[j4 * 4 + 2] * inv, kk[j4 * 4 + 3] * inv};
                st16bf(Kb + o, k);
                kp = kc; kc = kn;
            }
        }
        {
            float mpr[16], mnr[16], rkc[16]; ld16f(p.mu_prev + c, mpr); ld16f(p.mu_next + c, mnr); ld16f(p.r_k + c, rkc);
            const u16* zc = ZS + (size_t)t0 * 3328 + c;
            Z16 rp = tt0 > 0 ? ldz(zc - 3328) : zz(), rc = ldz(zc);
#pragma unroll 2
            for (int i = 0; i < 16; ++i) {
                const bool hn = (tt0 + i) < SEQ - 1; const Z16 rn = hn ? ldz(zc + (size_t)(i + 1) * 3328) : zz();
                const size_t o = (size_t)(t0 + i) * RW + c;
                float r[16], k[16]; mix16(rp, rc, rn, mpr, mnr, r); unz(ldz(Kb + o), k);
                float bs = 0.f;
#pragma unroll
                for (int q = 0; q < 16; ++q) bs += r[q] * k[q] * rkc[q];
                bs += __shfl_xor(bs, 1); bs += __shfl_xor(bs, 2);
#pragma unroll
                for (int j4 = 0; j4 < 4; ++j4) *(f32x4*)(R + o + j4 * 4) = (f32x4){r[j4 * 4], r[j4 * 4 + 1], r[j4 * 4 + 2], r[j4 * 4 + 3]};
                if ((lane & 3) == 0) BON[(size_t)(t0 + i) * 16 + (lane >> 2)] = bs;
                rp = rc; rc = rn;
            }
        }
        {
            float mpv[16], mnv[16]; ld16f(p.mu_prev + 2048 + c, mpv); ld16f(p.mu_next + 2048 + c, mnv);
            const int cl = 3072 + lane * 4; const f32x4 la = *(const f32x4*)(p.mu_prev + cl), lb = *(const f32x4*)(p.mu_next + cl);
            const u16* zc = ZS + (size_t)t0 * 3328;
            Z16 vp = tt0 > 0 ? ldz(zc - 3328 + 2048 + c) : zz(), vc = ldz(zc + 2048 + c);
            u32x2 lp = tt0 > 0 ? *(const u32x2*)(zc - 3328 + cl) : (u32x2){0u, 0u}, lc = *(const u32x2*)(zc + cl);
#pragma unroll 2
            for (int i = 0; i < 16; ++i) {
                const bool hn = (tt0 + i) < SEQ - 1; const u16* zn = zc + (size_t)(i + 1) * 3328;
                const Z16 vn = hn ? ldz(zn + 2048 + c) : zz(); const u32x2 ln = hn ? *(const u32x2*)(zn + cl) : (u32x2){0u, 0u};
                float v[16]; mix16(vp, vc, vn, mpv, mnv, v);
                st16bf(V + (size_t)(t0 + i) * RW + c, v);
                const float z4[4] = {bflo(lc.x), bfhi(lc.x), bflo(lc.y), bfhi(lc.y)}, p4[4] = {bflo(lp.x), bfhi(lp.x), bflo(lp.y), bfhi(lp.y)}, n4[4] = {bflo(ln.x), bfhi(ln.x), bflo(ln.y), bfhi(ln.y)};
                float o4[4];
#pragma unroll
                for (int j = 0; j < 4; ++j) { const float sft = z4[j] + la[j] * (p4[j] - z4[j]) + lb[j] * (n4[j] - z4[j]); o4[j] = (lane < 32) ? tanhf(sft) : sft; }
                u32x2 w; w.x = cvt_pk_bf16(o4[0], o4[1]); w.y = cvt_pk_bf16(o4[2], o4[3]); *(u32x2*)(AL + (size_t)(t0 + i) * 256 + lane * 4) = w;
                vp = vc; vc = vn; lp = lc; lc = ln;
            }
        }
    }
}

__device__ __forceinline__ void nat_phase(const Params& p, float* ldsf) {
    const int lane = threadIdx.x & 63, wid = __builtin_amdgcn_readfirstlane(threadIdx.x >> 6), l15 = lane & 15, lq = lane >> 4;
    const u16* Qn = (const u16*)p.out; const u16* Kn = Qn + (size_t)NTOK * RW; const u16* VT = Kn + (size_t)NTOK * RW; const u16* Gn = VT + (size_t)NTOK * RW;
    u16* MIX = (u16*)(p.ws + O_HN);
    for (int item = blockIdx.x * 8 + wid; item < 8192; item += gridDim.x * 8) {
        const int r = item & 255, h = (item >> 8) & 15, b = item >> 12;
        const int rs = min(max(r - 4, 0), 248);
        const u16* Qb = Qn + (size_t)(b * SEQ + r * 64) * RW + h * 64;
        const u16* Kb = Kn + (size_t)(b * SEQ + rs * 64) * RW + h * 64;
        const u16* Vb = VT + (size_t)((b * 16 + h) * 64) * SEQ + rs * 64;
        float* tb = ldsf + wid * 256;
        { const float* rpb = p.rpb + h * 465 + (rs - r + 7) * 31;
#pragma unroll
          for (int q = 0; q < 4; ++q) { const int e = lane + q * 64; if (e < 248) tb[e] = rpb[e]; } }
#pragma unroll 1
        for (int qt = 0; qt < 4; ++qt) {
            const int c0 = qt * 16, cs0 = (qt == 0) ? 0 : (qt == 1 ? 8 : (qt == 2 ? 24 : 32));
            const int c = c0 + l15, csq = min(max(c - 8, 0), 48);
            const bf16x8 bq0 = *(const bf16x8*)(Qb + (size_t)c * RW + lq * 8), bq1 = *(const bf16x8*)(Qb + (size_t)c * RW + 32 + lq * 8);
            f32x4 sc[8][2];
#pragma unroll
            for (int i = 0; i < 8; ++i)
#pragma unroll
                for (int hf = 0; hf < 2; ++hf) { const u16* kp = Kb + (size_t)(i * 64 + cs0 + (l15 >> 2) * 8 + hf * 4 + (l15 & 3)) * RW + lq * 8;
                    const bf16x8 a0 = *(const bf16x8*)kp, a1 = *(const bf16x8*)(kp + 32); f32x4 z = {0.f, 0.f, 0.f, 0.f};
                    z = __builtin_amdgcn_mfma_f32_16x16x32_bf16(a0, bq0, z, 0, 0, 0); z = __builtin_amdgcn_mfma_f32_16x16x32_bf16(a1, bq1, z, 0, 0, 0); sc[i][hf] = z; }
            float mx = -1e30f;
#pragma unroll
            for (int i = 0; i < 8; ++i)
#pragma unroll
                for (int hf = 0; hf < 2; ++hf)
#pragma unroll
                    for (int j = 0; j < 4; ++j) { const int kc = cs0 + lq * 8 + hf * 4 + j; const bool valid = (kc >= csq) && (kc < csq + 16); const int bc = valid ? (kc - c + 15) : 0;
                        const float s = valid ? sc[i][hf][j] * 0.125f + tb[i * 31 + bc] : -1e30f; sc[i][hf][j] = s; mx = fmaxf(mx, s); }
            mx = fmaxf(mx, __shfl_xor(mx, 16)); mx = fmaxf(mx, __shfl_xor(mx, 32));
            float sum = 0.f;
#pragma unroll
            for (int i = 0; i < 8; ++i)
#pragma unroll
                for (int hf = 0; hf < 2; ++hf)
#pragma unroll
                    for (int j = 0; j < 4; ++j) { const float e = __expf(sc[i][hf][j] - mx); sc[i][hf][j] = e; sum += e; }
            sum += __shfl_xor(sum, 16); sum += __shfl_xor(sum, 32);
            const float inv = 1.0f / sum;
            f32x4 o[4];
#pragma unroll
            for (int mt = 0; mt < 4; ++mt) o[mt] = (f32x4){0.f, 0.f, 0.f, 0.f};
#pragma unroll
            for (int i = 0; i < 8; ++i) {
                u32x4 pw; pw.x = cvt_pk_bf16(sc[i][0][0] * inv, sc[i][0][1] * inv); pw.y = cvt_pk_bf16(sc[i][0][2] * inv, sc[i][0][3] * inv);
                pw.z = cvt_pk_bf16(sc[i][1][0] * inv, sc[i][1][1] * inv); pw.w = cvt_pk_bf16(sc[i][1][2] * inv, sc[i][1][3] * inv);
                const bf16x8 bp = __builtin_bit_cast(bf16x8, pw);
#pragma unroll
                for (int mt = 0; mt < 4; ++mt) { const u16* vp = Vb + (size_t)(mt * 16 + l15) * SEQ + i * 64 + cs0 + lq * 8;
                    o[mt] = __builtin_amdgcn_mfma_f32_16x16x32_bf16(*(const bf16x8*)vp, bp, o[mt], 0, 0, 0); }
            }
            const size_t tok = (size_t)(b * SEQ + r * 64 + c);
#pragma unroll
            for (int mt = 0; mt < 4; ++mt) { const int ch = h * 64 + mt * 16 + lq * 4; const u32x2 gw = *(const u32x2*)(Gn + tok * RW + ch);
                const float g0 = bflo(gw.x), g1 = bfhi(gw.x), g2 = bflo(gw.y), g3 = bfhi(gw.y);
                u32x2 w; w.x = cvt_pk_bf16(o[mt][0] * g0 * sigmoidf_(g0), o[mt][1] * g1 * sigmoidf_(g1)); w.y = cvt_pk_bf16(o[mt][2] * g2 * sigmoidf_(g2), o[mt][3] * g3 * sigmoidf_(g3));
                *(u32x2*)(MIX + tok * DM + 1024 + ch) = w; }
        }
    }
}

template <int N> __device__ __forceinline__ void fmac_bc(float& d, float bsrc, float o) { asm volatile("v_fmac_f32_dpp %0, %1, %2 row_newbcast:%3 row_mask:0xf bank_mask:0xf" : "+v"(d) : "v"(bsrc), "v"(o), "n"(N)); }
template <int N> __device__ __forceinline__ float mul_bc(float bsrc, float o) { float d; asm volatile("v_mul_f32_dpp %0, %1, %2 row_newbcast:%3 row_mask:0xf bank_mask:0xf" : "=v"(d) : "v"(bsrc), "v"(o), "n"(N)); return d; }
struct In1 { f32x4 w, a, b, kd; unsigned v; u32x2 kw; };
struct In2 { f32x4 w, a, b, kd, r; unsigned v; float yo; u32x2 kw; };
#define DERIVE_B(set) { set.b = -set.a * set.b; asm volatile("" : "+v"(set.b)); }
#define DERIVE_BK(set) { const f32x4 f_ = set.b * ka4 + c04; set.b = -set.a * set.b; const f32x4 k_ = {bflo(set.kw.x), bfhi(set.kw.x), bflo(set.kw.y), bfhi(set.kw.y)}; set.kd = k_ * f_; asm volatile("" : "+v"(set.b), "+v"(set.kd)); }
#define BC(x, k) x[(k) & 3]
template <int K> struct ScanK {
    static constexpr int N0 = K >> 2, N1 = (K + 1) >> 2;
    static __device__ __forceinline__ void dot(const float (&S)[64], const f32x4& a, float& s0, float& s1) {
        fmac_bc<N0>(s0, BC(a, K), S[K]); fmac_bc<N1>(s1, BC(a, K + 1), S[K + 1]);
        if constexpr (K + 2 < 64) ScanK<K + 2>::dot(S, a, s0, s1);
    }
    static __device__ __forceinline__ void upd(float (&S)[64], const In2& in, float sa, float vv, float& y0, float& y1) {
        float t0 = mul_bc<N0>(BC(in.kd, K), vv); float t1 = mul_bc<N1>(BC(in.kd, K + 1), vv);
        fmac_bc<N0>(t0, BC(in.w, K), S[K]); fmac_bc<N1>(t1, BC(in.w, K + 1), S[K + 1]);
        fmac_bc<N0>(t0, BC(in.b, K), sa); fmac_bc<N1>(t1, BC(in.b, K + 1), sa);
        S[K] = t0; S[K + 1] = t1;
        fmac_bc<N0>(y0, BC(in.r, K), t0); fmac_bc<N1>(y1, BC(in.r, K + 1), t1);
        if constexpr (K + 2 < 64) ScanK<K + 2>::upd(S, in, sa, vv, y0, y1);
    }
    static __device__ __forceinline__ void updS(float (&S)[64], const In1& in, float sa, float vv) {
        float t0 = mul_bc<N0>(BC(in.kd, K), vv); float t1 = mul_bc<N1>(BC(in.kd, K + 1), vv);
        fmac_bc<N0>(t0, BC(in.w, K), S[K]); fmac_bc<N1>(t1, BC(in.w, K + 1), S[K + 1]);
        fmac_bc<N0>(t0, BC(in.b, K), sa); fmac_bc<N1>(t1, BC(in.b, K + 1), sa);
        S[K] = t0; S[K + 1] = t1;
        if constexpr (K + 2 < 64) ScanK<K + 2>::updS(S, in, sa, vv);
    }
    static __device__ __forceinline__ void updP(float (&P)[64], const In1& in, float sa) {
        float u0 = mul_bc<N0>(BC(in.w, K), P[K]); float u1 = mul_bc<N1>(BC(in.w, K + 1), P[K + 1]);
        fmac_bc<N0>(u0, BC(in.b, K), sa); fmac_bc<N1>(u1, BC(in.b, K + 1), sa);
        P[K] = u0; P[K + 1] = u1;
        if constexpr (K + 2 < 64) ScanK<K + 2>::updP(P, in, sa);
    }
};
__device__ __forceinline__ void scan_pass1(const Params& p, int d) {
    const int lane = threadIdx.x & 63, wid = __builtin_amdgcn_readfirstlane(threadIdx.x >> 6); const unsigned lo16 = (lane & 15) * 16, lo2 = lane * 2;
    const float* Wd = p.out; const float* Bd = p.out + (size_t)NTOK * RW; const u16* KB = (const u16*)(p.ws + O_K); const float* A = (const float*)(p.ws + O_A);
    const u16* V = (const u16*)(p.ws + O_V); float* PT = (float*)(p.ws + O_PT); float* SLT = (float*)(p.ws + O_SLT); const unsigned lo8 = (lane & 15) * 8;
    constexpr int NS = 32 * (NC - 1);
    for (int item = blockIdx.x * 8 + wid; item < 2 * NS; item += gridDim.x * 8) {
        const bool isP = item >= NS; const int idx = isP ? item - NS : item;
        const int bh = idx / (NC - 1), c = idx - bh * (NC - 1), b = bh >> 4, h = bh & 15;
        const int t0 = d ? (SEQ - 1 - c * LC) : c * LC;
        const size_t off0 = ((size_t)(b * SEQ + t0)) * RW + h * 64; const long stp = d ? -(long)RW : (long)RW;
        const float *wq = Wd + off0, *aq = A + off0, *bq = Bd + off0; const u16* kq = KB + off0; const u16* vq = V + off0;
        const f32x4 ka4 = *(const f32x4*)(p.k_a + h * 64 + (lane & 15) * 4), c04 = 1.0f - ka4;
        float S[64]; int ln = lane; asm volatile("" : "+v"(ln));
#define SB __builtin_amdgcn_sched_barrier(0)
#define LDX(base, o_) (*(const f32x4*)((const char*)((base) + (o_)) + lo16))
        if (!isP) {
#pragma unroll
            for (int i = 0; i < 64; ++i) S[i] = 0.f;
#define LD1(set, s) { const long o_ = (long)min((int)(s), LC - 1) * stp; set.w = LDX(wq, o_); set.a = LDX(aq, o_); set.b = LDX(bq, o_); set.kw = *(const u32x2*)((const char*)(kq + o_) + lo8); set.v = *(const u16*)((const char*)(vq + o_) + lo2); }
#define TOUCH1(set) asm volatile("" :: "v"(set.w), "v"(set.a), "v"(set.b), "v"(set.kw), "v"(set.v))
#define ST1(set) { DERIVE_BK(set); float s0 = 0.f, s1 = 0.f; ScanK<0>::dot(S, set.a, s0, s1); ScanK<0>::updS(S, set, s0 + s1, __uint_as_float(set.v << 16)); }
            In1 i0, i1; LD1(i0, 0);
#pragma unroll 1
            for (int s = 0; s < LC; s += 2) { TOUCH1(i0); SB; LD1(i1, s + 1); SB; ST1(i0); TOUCH1(i1); SB; LD1(i0, s + 2); SB; ST1(i1); }
#undef LD1
#undef TOUCH1
#undef ST1
        } else {
#pragma unroll
            for (int i = 0; i < 64; ++i) S[i] = (ln == i) ? 1.f : 0.f;
#define LD1(set, s) { const long o_ = (long)min((int)(s), LC - 1) * stp; set.w = LDX(wq, o_); set.a = LDX(aq, o_); set.b = LDX(bq, o_); }
#define TOUCH1(set) asm volatile("" :: "v"(set.w), "v"(set.a), "v"(set.b))
#define ST1(set) { DERIVE_B(set); float s0 = 0.f, s1 = 0.f; ScanK<0>::dot(S, set.a, s0, s1); ScanK<0>::updP(S, set, s0 + s1); }
            In1 i0, i1; LD1(i0, 0);
#pragma unroll 1
            for (int s = 0; s < LC; s += 2) { TOUCH1(i0); SB; LD1(i1, s + 1); SB; ST1(i0); TOUCH1(i1); SB; LD1(i0, s + 2); SB; ST1(i1); }
#undef LD1
#undef TOUCH1
#undef ST1
        }
        float* po = (isP ? PT : SLT) + ((size_t)(bh * NC + c)) * 4096 + lane * 64;
#pragma unroll
        for (int i = 0; i < 16; ++i) *(f32x4*)(po + 4 * i) = (f32x4){S[4 * i], S[4 * i + 1], S[4 * i + 2], S[4 * i + 3]};
    }
}
template <int J> struct CombJ {
    static __device__ __forceinline__ void run(const LAS float* pl, float srow, float (&acc)[4]) {
        const f32x4 q = *(const LAS f32x4*)(pl + J * 64);
        fmac_bc<J>(acc[0], srow, q[0]); fmac_bc<J>(acc[1], srow, q[1]); fmac_bc<J>(acc[2], srow, q[2]); fmac_bc<J>(acc[3], srow, q[3]);
        if constexpr (J + 1 < 16) CombJ<J + 1>::run(pl, srow, acc);
    }
};
__device__ __forceinline__ void scan_combine(const Params& p, unsigned char* lds) {
    const int tid = threadIdx.x, lane = tid & 63, wid = __builtin_amdgcn_readfirstlane(tid >> 6), lq = lane >> 4, k4 = lane & 15;
    const float* PT = (const float*)(p.ws + O_PT); const float* SLT = (const float*)(p.ws + O_SLT); float* SIT = (float*)(p.ws + O_SIT);
    LAS float* pbuf = (LAS float*)(LAS unsigned char*)lds;
    LAS float* rowb = pbuf + 8192 + wid * 64;
    for (int item = blockIdx.x; item < 256; item += gridDim.x) {
        const int bh = item >> 3, row = (item & 7) * 8 + wid;
        const float* pt = PT + (size_t)bh * NC * 4096 + tid * 8; const float* st = SLT + (size_t)bh * NC * 4096 + row * 64 + k4 * 4; float* si = SIT + (size_t)bh * NC * 4096 + row * 64 + k4 * 4;
        __syncthreads();
        { const f32x4 pa = *(const f32x4*)pt, pb = *(const f32x4*)(pt + 4); *(LAS f32x4*)(pbuf + tid * 8) = pa; *(LAS f32x4*)(pbuf + tid * 8 + 4) = pb; }
#define PLD(A, B, ci) { const size_t o_ = (size_t)min((int)(ci), NC - 2) * 4096; A = *(const f32x4*)(pt + o_); B = *(const f32x4*)(pt + o_ + 4); }
#define SLD(Sv, ci) { Sv = *(const f32x4*)(st + (size_t)min((int)(ci), NC - 2) * 4096); }
        f32x4 pa0, pb0, pa1, pb1, pa2, pb2, sl0, sl1, sl2;
        PLD(pa0, pb0, 1); PLD(pa1, pb1, 2); PLD(pa2, pb2, 3); SLD(sl0, 0); SLD(sl1, 1); SLD(sl2, 2);
        float srow = 0.f;
        __syncthreads();
#define CSTEP(c, PA, PB, SLV) { \
            const LAS float* pl = pbuf + ((c) & 1) * 4096 + (lq * 16) * 64 + k4 * 4; \
            float ac[4] = {0.f, 0.f, 0.f, 0.f}; \
            CombJ<0>::run(pl, srow, ac); \
            _Pragma("unroll") for (int q = 0; q < 4; ++q) { ac[q] += __shfl_xor(ac[q], 16); ac[q] += __shfl_xor(ac[q], 32); } \
            const f32x4 acc = (f32x4){ac[0], ac[1], ac[2], ac[3]} + SLV; \
            if (lq == 0) { *(LAS f32x4*)(rowb + k4 * 4) = acc; *(f32x4*)(si + (size_t)((c) + 1) * 4096) = acc; } \
            srow = rowb[lane]; \
            { LAS float* pn = pbuf + (((c) + 1) & 1) * 4096 + tid * 8; *(LAS f32x4*)pn = PA; *(LAS f32x4*)(pn + 4) = PB; } \
            PLD(PA, PB, (c) + 4); SLD(SLV, (c) + 3); \
            __syncthreads(); }
#pragma unroll 1
        for (int c = 0; c < NC - 1; c += 3) { CSTEP(c, pa0, pb0, sl0); CSTEP(c + 1, pa1, pb1, sl1); CSTEP(c + 2, pa2, pb2, sl2); }
#undef CSTEP
#undef PLD
#undef SLD
    }
}
__device__ __forceinline__ void scan_pass2(const Params& p, int d) {
    const int lane = threadIdx.x & 63, wid = __builtin_amdgcn_readfirstlane(threadIdx.x >> 6); const unsigned lo16 = (lane & 15) * 16, lo2 = lane * 2, lo4b = lane * 4;
    const float* Wd = p.out; const float* Bd = p.out + (size_t)NTOK * RW; const u16* KB = (const u16*)(p.ws + O_K); const float* A = (const float*)(p.ws + O_A); const float* R = (const float*)(p.ws + O_R); const unsigned lo8 = (lane & 15) * 8;
    const u16* V = (const u16*)(p.ws + O_V); const float* SIT = (const float*)(p.ws + O_SIT); float* Y = (float*)(p.ws + O_Y);
    for (int item = blockIdx.x * 8 + wid; item < 32 * NC; item += gridDim.x * 8) {
        const int bh = item / NC, c = item - bh * NC, b = bh >> 4, h = bh & 15;
        const int t0 = d ? (SEQ - 1 - c * LC) : c * LC;
        const size_t off0 = ((size_t)(b * SEQ + t0)) * RW + h * 64; const long stp = d ? -(long)RW : (long)RW;
        const float *wq = Wd + off0, *aq = A + off0, *bq = Bd + off0, *rq = R + off0; const u16* kq = KB + off0; const u16* vq = V + off0; float* yq = Y + off0;
        const f32x4 ka4 = *(const f32x4*)(p.k_a + h * 64 + (lane & 15) * 4), c04 = 1.0f - ka4;
        float S[64];
        if (c == 0) {
#pragma unroll
            for (int i = 0; i < 64; ++i) S[i] = 0.f;
        } else { const float* si = SIT + ((size_t)(bh * NC + c)) * 4096 + lane * 64;
#pragma unroll
            for (int i = 0; i < 16; ++i) { const f32x4 q = *(const f32x4*)(si + 4 * i); S[4 * i] = q[0]; S[4 * i + 1] = q[1]; S[4 * i + 2] = q[2]; S[4 * i + 3] = q[3]; } }
#define LD2(set, s) { const long o_ = (long)min((int)(s), LC - 1) * stp; set.w = LDX(wq, o_); set.a = LDX(aq, o_); set.b = LDX(bq, o_); set.kw = *(const u32x2*)((const char*)(kq + o_) + lo8); \
            set.r = LDX(rq, o_); set.v = *(const u16*)((const char*)(vq + o_) + lo2); set.yo = d ? *(const float*)((const char*)(yq + o_) + lo4b) : 0.f; }
#define ST2(set, s) { DERIVE_BK(set); float s0 = 0.f, s1 = 0.f; ScanK<0>::dot(S, set.a, s0, s1); float y0 = set.yo, y1 = 0.f; ScanK<0>::upd(S, set, s0 + s1, __uint_as_float(set.v << 16), y0, y1); *(float*)((char*)(yq + (long)(s) * stp) + lo4b) = y0 + y1; }
#define TOUCH2(set) asm volatile("" :: "v"(set.w), "v"(set.a), "v"(set.b), "v"(set.kw), "v"(set.r), "v"(set.v), "v"(set.yo))
        In2 i0, i1; LD2(i0, 0);
#pragma unroll 1
        for (int s = 0; s < LC; s += 2) { TOUCH2(i0); SB; LD2(i1, s + 1); SB; ST2(i0, s); TOUCH2(i1); SB; LD2(i0, s + 2); SB; ST2(i1, s + 1); }
#undef LD2
#undef ST2
    }
}

__device__ __forceinline__ void post_phase(const Params& p) {
    const int lane = threadIdx.x & 63, wid = threadIdx.x >> 6;
    const float* Y = (const float*)(p.ws + O_Y); const u16* V = (const u16*)(p.ws + O_V); const u16* ZG = (const u16*)(p.ws + O_ZG); const float* BON = (const float*)(p.ws + O_BON);
    u16* MIX = (u16*)(p.ws + O_HN); u16* PB = (u16*)(p.ws + O_AL);
    for (int t = blockIdx.x * 8 + wid; t < NTOK; t += gridDim.x * 8) {
        const int c = lane * 16; const size_t o = (size_t)t * RW + c;
        float y[16], v[16], g[16]; float s = 0.f;
#pragma unroll
        for (int j4 = 0; j4 < 4; ++j4) { const f32x4 a = *(const f32x4*)(Y + o + j4 * 4); y[j4 * 4] = a[0]; y[j4 * 4 + 1] = a[1]; y[j4 * 4 + 2] = a[2]; y[j4 * 4 + 3] = a[3]; s += a[0] + a[1] + a[2] + a[3]; }
        ld16bf(V + o, v); ld16bf(ZG + o, g);
        s += __shfl_xor(s, 1); s += __shfl_xor(s, 2); const float mu = s * (1.0f / 64.0f);
        float q = 0.f;
#pragma unroll
        for (int j = 0; j < 16; ++j) { y[j] -= mu; q += y[j] * y[j]; }
        q += __shfl_xor(q, 1); q += __shfl_xor(q, 2); const float rs = rsqrtf(q * (1.0f / 64.0f) + 64e-5f);
        const float bon = BON[(size_t)t * 16 + (lane >> 2)];
        float outv[16];
#pragma unroll
        for (int j4 = 0; j4 < 4; ++j4) { const f32x4 lw = *(const f32x4*)(p.lnx_w + c + j4 * 4), lb = *(const f32x4*)(p.lnx_b + c + j4 * 4);
#pragma unroll
            for (int j = 0; j < 4; ++j) { const int i = j4 * 4 + j; const float yn = y[i] * rs * lw[j] + lb[j]; outv[i] = (yn + bon * v[i]) * g[i] * sigmoidf_(g[i]); } }
        st16bf(MIX + (size_t)t * DM + c, outv);
        { const f32x4 pv = *(const f32x4*)(p.p + (size_t)t * 256 + lane * 4); u32x2 w; w.x = cvt_pk_bf16(pv[0], pv[1]); w.y = cvt_pk_bf16(pv[2], pv[3]); *(u32x2*)(PB + (size_t)t * 256 + lane * 4) = w; }
    }
}

#define XB_TMO      128
#define XB_XCNT(j)  (256  + 64 * (j))
#define XB_XSUB(j)  (1280 + 64 * (j))
#define XB_XGEN(j)  (2304 + 64 * (j))
#define XB_TOP      3328
#define XB_TOPGEN   3392
#define XCD_BAR_WORDS 3456
#define XB_SPIN_CAP (1u << 18)
__device__ __forceinline__ unsigned xb_ld(unsigned* p)              { return __hip_atomic_load(p, __ATOMIC_RELAXED, __HIP_MEMORY_SCOPE_AGENT); }
__device__ __forceinline__ unsigned xb_add(unsigned* p, unsigned v) { return __hip_atomic_fetch_add(p, v, __ATOMIC_RELAXED, __HIP_MEMORY_SCOPE_AGENT); }
__device__ __forceinline__ unsigned xb_xcc_id() { return (unsigned)__builtin_amdgcn_s_getreg((3 << 11) | 20) & 0xFu; }
#define XB_SPIN(cond, bar) do { unsigned _sp = 0; while (cond) { __builtin_amdgcn_s_sleep(1); \
    if ((++_sp & 255u) == 0u) { if (xb_ld(&(bar)[XB_TMO])) break; if (_sp > XB_SPIN_CAP) { atomicAdd(&(bar)[XB_TMO], 1u); break; } } } } while (0)
struct XcdBarrier { unsigned* bar; unsigned x; volatile LAS unsigned* st; };
__device__ __forceinline__ XcdBarrier xcd_barrier_post(unsigned* bar, volatile LAS unsigned* st) {
    XcdBarrier b; b.bar = bar; b.x = xb_xcc_id(); b.st = st;
    if (threadIdx.x == 0) (void)xb_add(&bar[XB_XCNT(b.x)], 1u);
    return b;
}
__device__ __forceinline__ void xcd_barrier_complete(unsigned* bar, unsigned x, unsigned& nloc, unsigned& nx) {
    const unsigned G = gridDim.x * gridDim.y * gridDim.z;
    unsigned sum, cnt, mine, sp = 0u;
    for (;;) {
        sum = 0u; cnt = 0u; mine = 0u;
#pragma unroll
        for (unsigned j = 0; j < 16; ++j) { const unsigned c = xb_ld(&bar[XB_XCNT(j)]); sum += c; cnt += (c > 0u) ? 1u : 0u; mine = (j == x) ? c : mine; }
        if (sum == G) break;
        __builtin_amdgcn_s_sleep(1);
        if ((++sp & 255u) == 0u) { if (xb_ld(&bar[XB_TMO])) break; if (sp > XB_SPIN_CAP) { atomicAdd(&bar[XB_TMO], 1u); break; } }
    }
    nloc = mine > 0u ? mine : 1u; nx = cnt > 0u ? cnt : 1u;
}
__device__ __forceinline__ void xcd_barrier(const XcdBarrier& b) {
    asm volatile("s_waitcnt vmcnt(0)" ::: "memory");
    __syncthreads();
    if (threadIdx.x == 0) {
        unsigned* bar = b.bar;
        __builtin_amdgcn_s_waitcnt(0);
        unsigned nloc = b.st[0], nx = b.st[1];
        if (nloc == 0u) { xcd_barrier_complete(bar, b.x, nloc, nx); b.st[0] = nloc; b.st[1] = nx; }
        const unsigned old = xb_add(&bar[XB_XSUB(b.x)], 1u);
        const unsigned gen = old / nloc;
        if (old + 1u == (gen + 1u) * nloc) {
            __builtin_amdgcn_fence(__ATOMIC_RELEASE, "agent");
            asm volatile("s_waitcnt vmcnt(0)" ::: "memory");
            const unsigned og = xb_add(&bar[XB_TOP], 1u);
            const unsigned tg = og / nx;
            if (og + 1u == (tg + 1u) * nx) xb_add(&bar[XB_TOPGEN], 1u);
            else XB_SPIN(xb_ld(&bar[XB_TOPGEN]) == tg, bar);
            __builtin_amdgcn_fence(__ATOMIC_ACQUIRE, "agent");
            xb_add(&bar[XB_XGEN(b.x)], 1u);
            asm volatile("s_waitcnt vmcnt(0)" ::: "memory");
        } else {
            XB_SPIN(xb_ld(&bar[XB_XGEN(b.x)]) == gen, bar);
            __builtin_amdgcn_fence(__ATOMIC_ACQUIRE, "agent");
            asm volatile("s_waitcnt vmcnt(0)" ::: "memory");
        }
    }
    __syncthreads();
}

__global__ void __launch_bounds__(NTHREADS, 2) mega(Params p) {
    extern __shared__ __attribute__((aligned(16))) unsigned char lds[];
    cg::grid_group grid = cg::this_grid();
    unsigned char* ws = p.ws;
    volatile LAS unsigned* xbw = (volatile LAS unsigned*)((LAS unsigned char*)lds + LDS_XB);
    if (threadIdx.x < 4) xbw[threadIdx.x] = 0u;
    __syncthreads();
    const XcdBarrier xbar = xcd_barrier_post((unsigned*)(ws + O_BAR), xbw);
#define PH_ON(n) (p.ph_lo <= (n) && (n) < p.ph_hi)
#define PH_END(n) do { if ((n) + 1 < p.ph_hi) { if ((n) == 0) grid.sync(); else xcd_barrier(xbar); } } while (0)
#ifndef PROBE_PH
#define PROBE_PH -1
#endif
#define RUN(n, ...) if (PH_ON(n)) { __VA_ARGS__ if (PROBE_PH == (n)) { __syncthreads(); __VA_ARGS__ } PH_END(n); }
    RUN(0,
        transpose_cvt(p.w_in, 2048, 8448, (u16*)(ws + O_W1T), 2048, (float*)lds);
        transpose_cvt(p.w_out, 2048, 2048, (u16*)(ws + O_W2T), 2048, (float*)lds);
        transpose_cvt(p.w_ple_gate, 2048, 2048, (u16*)(ws + O_W3T), 2048, (float*)lds);
        transpose_cvt(p.w_ple_proj, 256, 2048, (u16*)(ws + O_WPT), 256, (float*)lds);
        build_wlt(p);
        rownorm<true>(p.x, p.norm_mix_g, ws + O_HN);)
    RUN(1, {
        EpiZ e; e.zs = (u16*)(ws + O_ZS); e.zg = (u16*)(ws + O_ZG); e.qn = (u16*)p.out; e.kn = e.qn + (size_t)NTOK * RW; e.vt = e.kn + (size_t)NTOK * RW; e.gn = e.vt + (size_t)NTOK * RW;
        run_gemm(lds, (const u16*)(ws + O_HN), (const u16*)(ws + O_W1T), NTOK, 8448, 2048, e); })
    RUN(2, nat_phase(p, (float*)lds); prep_phase(p);)
#define SCAN_DIR(d, pb) \
    RUN(pb, { \
        EpiLora e; e.w0 = p.decay_w0 + (d) * RW; e.a0 = p.iclr_a0 + (d) * RW; e.Wd = p.out; e.IC = p.out + (size_t)NTOK * RW; \
        run_gemm(lds, (const u16*)(ws + O_AL), (const u16*)(ws + O_WLT) + (size_t)(d) * 2048 * 256, NTOK, 2048, 256, e); }) \
    RUN(pb + 1, scan_pass1(p, d);) \
    RUN(pb + 2, scan_combine(p, lds);) \
    RUN(pb + 3, scan_pass2(p, d);)
    SCAN_DIR(0, 3)
    SCAN_DIR(1, 7)
    RUN(11, post_phase(p);)
    RUN(12, {
        EpiH e; e.X = p.x; e.H = p.out;
        run_gemm(lds, (const u16*)(ws + O_HN), (const u16*)(ws + O_W2T), NTOK, 2048, 2048, e);
        EpiBf e2; e2.O = (u16*)(ws + O_R); e2.ld = DM;
        run_gemm(lds, (const u16*)(ws + O_AL), (const u16*)(ws + O_WPT), NTOK, 2048, 256, e2); })
    RUN(13, rownorm<true>(p.out, p.ple_norm_g, ws + O_HN);)
    RUN(14, {
        EpiGate e; e.H = p.out; e.PP = (const u16*)(ws + O_R);
        run_gemm(lds, (const u16*)(ws + O_HN), (const u16*)(ws + O_W3T), NTOK, 2048, 2048, e); })
    RUN(15, rownorm<false>(p.out, p.final_g, p.out);)
}

extern "C" void kernel_launch(void* const* d_in, const int* in_sizes, int n_in, void* d_out, int out_size, void* d_ws, size_t ws_size, hipStream_t stream) {
    static int grid = 0;
    if (grid == 0) {
        if (n_in != 21 || out_size != NTOK * DM || ws_size < WS_END) { fprintf(stderr, "kernel_launch: unexpected shapes (n_in %d out %d ws %zu need %zu)\n", n_in, out_size, ws_size, (size_t)WS_END); grid = -1; return; }
        int dev = 0, cus = 0, per_cu = 0;
        hipGetDevice(&dev); hipDeviceGetAttribute(&cus, hipDeviceAttributeMultiprocessorCount, dev);
        hipFuncSetAttribute((const void*)mega, hipFuncAttributeMaxDynamicSharedMemorySize, LDS_BYTES);
        hipOccupancyMaxActiveBlocksPerMultiprocessor(&per_cu, (const void*)mega, NTHREADS, LDS_BYTES);
        if (per_cu < 1) { fprintf(stderr, "kernel_launch: occupancy query says %d blocks/CU\n", per_cu); grid = -1; return; }
        grid = cus;
    }
    if (grid < 0) return;
    Params p{};
    const float** f = (const float**)&p;
    for (int i = 0; i < 21; ++i) f[i] = (const float*)d_in[i];
    p.out = (float*)d_out; p.ws = (unsigned char*)d_ws;
    hipMemsetAsync((unsigned char*)d_ws + O_BAR, 0, XCD_BAR_WORDS * sizeof(unsigned), stream);
#if MULTI_LAUNCH
    for (int ph = 0; ph < 16; ++ph) { p.ph_lo = ph; p.ph_hi = ph + 1; hipLaunchKernelGGL(mega, dim3(grid), dim3(NTHREADS), LDS_BYTES, stream, p); }
#else
    p.ph_lo = 0; p.ph_hi = 16;
    void* args[] = {&p};
    hipError_t e = hipLaunchCooperativeKernel((const void*)mega, dim3(grid), dim3(NTHREADS), args, LDS_BYTES, stream);
    if (e != hipSuccess) fprintf(stderr, "cooperative launch failed: %s (grid %d)\n", hipGetErrorString(e), grid);
#endif
}
```

```cpp
#include <hip/hip_runtime.h>
#include <hip/hip_cooperative_groups.h>
#include <cstdio>
namespace cg = cooperative_groups;

#ifndef MULTI_LAUNCH
#define MULTI_LAUNCH 0
#endif

#define LAS __attribute__((address_space(3)))
typedef unsigned short u16;
typedef short bf16x8 __attribute__((ext_vector_type(8)));
typedef float f32x4 __attribute__((ext_vector_type(4)));
typedef float f32x2 __attribute__((ext_vector_type(2)));
typedef unsigned u32x4 __attribute__((ext_vector_type(4)));
typedef unsigned u32x2 __attribute__((ext_vector_type(2)));
typedef const __attribute__((address_space(4))) f32x2* cf2p;

constexpr int SEQ = 16384, NTOK = 32768, DM = 2048, RW = 1024;
constexpr int NC = 64, LC = SEQ / NC;
constexpr int NTHREADS = 512, LDS_XB = 131072, LDS_BYTES = 131072 + 16;
constexpr float DECAY_SCALE = 0.6065306597126334f;

constexpr size_t MiB = 1ull << 20;
constexpr size_t O_W1T = 0, O_W2T = 33 * MiB, O_W3T = 41 * MiB, O_WPT = 49 * MiB, O_WLT = 50 * MiB;
constexpr size_t O_HN = 56 * MiB;
constexpr size_t O_ZS = 184 * MiB;
constexpr size_t O_KD = O_ZS, O_PT = O_ZS + 128 * MiB, O_SLT = O_ZS + 160 * MiB;
constexpr size_t O_ZG = 392 * MiB;
constexpr size_t O_R = 456 * MiB;
constexpr size_t O_A = 584 * MiB;
constexpr size_t O_V = 712 * MiB;
constexpr size_t O_K = 776 * MiB;
constexpr size_t O_AL = 840 * MiB;
constexpr size_t O_BON = 856 * MiB;
constexpr size_t O_Y = 858 * MiB;
constexpr size_t O_SIT = 986 * MiB;
constexpr size_t O_BAR = 1018 * MiB;
constexpr size_t WS_END = 1019 * MiB;

struct Params {
    const float *x, *p, *norm_mix_g, *w_in, *mu_prev, *mu_next, *decay_w0, *decay_w2, *iclr_a0, *iclr_a2, *k_k, *k_a, *r_k, *lnx_w, *lnx_b, *rpb, *w_out,
        *ple_norm_g, *w_ple_gate, *w_ple_proj, *final_g;
    float* out; unsigned char* ws;
    int ph_lo, ph_hi;
};

__device__ __forceinline__ float bf2f(u16 b) { return __uint_as_float(((unsigned)b) << 16); }
__device__ __forceinline__ float bflo(unsigned w) { return __uint_as_float(w << 16); }
__device__ __forceinline__ float bfhi(unsigned w) { return __uint_as_float(w & 0xffff0000u); }
__device__ __forceinline__ unsigned cvt_pk_bf16(float lo, float hi) { unsigned r; asm volatile("v_cvt_pk_bf16_f32 %0, %1, %2" : "=v"(r) : "v"(lo), "v"(hi)); return r; }
__device__ __forceinline__ float sigmoidf_(float x) { return __builtin_amdgcn_rcpf(1.0f + __expf(-x)); }
__device__ __forceinline__ f32x2 fma2(f32x2 a, f32x2 b, f32x2 c) { return __builtin_elementwise_fma(a, b, c); }

namespace pg8 {
constexpr int BM = 256, BK = 64, HALF = 128, HTB = HALF * BK * 2, NXCD = 8, WGM = 8;
__device__ __forceinline__ int lds_byte(int r, int c) { const int st = (r >> 4) * 2 + (c >> 5), rr = r & 15, cc = c & 31, ob = rr * 64 + cc * 2; return st * 1024 + (ob ^ (((ob >> 9) & 1) << 5)); }
__device__ __forceinline__ void stage_rc(int b, int& R, int& C) { const int st = b / 1024, sb = b % 1024, swz = sb ^ (((sb >> 9) & 1) << 5); R = (st >> 1) * 16 + swz / 64; C = (st & 1) * 32 + (swz % 64) / 2; }
__device__ __forceinline__ int perm32(int rho) { const int n = rho >> 4, i = rho & 15; return 8 * (i >> 2) + 4 * n + (i & 3); }
struct Unit { int pm, pn; };
struct Gemm { const u16* A; const u16* Bt; int M, N, K, lda, ldb; };
struct StaticOrder {
    int nM, nN, nwg, G, c;
    __device__ void init(int M, int N, int G_, int c_) { nM = M / BM; nN = N / BM; nwg = nM * nN; G = G_; c = c_; }
    __device__ bool next(int i, Unit& u) const {
        const long L = (long)i * G + c; if (L >= nwg) return false;
        int wgid = (int)L; { const int q = nwg / NXCD, r = nwg % NXCD, xcd = wgid % NXCD, off = wgid / NXCD; wgid = (xcd < r ? xcd * (q + 1) : r * (q + 1) + (xcd - r) * q) + off; }
        const int nig = WGM * nN, gid = wgid / nig, fm = gid * WGM, gsz = (nM - fm) < WGM ? (nM - fm) : WGM;
        u.pm = fm + ((wgid % nig) % gsz); u.pn = (wgid % nig) / gsz; return true;
    }
};
template <class Epi>
__device__ __forceinline__ void gemm_phase(LAS unsigned char* lds, const Gemm g, const StaticOrder& S, const Epi& E) {
    const int tid = threadIdx.x, wid = __builtin_amdgcn_readfirstlane(tid >> 6), lane = tid & 63, wr = wid >> 2, wc = wid & 3, fr = lane & 15, fq = lane >> 4;
    const int K = g.K, nt = K / BK;
    unsigned voffA[2], voffB[2];
#pragma unroll
    for (int i = 0; i < 2; ++i) { int R, C; stage_rc(tid * 16 + i * 8192, R, C); const int Rb = Epi::PERM ? ((R & ~31) + perm32(R & 31)) : R;
        voffA[i] = (unsigned)(R * g.lda + C) * 2u; voffB[i] = (unsigned)(Rb * g.ldb + C) * 2u; }
    const size_t kstep = (size_t)(BK * 2);
    const size_t hstepA = (size_t)HALF * g.lda * 2, hstepB = (size_t)HALF * g.ldb * 2;
    const size_t tstepA = 2 * hstepA, tstepB = 2 * hstepB;
    const unsigned ldsw = (unsigned)wid * 1024u;
    const int aoff = lds_byte(wr * 64 + fr, fq * 8), boff = lds_byte(wc * 32 + fr, fq * 8);
#define PG8_SA(b, h) (((b) * 2 + (h)) * HTB)
#define PG8_SB(b, h) ((4 + (b) * 2 + (h)) * HTB)
#define PG8_STAGE(bufoff, gbase, voff) do { _Pragma("unroll") for (int _i = 0; _i < 2; ++_i) \
        __builtin_amdgcn_global_load_lds((const unsigned*)((const char*)(gbase) + (voff)[_i]), (LAS unsigned*)(lds + (bufoff) + ldsw + _i * 8192), 16, 0, 0); } while (0)
#define PG8_LDA(dst, b, h) do { _Pragma("unroll") for (int m = 0; m < 4; ++m) _Pragma("unroll") for (int k = 0; k < 2; ++k) dst[m][k] = *(const LAS bf16x8*)(lds + PG8_SA(b, h) + aoff + m * 2048 + k * 1024); } while (0)
#define PG8_LDB(dst, b, h) do { _Pragma("unroll") for (int n = 0; n < 2; ++n) _Pragma("unroll") for (int k = 0; k < 2; ++k) dst[n][k] = *(const LAS bf16x8*)(lds + PG8_SB(b, h) + boff + n * 2048 + k * 1024); } while (0)
#define PG8_MMA(ai, bj, At, Bt) do { __builtin_amdgcn_s_setprio(1); _Pragma("unroll") for (int m = 0; m < 4; ++m) _Pragma("unroll") for (int n = 0; n < 2; ++n) _Pragma("unroll") for (int k = 0; k < 2; ++k) \
        acc[ai][bj][m][n] = __builtin_amdgcn_mfma_f32_16x16x32_bf16(Bt[n][k], At[m][k], acc[ai][bj][m][n], 0, 0, 0); __builtin_amdgcn_s_setprio(0); } while (0)
#define PG8_WAIT_V(n) asm volatile("s_waitcnt vmcnt(" #n ")" ::: "memory")
#define PG8_WAIT_L(n) asm volatile("s_waitcnt lgkmcnt(" #n ")" ::: "memory")
#define PG8_BAR __builtin_amdgcn_s_barrier()
#define PG8_SCHED __builtin_amdgcn_sched_barrier(0)
    Unit cur, nxt; int ui = 0;
    if (!S.next(0, cur)) return;
    f32x4 acc[2][2][4][2];
#pragma unroll
    for (int a = 0; a < 2; ++a)
#pragma unroll
        for (int b = 0; b < 2; ++b)
#pragma unroll
            for (int m = 0; m < 4; ++m)
#pragma unroll
                for (int n = 0; n < 2; ++n) acc[a][b][m][n] = (f32x4){0.f, 0.f, 0.f, 0.f};
    bf16x8 At[4][2], B0[2][2], B1[2][2];
    const char* cA = (const char*)g.A + (size_t)cur.pm * tstepA; const char* cB = (const char*)g.Bt + (size_t)cur.pn * tstepB;
    PG8_STAGE(PG8_SB(0, 0), cB, voffB); PG8_STAGE(PG8_SA(0, 0), cA, voffA); PG8_STAGE(PG8_SB(0, 1), cB + hstepB, voffB); PG8_STAGE(PG8_SA(0, 1), cA + hstepA, voffA);
    if (wr == 1) PG8_BAR;
    PG8_WAIT_V(4); PG8_BAR;
    PG8_STAGE(PG8_SB(1, 0), cB + kstep, voffB); PG8_STAGE(PG8_SA(1, 0), cA + kstep, voffA); PG8_STAGE(PG8_SB(1, 1), cB + hstepB + kstep, voffB);
    PG8_WAIT_V(6); PG8_BAR;
    for (;;) {
        const bool has_next = S.next(ui + 1, nxt);
        const char* nA = has_next ? (const char*)g.A + (size_t)nxt.pm * tstepA : cA; const char* nB = has_next ? (const char*)g.Bt + (size_t)nxt.pn * tstepB : cB;
        for (int t = 0; t < nt; t += 2) {
            const bool last = (t == nt - 2);
            const char* a1 = cA + (size_t)(t + 1) * kstep;
            const char* a2 = last ? nA : cA + (size_t)(t + 2) * kstep; const char* b2 = last ? nB : cB + (size_t)(t + 2) * kstep;
            const char* a3 = a2 + kstep; const char* b3 = b2 + kstep;
            PG8_LDB(B0, 0, 0); PG8_SCHED; PG8_LDA(At, 0, 0); PG8_STAGE(PG8_SA(1, 1), a1 + hstepA, voffA);
            PG8_WAIT_L(8); PG8_BAR; PG8_WAIT_L(0); PG8_MMA(0, 0, At, B0); PG8_BAR; PG8_SCHED;
            PG8_LDB(B1, 0, 1); PG8_STAGE(PG8_SB(0, 0), b2, voffB);
            PG8_BAR; PG8_WAIT_L(0); PG8_MMA(0, 1, At, B1); PG8_BAR;
            PG8_LDA(At, 0, 1); PG8_STAGE(PG8_SA(0, 0), a2, voffA);
            PG8_BAR; PG8_WAIT_L(0); PG8_MMA(1, 0, At, B0); PG8_BAR; PG8_SCHED;
            PG8_STAGE(PG8_SB(0, 1), b2 + hstepB, voffB);
            PG8_WAIT_V(6); PG8_BAR; PG8_MMA(1, 1, At, B1); PG8_BAR;
            PG8_LDB(B0, 1, 0); PG8_SCHED; PG8_LDA(At, 1, 0); PG8_STAGE(PG8_SA(0, 1), a2 + hstepA, voffA);
            PG8_WAIT_L(8); PG8_BAR; PG8_WAIT_L(0); PG8_MMA(0, 0, At, B0); PG8_BAR; PG8_SCHED;
            PG8_LDB(B1, 1, 1); PG8_STAGE(PG8_SB(1, 0), b3, voffB);
            PG8_BAR; PG8_WAIT_L(0); PG8_MMA(0, 1, At, B1); PG8_BAR;
            PG8_LDA(At, 1, 1); PG8_STAGE(PG8_SA(1, 0), a3, voffA);
            PG8_BAR; PG8_WAIT_L(0); PG8_MMA(1, 0, At, B0); PG8_BAR; PG8_SCHED;
            PG8_STAGE(PG8_SB(1, 1), b3 + hstepB, voffB);
            PG8_WAIT_V(6); PG8_BAR; PG8_MMA(1, 1, At, B1); PG8_BAR;
        }
        E(acc, cur, wr, wc, fr, fq);
        if (!has_next) break;
#pragma unroll
        for (int a = 0; a < 2; ++a)
#pragma unroll
            for (int b = 0; b < 2; ++b)
#pragma unroll
                for (int m = 0; m < 4; ++m)
#pragma unroll
                    for (int n = 0; n < 2; ++n) acc[a][b][m][n] = (f32x4){0.f, 0.f, 0.f, 0.f};
        cur = nxt; cA = nA; cB = nB; ++ui;
    }
    PG8_WAIT_V(0);
    if (wr == 0) PG8_BAR;
    PG8_BAR;
#undef PG8_SA
#undef PG8_SB
#undef PG8_STAGE
#undef PG8_LDA
#undef PG8_LDB
#undef PG8_MMA
#undef PG8_WAIT_V
#undef PG8_WAIT_L
#undef PG8_BAR
#undef PG8_SCHED
}
}
using pg8::Unit;
typedef f32x4 AccT[2][2][4][2];

struct EpiZ {
    static constexpr bool PERM = true;
    u16 *zs, *zg, *qn, *kn, *vt, *gn;
    __device__ __forceinline__ void operator()(const AccT& acc, const Unit& u, int wr, int wc, int fr, int fq) const {
        const int row0 = u.pm * 256 + wr * 64 + fr; const int pn = u.pn;
        if (pn >= 25 && pn < 29) {
            const int cb = (pn - 25) * 256 + wc * 32 + 8 * fq;
#pragma unroll
            for (int ai = 0; ai < 2; ++ai)
#pragma unroll
                for (int m = 0; m < 4; ++m) { const int row = row0 + ai * 128 + m * 16; const int b = row >> 14, tt = row & (SEQ - 1);
#pragma unroll
                    for (int bj = 0; bj < 2; ++bj)
#pragma unroll
                        for (int n = 0; n < 2; ++n)
#pragma unroll
                            for (int j = 0; j < 4; ++j) { const int ch = cb + bj * 128 + 4 * n + j;
                                vt[((size_t)(b * 1024 + ch)) * SEQ + tt] = (u16)(cvt_pk_bf16(acc[ai][bj][m][n][j], 0.f) & 0xffffu); } }
            return;
        }
        u16* base; int ld, colt;
        if (pn < 13) { base = zs; ld = 3328; colt = pn * 256; }
        else if (pn < 17) { base = zg; ld = 1024; colt = (pn - 13) * 256; }
        else if (pn < 21) { base = qn; ld = 1024; colt = (pn - 17) * 256; }
        else if (pn < 25) { base = kn; ld = 1024; colt = (pn - 21) * 256; }
        else { base = gn; ld = 1024; colt = (pn - 29) * 256; }
        const int col0 = colt + wc * 32 + 8 * fq;
#pragma unroll
        for (int ai = 0; ai < 2; ++ai)
#pragma unroll
            for (int m = 0; m < 4; ++m) { u16* rowp = base + (size_t)(row0 + ai * 128 + m * 16) * ld + col0;
#pragma unroll
                for (int bj = 0; bj < 2; ++bj) { const f32x4 v0 = acc[ai][bj][m][0], v1 = acc[ai][bj][m][1];
                    u32x4 w; w.x = cvt_pk_bf16(v0[0], v0[1]); w.y = cvt_pk_bf16(v0[2], v0[3]); w.z = cvt_pk_bf16(v1[0], v1[1]); w.w = cvt_pk_bf16(v1[2], v1[3]);
                    *(u32x4*)(rowp + bj * 128) = w; } }
    }
};
struct EpiBf {
    static constexpr bool PERM = true;
    u16* O; int ld;
    __device__ __forceinline__ void operator()(const AccT& acc, const Unit& u, int wr, int wc, int fr, int fq) const {
        const int row0 = u.pm * 256 + wr * 64 + fr, col0 = u.pn * 256 + wc * 32 + 8 * fq;
#pragma unroll
        for (int ai = 0; ai < 2; ++ai)
#pragma unroll
            for (int m = 0; m < 4; ++m) { u16* rowp = O + (size_t)(row0 + ai * 128 + m * 16) * ld + col0;
#pragma unroll
                for (int bj = 0; bj < 2; ++bj) { const f32x4 v0 = acc[ai][bj][m][0], v1 = acc[ai][bj][m][1];
                    u32x4 w; w.x = cvt_pk_bf16(v0[0], v0[1]); w.y = cvt_pk_bf16(v0[2], v0[3]); w.z = cvt_pk_bf16(v1[0], v1[1]); w.w = cvt_pk_bf16(v1[2], v1[3]);
                    *(u32x4*)(rowp + bj * 128) = w; } }
    }
};
struct EpiLora {
    static constexpr bool PERM = false;
    const float *w0, *a0; float *Wd, *IC;
    __device__ __forceinline__ void operator()(const AccT& acc, const Unit& u, int wr, int wc, int fr, int fq) const {
        const int row0 = u.pm * 256 + wr * 64 + fr, col0 = u.pn * 256 + wc * 32 + 4 * fq;
        if (u.pn < 4) {
#pragma unroll
            for (int bj = 0; bj < 2; ++bj)
#pragma unroll
                for (int n = 0; n < 2; ++n) { const int col = col0 + bj * 128 + n * 16; const f32x4 wv = *(const f32x4*)(w0 + col);
#pragma unroll
                    for (int ai = 0; ai < 2; ++ai)
#pragma unroll
                        for (int m = 0; m < 4; ++m) { const int row = row0 + ai * 128 + m * 16; f32x4 o;
#pragma unroll
                            for (int j = 0; j < 4; ++j) o[j] = __expf(-DECAY_SCALE * sigmoidf_(wv[j] + acc[ai][bj][m][n][j]));
                            *(f32x4*)(Wd + (size_t)row * RW + col) = o; asm volatile("" ::: "memory"); } }
        } else {
#pragma unroll
            for (int bj = 0; bj < 2; ++bj)
#pragma unroll
                for (int n = 0; n < 2; ++n) { const int col = col0 - 1024 + bj * 128 + n * 16; const f32x4 av0 = *(const f32x4*)(a0 + col);
#pragma unroll
                    for (int ai = 0; ai < 2; ++ai)
#pragma unroll
                        for (int m = 0; m < 4; ++m) { const int row = row0 + ai * 128 + m * 16; f32x4 o;
#pragma unroll
                            for (int j = 0; j < 4; ++j) o[j] = sigmoidf_(av0[j] + acc[ai][bj][m][n][j]);
                            *(f32x4*)(IC + (size_t)row * RW + col) = o; asm volatile("" ::: "memory"); } }
        }
    }
};
struct EpiH {
    static constexpr bool PERM = false;
    const float* X; float* H;
    __device__ __forceinline__ void operator()(const AccT& acc, const Unit& u, int wr, int wc, int fr, int fq) const {
        const int row0 = u.pm * 256 + wr * 64 + fr, col0 = u.pn * 256 + wc * 32 + 4 * fq;
#pragma unroll
        for (int ai = 0; ai < 2; ++ai)
#pragma unroll
            for (int m = 0; m < 4; ++m) { const size_t ro = (size_t)(row0 + ai * 128 + m * 16) * DM + col0;
#pragma unroll
                for (int bj = 0; bj < 2; ++bj)
#pragma unroll
                    for (int n = 0; n < 2; ++n) { const size_t o = ro + bj * 128 + n * 16; *(f32x4*)(H + o) = acc[ai][bj][m][n] + *(const f32x4*)(X + o); } asm volatile("" ::: "memory"); }
    }
};
struct EpiGate {
    static constexpr bool PERM = false;
    float* H; const u16* PP;
    __device__ __forceinline__ void operator()(const AccT& acc, const Unit& u, int wr, int wc, int fr, int fq) const {
        const int row0 = u.pm * 256 + wr * 64 + fr, col0 = u.pn * 256 + wc * 32 + 4 * fq;
#pragma unroll
        for (int ai = 0; ai < 2; ++ai)
#pragma unroll
            for (int m = 0; m < 4; ++m) { const size_t ro = (size_t)(row0 + ai * 128 + m * 16) * DM + col0;
#pragma unroll
                for (int bj = 0; bj < 2; ++bj)
#pragma unroll
                    for (int n = 0; n < 2; ++n) { const size_t o = ro + bj * 128 + n * 16; const f32x4 h = *(const f32x4*)(H + o); const u32x2 pw = *(const u32x2*)(PP + o);
                        const f32x4 a = acc[ai][bj][m][n]; f32x4 r;
                        r[0] = h[0] + bflo(pw.x) * sigmoidf_(a[0]); r[1] = h[1] + bfhi(pw.x) * sigmoidf_(a[1]); r[2] = h[2] + bflo(pw.y) * sigmoidf_(a[2]); r[3] = h[3] + bfhi(pw.y) * sigmoidf_(a[3]);
                        *(f32x4*)(H + o) = r; asm volatile("" ::: "memory"); } }
    }
};

template <class Epi> __device__ __forceinline__ void run_gemm(unsigned char* lds, const u16* A, const u16* Bt, int M, int N, int K, const Epi& E, int lda = 0, int ldb = 0) {
    pg8::Gemm g; g.A = A; g.Bt = Bt; g.M = M; g.N = N; g.K = K; g.lda = lda ? lda : K; g.ldb = ldb ? ldb : K;
    pg8::StaticOrder S; S.init(M, N, gridDim.x, blockIdx.x);
    pg8::gemm_phase<Epi>((LAS unsigned char*)lds, g, S, E);
    __syncthreads();
}

__device__ __forceinline__ void transpose_cvt(const float* __restrict__ src, int K, int N, u16* __restrict__ dst, int ldd, float* tile) {
    const int tid = threadIdx.x, tn = N / 64, ntile = (K / 64) * tn;
    for (int t = blockIdx.x; t < ntile; t += gridDim.x) {
        const int k0 = (t / tn) * 64, n0 = (t % tn) * 64;
#pragma unroll
        for (int ps = 0; ps < 2; ++ps) { const int r = (tid >> 4) + ps * 32, c4 = (tid & 15) * 4; const f32x4 v = *(const f32x4*)(src + (size_t)(k0 + r) * N + n0 + c4);
            tile[r * 65 + c4] = v[0]; tile[r * 65 + c4 + 1] = v[1]; tile[r * 65 + c4 + 2] = v[2]; tile[r * 65 + c4 + 3] = v[3]; }
        __syncthreads();
        { const int n = tid >> 3, ks = (tid & 7) * 8; u32x4 w;
          w.x = cvt_pk_bf16(tile[(ks + 0) * 65 + n], tile[(ks + 1) * 65 + n]); w.y = cvt_pk_bf16(tile[(ks + 2) * 65 + n], tile[(ks + 3) * 65 + n]);
          w.z = cvt_pk_bf16(tile[(ks + 4) * 65 + n], tile[(ks + 5) * 65 + n]); w.w = cvt_pk_bf16(tile[(ks + 6) * 65 + n], tile[(ks + 7) * 65 + n]);
          *(u32x4*)(dst + (size_t)(n0 + n) * ldd + k0 + ks) = w; }
        __syncthreads();
    }
}
__device__ __forceinline__ void build_wlt(const Params& p) {
    u16* W = (u16*)(p.ws + O_WLT);
    for (int i = blockIdx.x * NTHREADS + threadIdx.x; i < 2 * 2048 * 128; i += gridDim.x * NTHREADS) {
        const int k = i & 127, n = (i >> 7) & 2047, d = i >> 18; float v = 0.f;
        if (n < 1024) { if (k < 64) v = p.decay_w2[((size_t)d * 64 + k) * RW + n]; }
        else { if (k >= 64) v = p.iclr_a2[((size_t)d * 64 + (k - 64)) * RW + (n - 1024)]; }
        W[i] = (u16)(cvt_pk_bf16(v, 0.f) & 0xffffu);
    }
}
template <bool BF> __device__ __forceinline__ void rownorm(const float* src, const float* __restrict__ g, void* dst) {
    const int lane = threadIdx.x & 63, wid = threadIdx.x >> 6;
    for (int row = blockIdx.x * 8 + wid; row < NTOK; row += gridDim.x * 8) {
        const float* s = src + (size_t)row * DM + lane * 4; f32x4 v[8]; float ss = 0.f;
#pragma unroll
        for (int i = 0; i < 8; ++i) { v[i] = *(const f32x4*)(s + i * 256); ss += v[i][0] * v[i][0] + v[i][1] * v[i][1] + v[i][2] * v[i][2] + v[i][3] * v[i][3]; }
#pragma unroll
        for (int o = 32; o >= 1; o >>= 1) ss += __shfl_xor(ss, o);
        const float sc = rsqrtf(ss * (1.0f / DM) + 1e-6f);
#pragma unroll
        for (int i = 0; i < 8; ++i) { const f32x4 gv = *(const f32x4*)(g + lane * 4 + i * 256); const f32x4 o = v[i] * sc * gv;
            if (BF) { u32x2 w; w.x = cvt_pk_bf16(o[0], o[1]); w.y = cvt_pk_bf16(o[2], o[3]); *(u32x2*)((u16*)dst + (size_t)row * DM + lane * 4 + i * 256) = w; }
            else *(f32x4*)((float*)dst + (size_t)row * DM + lane * 4 + i * 256) = o; }
    }
}

__device__ __forceinline__ void ld16bf(const u16* p, float* o) {
    const u32x4 a = *(const u32x4*)p, b = *(const u32x4*)(p + 8);
    o[0] = bflo(a.x); o[1] = bfhi(a.x); o[2] = bflo(a.y); o[3] = bfhi(a.y); o[4] = bflo(a.z); o[5] = bfhi(a.z); o[6] = bflo(a.w); o[7] = bfhi(a.w);
    o[8] = bflo(b.x); o[9] = bfhi(b.x); o[10] = bflo(b.y); o[11] = bfhi(b.y); o[12] = bflo(b.z); o[13] = bfhi(b.z); o[14] = bflo(b.w); o[15] = bfhi(b.w);
}
__device__ __forceinline__ void st16bf(u16* p, const float* v) {
    u32x4 a, b; a.x = cvt_pk_bf16(v[0], v[1]); a.y = cvt_pk_bf16(v[2], v[3]); a.z = cvt_pk_bf16(v[4], v[5]); a.w = cvt_pk_bf16(v[6], v[7]);
    b.x = cvt_pk_bf16(v[8], v[9]); b.y = cvt_pk_bf16(v[10], v[11]); b.z = cvt_pk_bf16(v[12], v[13]); b.w = cvt_pk_bf16(v[14], v[15]);
    *(u32x4*)p = a; *(u32x4*)(p + 8) = b;
}
__device__ __forceinline__ void shift16(const u16* zc, bool hp, bool hn, const float* __restrict__ mp, const float* __restrict__ mn, int c, float* o) {
    float z[16], zp[16], zn[16]; ld16bf(zc + c, z);
    if (hp) ld16bf(zc - 3328 + c, zp); else {
#pragma unroll
        for (int j = 0; j < 16; ++j) zp[j] = 0.f; }
    if (hn) ld16bf(zc + 3328 + c, zn); else {
#pragma unroll
        for (int j = 0; j < 16; ++j) zn[j] = 0.f; }
#pragma unroll
    for (int j4 = 0; j4 < 4; ++j4) { const f32x4 a = *(const f32x4*)(mp + c + j4 * 4), b = *(const f32x4*)(mn + c + j4 * 4);
#pragma unroll
        for (int j = 0; j < 4; ++j) { const int q = j4 * 4 + j; o[q] = z[q] + a[j] * (zp[q] - z[q]) + b[j] * (zn[q] - z[q]); } }
}
struct Z16 { u32x4 a, b; };
__device__ __forceinline__ Z16 ldz(const u16* p) { Z16 z; z.a = *(const u32x4*)p; z.b = *(const u32x4*)(p + 8); return z; }
__device__ __forceinline__ Z16 zz() { Z16 z; z.a = (u32x4){0u, 0u, 0u, 0u}; z.b = z.a; return z; }
__device__ __forceinline__ void unz(const Z16& z, float* o) {
    o[0] = bflo(z.a.x); o[1] = bfhi(z.a.x); o[2] = bflo(z.a.y); o[3] = bfhi(z.a.y); o[4] = bflo(z.a.z); o[5] = bfhi(z.a.z); o[6] = bflo(z.a.w); o[7] = bfhi(z.a.w);
    o[8] = bflo(z.b.x); o[9] = bfhi(z.b.x); o[10] = bflo(z.b.y); o[11] = bfhi(z.b.y); o[12] = bflo(z.b.z); o[13] = bfhi(z.b.z); o[14] = bflo(z.b.w); o[15] = bfhi(z.b.w);
}
__device__ __forceinline__ void ld16f(const float* p, float* o) {
#pragma unroll
    for (int j = 0; j < 4; ++j) { const f32x4 v = *(const f32x4*)(p + 4 * j); o[4 * j] = v[0]; o[4 * j + 1] = v[1]; o[4 * j + 2] = v[2]; o[4 * j + 3] = v[3]; }
}
__device__ __forceinline__ void mix16(const Z16& zp, const Z16& zc, const Z16& zn, const float* mp, const float* mn, float* o) {
    float p_[16], c_[16], n_[16]; unz(zp, p_); unz(zc, c_); unz(zn, n_);
#pragma unroll
    for (int q = 0; q < 16; ++q) o[q] = c_[q] + mp[q] * (p_[q] - c_[q]) + mn[q] * (n_[q] - c_[q]);
}
__device__ __forceinline__ void prep_phase(const Params& p) {
    const int lane = threadIdx.x & 63, wid = threadIdx.x >> 6, c = lane * 16;
    const u16* ZS = (const u16*)(p.ws + O_ZS);
    float* R = (float*)(p.ws + O_R); float* A = (float*)(p.ws + O_A); u16* V = (u16*)(p.ws + O_V); u16* Kb = (u16*)(p.ws + O_K); u16* AL = (u16*)(p.ws + O_AL); float* BON = (float*)(p.ws + O_BON);
    for (int t0 = (blockIdx.x * 8 + wid) * 16; t0 < NTOK; t0 += gridDim.x * 8 * 16) {
        const int tt0 = t0 & (SEQ - 1);
        {
            float mpk[16], mnk[16], kkc[16]; ld16f(p.mu_prev + 1024 + c, mpk); ld16f(p.mu_next + 1024 + c, mnk); ld16f(p.k_k + c, kkc);
            const u16* zc = ZS + (size_t)t0 * 3328 + 1024 + c;
            Z16 kp = tt0 > 0 ? ldz(zc - 3328) : zz(), kc = ldz(zc);
#pragma unroll 2
            for (int i = 0; i < 16; ++i) {
                const bool hn = (tt0 + i) < SEQ - 1; const Z16 kn = hn ? ldz(zc + (size_t)(i + 1) * 3328) : zz();
                float k[16], kk[16]; mix16(kp, kc, kn, mpk, mnk, k);
                float s2 = 0.f;
#pragma unroll
                for (int q = 0; q < 16; ++q) { kk[q] = k[q] * kkc[q]; s2 += kk[q] * kk[q]; }
                s2 += __shfl_xor(s2, 1); s2 += __shfl_xor(s2, 2);
                const float inv = -1.0f / fmaxf(sqrtf(s2), 1e-12f);
                const size_t o = (size_t)(t0 + i) * RW + c;
#pragma unroll
                for (int j4 = 0; j4 < 4; ++j4) *(f32x4*)(A + o + j4 * 4) = (f32x4){kk[j4 * 4] * inv, kk[j4 * 4 + 1] * inv, kk[j4 * 4 + 2] * inv, kk[j4 * 4 + 3] * inv};
                st16bf(Kb + o, k);
                kp = kc; kc = kn;
            }
        }
        {
            float mpr[16], mnr[16], rkc[16]; ld16f(p.mu_prev + c, mpr); ld16f(p.mu_next + c, mnr); ld16f(p.r_k + c, rkc);
            const u16* zc = ZS + (size_t)t0 * 3328 + c;
            Z16 rp = tt0 > 0 ? ldz(zc - 3328) : zz(), rc = ldz(zc);
#pragma unroll 2
            for (int i = 0; i < 16; ++i) {
                const bool hn = (tt0 + i) < SEQ - 1; const Z16 rn = hn ? ldz(zc + (size_t)(i + 1) * 3328) : zz();
                const size_t o = (size_t)(t0 + i) * RW + c;
                float r[16], k[16]; mix16(rp, rc, rn, mpr, mnr, r); unz(ldz(Kb + o), k);
                float bs = 0.f;
#pragma unroll
                for (int q = 0; q < 16; ++q) bs += r[q] * k[q] * rkc[q];
                bs += __shfl_xor(bs, 1); bs += __shfl_xor(bs, 2);
#pragma unroll
                for (int j4 = 0; j4 < 4; ++j4) *(f32x4*)(R + o + j4 * 4) = (f32x4){r[j4 * 4], r[j4 * 4 + 1], r[j4 * 4 + 2], r[j4 * 4 + 3]};
                if ((lane & 3) == 0) BON[(size_t)(t0 + i) * 16 + (lane >> 2)] = bs;
                rp = rc; rc = rn;
            }
        }
        {
            float mpv[16], mnv[16]; ld16f(p.mu_prev + 2048 + c, mpv); ld16f(p.mu_next + 2048 + c, mnv);
            const int cl = 3072 + lane * 4; const f32x4 la = *(const f32x4*)(p.mu_prev + cl), lb = *(const f32x4*)(p.mu_next + cl);
            const int alc = ((lane >> 4) & 1) * 128 + (lane >> 5) * 64 + (lane & 15) * 4;
            const u16* zc = ZS + (size_t)t0 * 3328;
            Z16 vp = tt0 > 0 ? ldz(zc - 3328 + 2048 + c) : zz(), vc = ldz(zc + 2048 + c);
            u32x2 lp = tt0 > 0 ? *(const u32x2*)(zc - 3328 + cl) : (u32x2){0u, 0u}, lc = *(const u32x2*)(zc + cl);
#pragma unroll 2
            for (int i = 0; i < 16; ++i) {
                const bool hn = (tt0 + i) < SEQ - 1; const u16* zn = zc + (size_t)(i + 1) * 3328;
                const Z16 vn = hn ? ldz(zn + 2048 + c) : zz(); const u32x2 ln = hn ? *(const u32x2*)(zn + cl) : (u32x2){0u, 0u};
                float v[16]; mix16(vp, vc, vn, mpv, mnv, v);
                st16bf(V + (size_t)(t0 + i) * RW + c, v);
                const float z4[4] = {bflo(lc.x), bfhi(lc.x), bflo(lc.y), bfhi(lc.y)}, p4[4] = {bflo(lp.x), bfhi(lp.x), bflo(lp.y), bfhi(lp.y)}, n4[4] = {bflo(ln.x), bfhi(ln.x), bflo(ln.y), bfhi(ln.y)};
                float o4[4];
#pragma unroll
                for (int j = 0; j < 4; ++j) { const float sft = z4[j] + la[j] * (p4[j] - z4[j]) + lb[j] * (n4[j] - z4[j]); o4[j] = (lane < 32) ? tanhf(sft) : sft; }
                u32x2 w; w.x = cvt_pk_bf16(o4[0], o4[1]); w.y = cvt_pk_bf16(o4[2], o4[3]); *(u32x2*)(AL + (size_t)(t0 + i) * 256 + alc) = w;
                vp = vc; vc = vn; lp = lc; lc = ln;
            }
        }
    }
}

__device__ __forceinline__ void nat_phase(const Params& p, float* ldsf, int wave0, int nwaves) {
    const int lane = threadIdx.x & 63, wid = __builtin_amdgcn_readfirstlane(threadIdx.x >> 6), l15 = lane & 15, lq = lane >> 4;
    const u16* Qn = (const u16*)p.out; const u16* Kn = Qn + (size_t)NTOK * RW; const u16* VT = Kn + (size_t)NTOK * RW; const u16* Gn = VT + (size_t)NTOK * RW;
    u16* MIX = (u16*)(p.ws + O_HN);
    for (int item = wave0; item < 8192; item += nwaves) {
        const int r = item & 255, h = (item >> 8) & 15, b = item >> 12;
        const int rs = min(max(r - 4, 0), 248);
        const u16* Qb = Qn + (size_t)(b * SEQ + r * 64) * RW + h * 64;
        const u16* Kb = Kn + (size_t)(b * SEQ + rs * 64) * RW + h * 64;
        const u16* Vb = VT + (size_t)((b * 16 + h) * 64) * SEQ + rs * 64;
        float* tb = ldsf + wid * 256;
        { const float* rpb = p.rpb + h * 465 + (rs - r + 7) * 31;
#pragma unroll
          for (int q = 0; q < 4; ++q) { const int e = lane + q * 64; if (e < 248) tb[e] = rpb[e]; } }
#pragma unroll 1
        for (int qt = 0; qt < 4; ++qt) {
            const int c0 = qt * 16, cs0 = (qt == 0) ? 0 : (qt == 1 ? 8 : (qt == 2 ? 24 : 32));
            const int c = c0 + l15, csq = min(max(c - 8, 0), 48);
            const bf16x8 bq0 = *(const bf16x8*)(Qb + (size_t)c * RW + lq * 8), bq1 = *(const bf16x8*)(Qb + (size_t)c * RW + 32 + lq * 8);
            f32x4 sc[8][2];
#pragma unroll
            for (int i = 0; i < 8; ++i)
#pragma unroll
                for (int hf = 0; hf < 2; ++hf) { const u16* kp = Kb + (size_t)(i * 64 + cs0 + (l15 >> 2) * 8 + hf * 4 + (l15 & 3)) * RW + lq * 8;
                    const bf16x8 a0 = *(const bf16x8*)kp, a1 = *(const bf16x8*)(kp + 32); f32x4 z = {0.f, 0.f, 0.f, 0.f};
                    z = __builtin_amdgcn_mfma_f32_16x16x32_bf16(a0, bq0, z, 0, 0, 0); z = __builtin_amdgcn_mfma_f32_16x16x32_bf16(a1, bq1, z, 0, 0, 0); sc[i][hf] = z; }
            float mx = -1e30f;
#pragma unroll
            for (int i = 0; i < 8; ++i)
#pragma unroll
                for (int hf = 0; hf < 2; ++hf)
#pragma unroll
                    for (int j = 0; j < 4; ++j) { const int kc = cs0 + lq * 8 + hf * 4 + j; const bool valid = (kc >= csq) && (kc < csq + 16); const int bc = valid ? (kc - c + 15) : 0;
                        const float s = valid ? sc[i][hf][j] * 0.125f + tb[i * 31 + bc] : -1e30f; sc[i][hf][j] = s; mx = fmaxf(mx, s); }
            mx = fmaxf(mx, __shfl_xor(mx, 16)); mx = fmaxf(mx, __shfl_xor(mx, 32));
            float sum = 0.f;
#pragma unroll
            for (int i = 0; i < 8; ++i)
#pragma unroll
                for (int hf = 0; hf < 2; ++hf)
#pragma unroll
                    for (int j = 0; j < 4; ++j) { const float e = __expf(sc[i][hf][j] - mx); sc[i][hf][j] = e; sum += e; }
            sum += __shfl_xor(sum, 16); sum += __shfl_xor(sum, 32);
            const float inv = 1.0f / sum;
            f32x4 o[4];
#pragma unroll
            for (int mt = 0; mt < 4; ++mt) o[mt] = (f32x4){0.f, 0.f, 0.f, 0.f};
#pragma unroll
            for (int i = 0; i < 8; ++i) {
                u32x4 pw; pw.x = cvt_pk_bf16(sc[i][0][0] * inv, sc[i][0][1] * inv); pw.y = cvt_pk_bf16(sc[i][0][2] * inv, sc[i][0][3] * inv);
                pw.z = cvt_pk_bf16(sc[i][1][0] * inv, sc[i][1][1] * inv); pw.w = cvt_pk_bf16(sc[i][1][2] * inv, sc[i][1][3] * inv);
                const bf16x8 bp = __builtin_bit_cast(bf16x8, pw);
#pragma unroll
                for (int mt = 0; mt < 4; ++mt) { const u16* vp = Vb + (size_t)(mt * 16 + l15) * SEQ + i * 64 + cs0 + lq * 8;
                    o[mt] = __builtin_amdgcn_mfma_f32_16x16x32_bf16(*(const bf16x8*)vp, bp, o[mt], 0, 0, 0); }
            }
            const size_t tok = (size_t)(b * SEQ + r * 64 + c);
#pragma unroll
            for (int mt = 0; mt < 4; ++mt) { const int ch = h * 64 + mt * 16 + lq * 4; const u32x2 gw = *(const u32x2*)(Gn + tok * RW + ch);
                const float g0 = bflo(gw.x), g1 = bfhi(gw.x), g2 = bflo(gw.y), g3 = bfhi(gw.y);
                u32x2 w; w.x = cvt_pk_bf16(o[mt][0] * g0 * sigmoidf_(g0), o[mt][1] * g1 * sigmoidf_(g1)); w.y = cvt_pk_bf16(o[mt][2] * g2 * sigmoidf_(g2), o[mt][3] * g3 * sigmoidf_(g3));
                *(u32x2*)(MIX + tok * DM + 1024 + ch) = w; }
        }
    }
}

template <int N> __device__ __forceinline__ void fmac_bc(float& d, float bsrc, float o) { asm volatile("v_fmac_f32_dpp %0, %1, %2 row_newbcast:%3 row_mask:0xf bank_mask:0xf" : "+v"(d) : "v"(bsrc), "v"(o), "n"(N)); }
template <int N> __device__ __forceinline__ float mul_bc(float bsrc, float o) { float d; asm volatile("v_mul_f32_dpp %0, %1, %2 row_newbcast:%3 row_mask:0xf bank_mask:0xf" : "=v"(d) : "v"(bsrc), "v"(o), "n"(N)); return d; }
struct In1 { f32x4 w, a, b, kd; unsigned v; u32x2 kw; };
struct In2 { f32x4 w, a, b, kd, r; unsigned v; float yo; u32x2 kw; };
#define DERIVE_B(set) { set.b = set.a * set.b; asm volatile("" : "+v"(set.b)); }
#define DERIVE_BK(set) { const f32x4 f_ = set.b * ka4 + c04; set.b = set.a * set.b; const f32x4 k_ = {bflo(set.kw.x), bfhi(set.kw.x), bflo(set.kw.y), bfhi(set.kw.y)}; set.kd = k_ * f_; asm volatile("" : "+v"(set.b), "+v"(set.kd)); }
#define BC(x, k) x[(k) & 3]
#define DPPM " row_mask:0xf bank_mask:0xf\n"
template <int K> struct ScanK {
    static constexpr int N0 = K >> 2, N1 = (K + 4) >> 2;
    static __device__ __forceinline__ void dot(const float (&S)[64], const f32x4& a, float (&s)[4]) {
        if constexpr (K == 0) {
            asm volatile("v_mul_f32_dpp %0, %4, %8 row_newbcast:%16" DPPM "v_mul_f32_dpp %1, %5, %9 row_newbcast:%16" DPPM "v_mul_f32_dpp %2, %6, %10 row_newbcast:%16" DPPM "v_mul_f32_dpp %3, %7, %11 row_newbcast:%16" DPPM
                         "v_fmac_f32_dpp %0, %4, %12 row_newbcast:%17" DPPM "v_fmac_f32_dpp %1, %5, %13 row_newbcast:%17" DPPM "v_fmac_f32_dpp %2, %6, %14 row_newbcast:%17" DPPM "v_fmac_f32_dpp %3, %7, %15 row_newbcast:%17" DPPM
                         : "=&v"(s[0]), "=&v"(s[1]), "=&v"(s[2]), "=&v"(s[3])
                         : "v"(a[0]), "v"(a[1]), "v"(a[2]), "v"(a[3]), "v"(S[K]), "v"(S[K + 1]), "v"(S[K + 2]), "v"(S[K + 3]), "v"(S[K + 4]), "v"(S[K + 5]), "v"(S[K + 6]), "v"(S[K + 7]), "n"(N0), "n"(N1));
        } else
        asm volatile("v_fmac_f32_dpp %0, %4, %8 row_newbcast:%16" DPPM "v_fmac_f32_dpp %1, %5, %9 row_newbcast:%16" DPPM "v_fmac_f32_dpp %2, %6, %10 row_newbcast:%16" DPPM "v_fmac_f32_dpp %3, %7, %11 row_newbcast:%16" DPPM
                     "v_fmac_f32_dpp %0, %4, %12 row_newbcast:%17" DPPM "v_fmac_f32_dpp %1, %5, %13 row_newbcast:%17" DPPM "v_fmac_f32_dpp %2, %6, %14 row_newbcast:%17" DPPM "v_fmac_f32_dpp %3, %7, %15 row_newbcast:%17" DPPM
                     : "+v"(s[0]), "+v"(s[1]), "+v"(s[2]), "+v"(s[3])
                     : "v"(a[0]), "v"(a[1]), "v"(a[2]), "v"(a[3]), "v"(S[K]), "v"(S[K + 1]), "v"(S[K + 2]), "v"(S[K + 3]), "v"(S[K + 4]), "v"(S[K + 5]), "v"(S[K + 6]), "v"(S[K + 7]), "n"(N0), "n"(N1));
        if constexpr (K + 8 < 64) ScanK<K + 8>::dot(S, a, s);
    }
    static __device__ __forceinline__ void upd(float (&S)[64], const In2& in, float sa, float vv, float& y0, float& y1) {
        float t0, t1, t2, t3;
        asm volatile("v_mul_f32_dpp %0, %10, %27 row_newbcast:%28" DPPM "v_mul_f32_dpp %1, %11, %27 row_newbcast:%28" DPPM "v_mul_f32_dpp %2, %12, %27 row_newbcast:%28" DPPM "v_mul_f32_dpp %3, %13, %27 row_newbcast:%28" DPPM
                     "v_fmac_f32_dpp %0, %14, %6 row_newbcast:%28" DPPM "v_fmac_f32_dpp %1, %15, %7 row_newbcast:%28" DPPM "v_fmac_f32_dpp %2, %16, %8 row_newbcast:%28" DPPM "v_fmac_f32_dpp %3, %17, %9 row_newbcast:%28" DPPM
                     "v_fmac_f32_dpp %0, %18, %26 row_newbcast:%28" DPPM "v_fmac_f32_dpp %1, %19, %26 row_newbcast:%28" DPPM "v_fmac_f32_dpp %2, %20, %26 row_newbcast:%28" DPPM "v_fmac_f32_dpp %3, %21, %26 row_newbcast:%28" DPPM
                     "v_fmac_f32_dpp %4, %22, %0 row_newbcast:%28" DPPM "v_fmac_f32_dpp %5, %23, %1 row_newbcast:%28" DPPM "v_fmac_f32_dpp %4, %24, %2 row_newbcast:%28" DPPM "v_fmac_f32_dpp %5, %25, %3 row_newbcast:%28" DPPM
                     : "=&v"(t0), "=&v"(t1), "=&v"(t2), "=&v"(t3), "+v"(y0), "+v"(y1)
                     : "v"(S[K]), "v"(S[K + 1]), "v"(S[K + 2]), "v"(S[K + 3]), "v"(in.kd[0]), "v"(in.kd[1]), "v"(in.kd[2]), "v"(in.kd[3]), "v"(in.w[0]), "v"(in.w[1]), "v"(in.w[2]), "v"(in.w[3]),
                       "v"(in.b[0]), "v"(in.b[1]), "v"(in.b[2]), "v"(in.b[3]), "v"(in.r[0]), "v"(in.r[1]), "v"(in.r[2]), "v"(in.r[3]), "v"(sa), "v"(vv), "n"(N0));
        S[K] = t0; S[K + 1] = t1; S[K + 2] = t2; S[K + 3] = t3;
        if constexpr (K + 4 < 64) ScanK<K + 4>::upd(S, in, sa, vv, y0, y1);
    }
    static __device__ __forceinline__ void updS(float (&S)[64], const In1& in, float sa, float vv) {
        float t0, t1, t2, t3;
        asm volatile("v_mul_f32_dpp %0, %8, %21 row_newbcast:%22" DPPM "v_mul_f32_dpp %1, %9, %21 row_newbcast:%22" DPPM "v_mul_f32_dpp %2, %10, %21 row_newbcast:%22" DPPM "v_mul_f32_dpp %3, %11, %21 row_newbcast:%22" DPPM
                     "v_fmac_f32_dpp %0, %12, %4 row_newbcast:%22" DPPM "v_fmac_f32_dpp %1, %13, %5 row_newbcast:%22" DPPM "v_fmac_f32_dpp %2, %14, %6 row_newbcast:%22" DPPM "v_fmac_f32_dpp %3, %15, %7 row_newbcast:%22" DPPM
                     "v_fmac_f32_dpp %0, %16, %20 row_newbcast:%22" DPPM "v_fmac_f32_dpp %1, %17, %20 row_newbcast:%22" DPPM "v_fmac_f32_dpp %2, %18, %20 row_newbcast:%22" DPPM "v_fmac_f32_dpp %3, %19, %20 row_newbcast:%22" DPPM
                     : "=&v"(t0), "=&v"(t1), "=&v"(t2), "=&v"(t3)
                     : "v"(S[K]), "v"(S[K + 1]), "v"(S[K + 2]), "v"(S[K + 3]), "v"(in.kd[0]), "v"(in.kd[1]), "v"(in.kd[2]), "v"(in.kd[3]), "v"(in.w[0]), "v"(in.w[1]), "v"(in.w[2]), "v"(in.w[3]),
                       "v"(in.b[0]), "v"(in.b[1]), "v"(in.b[2]), "v"(in.b[3]), "v"(sa), "v"(vv), "n"(N0));
        S[K] = t0; S[K + 1] = t1; S[K + 2] = t2; S[K + 3] = t3;
        if constexpr (K + 4 < 64) ScanK<K + 4>::updS(S, in, sa, vv);
    }
    static __device__ __forceinline__ void updP(float (&P)[64], const In1& in, float sa) {
        float u0, u1, u2, u3;
        asm volatile("v_mul_f32_dpp %0, %8, %4 row_newbcast:%17" DPPM "v_mul_f32_dpp %1, %9, %5 row_newbcast:%17" DPPM "v_mul_f32_dpp %2, %10, %6 row_newbcast:%17" DPPM "v_mul_f32_dpp %3, %11, %7 row_newbcast:%17" DPPM
                     "v_fmac_f32_dpp %0, %12, %16 row_newbcast:%17" DPPM "v_fmac_f32_dpp %1, %13, %16 row_newbcast:%17" DPPM "v_fmac_f32_dpp %2, %14, %16 row_newbcast:%17" DPPM "v_fmac_f32_dpp %3, %15, %16 row_newbcast:%17" DPPM
                     : "=&v"(u0), "=&v"(u1), "=&v"(u2), "=&v"(u3)
                     : "v"(P[K]), "v"(P[K + 1]), "v"(P[K + 2]), "v"(P[K + 3]), "v"(in.w[0]), "v"(in.w[1]), "v"(in.w[2]), "v"(in.w[3]), "v"(in.b[0]), "v"(in.b[1]), "v"(in.b[2]), "v"(in.b[3]), "v"(sa), "n"(N0));
        P[K] = u0; P[K + 1] = u1; P[K + 2] = u2; P[K + 3] = u3;
        if constexpr (K + 4 < 64) ScanK<K + 4>::updP(P, in, sa);
    }
};
template <bool MIX> __device__ __forceinline__ void scan_pass1(const Params& p, int d, float* ldsf) {
    const int lane = threadIdx.x & 63, wid = __builtin_amdgcn_readfirstlane(threadIdx.x >> 6); const unsigned lo16 = (lane & 15) * 16, lo2 = lane * 2;
    const float* Wd = (const float*)(p.ws + O_KD); const float* Bd = (const float*)(p.ws + O_Y); const u16* KB = (const u16*)(p.ws + O_K); const float* A = (const float*)(p.ws + O_A);
    const u16* V = (const u16*)(p.ws + O_V); float* PT = (float*)(p.ws + O_PT); float* SLT = (float*)(p.ws + O_SLT); const unsigned lo8 = (lane & 15) * 8;
    constexpr int NS = 32 * (NC - 1);
    unsigned* qctr = (unsigned*)(p.ws + O_BAR);
    if (MIX && wid >= 4) nat_phase(p, ldsf, blockIdx.x * 4 + (wid - 4), gridDim.x * 4);
#define NEXT_ITEM() (MIX ? (int)__builtin_amdgcn_readfirstlane(lane == 0 ? __hip_atomic_fetch_add(qctr, 1u, __ATOMIC_RELAXED, __HIP_MEMORY_SCOPE_AGENT) : 0u) : item + (int)gridDim.x * 8)
    for (int item = MIX ? NEXT_ITEM() : (int)(blockIdx.x * 8 + wid); item < 2 * NS; item = NEXT_ITEM()) {
        const bool isP = item >= NS; const int idx = isP ? item - NS : item;
        const int bh = idx / (NC - 1), c = idx - bh * (NC - 1), b = bh >> 4, h = bh & 15;
        const int t0 = d ? (SEQ - 1 - c * LC) : c * LC;
        const size_t off0 = ((size_t)(b * SEQ + t0)) * RW + h * 64; const long stp = d ? -(long)RW : (long)RW;
        const unsigned ob4 = (unsigned)(off0 * 4), ob2 = (unsigned)(off0 * 2);
        const f32x4 ka4 = *(const f32x4*)(p.k_a + h * 64 + (lane & 15) * 4), c04 = 1.0f - ka4;
        float S[64]; int ln = lane; asm volatile("" : "+v"(ln));
#define SB __builtin_amdgcn_sched_barrier(0)
#define MKR(ptr) __builtin_amdgcn_make_buffer_rsrc((void*)(ptr), 0, 0x7fffffff, 0x00027000)
#define LDX(rs, so4) __builtin_bit_cast(f32x4, __builtin_amdgcn_raw_buffer_load_b128(rs, lo16, so4, 0))
        const __amdgpu_buffer_rsrc_t rW = MKR(Wd), rA = MKR(A), rB = MKR(Bd), rK = MKR(KB), rV = MKR(V);
        if (!isP) {
#pragma unroll
            for (int i = 0; i < 64; ++i) S[i] = 0.f;
#define LD1(set, s) { const int e_ = min((int)(s), LC - 1) * (int)stp; const unsigned s4_ = ob4 + (unsigned)(e_ * 4), s2_ = ob2 + (unsigned)(e_ * 2); set.w = LDX(rW, s4_); set.a = LDX(rA, s4_); set.b = LDX(rB, s4_); \
            set.kw = __builtin_amdgcn_raw_buffer_load_b64(rK, lo8, s2_, 0); set.v = __builtin_amdgcn_raw_buffer_load_b16(rV, lo2, s2_, 0); }
#define TOUCH1(set) asm volatile("" :: "v"(set.w), "v"(set.a), "v"(set.b), "v"(set.kw), "v"(set.v))
#define ST1(set) { DERIVE_BK(set); float sd[4]; ScanK<0>::dot(S, set.a, sd); ScanK<0>::updS(S, set, -((sd[0] + sd[1]) + (sd[2] + sd[3])), __uint_as_float(set.v << 16)); }
            In1 i0, i1; LD1(i0, 0);
#pragma unroll 1
            for (int s = 0; s < LC; s += 2) { TOUCH1(i0); SB; LD1(i1, s + 1); SB; ST1(i0); TOUCH1(i1); SB; LD1(i0, s + 2); SB; ST1(i1); }
#undef LD1
#undef TOUCH1
#undef ST1
        } else {
#pragma unroll
            for (int i = 0; i < 64; ++i) S[i] = (ln == i) ? 1.f : 0.f;
#define LD1(set, s) { const int e_ = min((int)(s), LC - 1) * (int)stp; const unsigned s4_ = ob4 + (unsigned)(e_ * 4); set.w = LDX(rW, s4_); set.a = LDX(rA, s4_); set.b = LDX(rB, s4_); }
#define TOUCH1(set) asm volatile("" :: "v"(set.w), "v"(set.a), "v"(set.b))
#define ST1(set) { DERIVE_B(set); float sd[4]; ScanK<0>::dot(S, set.a, sd); ScanK<0>::updP(S, set, -((sd[0] + sd[1]) + (sd[2] + sd[3]))); }
            In1 i0, i1; LD1(i0, 0);
#pragma unroll 1
            for (int s = 0; s < LC; s += 2) { TOUCH1(i0); SB; LD1(i1, s + 1); SB; ST1(i0); TOUCH1(i1); SB; LD1(i0, s + 2); SB; ST1(i1); }
#undef LD1
#undef TOUCH1
#undef ST1
        }
        float* po = (isP ? PT : SLT) + ((size_t)(bh * NC + c)) * 4096 + lane * 64;
#pragma unroll
        for (int i = 0; i < 16; ++i) *(f32x4*)(po + 4 * i) = (f32x4){S[4 * i], S[4 * i + 1], S[4 * i + 2], S[4 * i + 3]};
    }
}
template <int J> struct CombJ {
    static __device__ __forceinline__ void run(const LAS float* pl, const float (&sq)[4], float (&ac)[4]) {
        const float p0 = pl[(J) * 64], p1 = pl[(16 + J) * 64], p2 = pl[(32 + J) * 64], p3 = pl[(48 + J) * 64];
        asm volatile("v_fmac_f32_dpp %0, %4, %8 row_newbcast:%12" DPPM "v_fmac_f32_dpp %1, %5, %9 row_newbcast:%12" DPPM "v_fmac_f32_dpp %2, %6, %10 row_newbcast:%12" DPPM "v_fmac_f32_dpp %3, %7, %11 row_newbcast:%12" DPPM
                     : "+v"(ac[0]), "+v"(ac[1]), "+v"(ac[2]), "+v"(ac[3]) : "v"(sq[0]), "v"(sq[1]), "v"(sq[2]), "v"(sq[3]), "v"(p0), "v"(p1), "v"(p2), "v"(p3), "n"(J));
        if constexpr (J + 1 < 16) CombJ<J + 1>::run(pl, sq, ac);
    }
};
__device__ __forceinline__ void scan_combine(const Params& p, unsigned char* lds) {
    const int tid = threadIdx.x, lane = tid & 63, wid = __builtin_amdgcn_readfirstlane(tid >> 6), l15 = lane & 15;
    const float* PT = (const float*)(p.ws + O_PT); const float* SLT = (const float*)(p.ws + O_SLT); float* SIT = (float*)(p.ws + O_SIT);
    LAS float* pbuf = (LAS float*)(LAS unsigned char*)lds;
    LAS float* rowb = pbuf + 8192 + wid * 64;
    for (int item = blockIdx.x; item < 256; item += gridDim.x) {
        const int bh = item >> 3, row = (item & 7) * 8 + wid;
        const float* pt = PT + (size_t)bh * NC * 4096 + tid * 8; const float* st = SLT + (size_t)bh * NC * 4096 + row * 64 + lane; float* si = SIT + (size_t)bh * NC * 4096 + row * 64 + lane;
        __syncthreads();
        { const f32x4 pa = *(const f32x4*)pt, pb = *(const f32x4*)(pt + 4); *(LAS f32x4*)(pbuf + tid * 8) = pa; *(LAS f32x4*)(pbuf + tid * 8 + 4) = pb; }
#define PLD(A, B, ci) { const size_t o_ = (size_t)min((int)(ci), NC - 2) * 4096; A = *(const f32x4*)(pt + o_); B = *(const f32x4*)(pt + o_ + 4); }
#define SLD(Sv, ci) { Sv = st[(size_t)min((int)(ci), NC - 2) * 4096]; }
        f32x4 pa0, pb0, pa1, pb1, pa2, pb2; float sl0, sl1, sl2;
        PLD(pa0, pb0, 1); PLD(pa1, pb1, 2); PLD(pa2, pb2, 3); SLD(sl0, 0); SLD(sl1, 1); SLD(sl2, 2);
        float sq[4] = {0.f, 0.f, 0.f, 0.f};
        __syncthreads();
#define CSTEP(c, PA, PB, SLV) { \
            const LAS float* pl = pbuf + ((c) & 1) * 4096 + lane; \
            float ac[4] = {SLV, 0.f, 0.f, 0.f}; \
            CombJ<0>::run(pl, sq, ac); \
            const float acc = (ac[0] + ac[1]) + (ac[2] + ac[3]); \
            rowb[lane] = acc; si[(size_t)((c) + 1) * 4096] = acc; \
            sq[0] = rowb[l15]; sq[1] = rowb[16 + l15]; sq[2] = rowb[32 + l15]; sq[3] = rowb[48 + l15]; \
            { LAS float* pn = pbuf + (((c) + 1) & 1) * 4096 + tid * 8; *(LAS f32x4*)pn = PA; *(LAS f32x4*)(pn + 4) = PB; } \
            PLD(PA, PB, (c) + 4); SLD(SLV, (c) + 3); \
            __syncthreads(); }
#pragma unroll 1
        for (int c = 0; c < NC - 1; c += 3) { CSTEP(c, pa0, pb0, sl0); CSTEP(c + 1, pa1, pb1, sl1); CSTEP(c + 2, pa2, pb2, sl2); }
#undef CSTEP
#undef PLD
#undef SLD
    }
}
__device__ __forceinline__ void scan_pass2(const Params& p, int d) {
    const int lane = threadIdx.x & 63, wid = __builtin_amdgcn_readfirstlane(threadIdx.x >> 6); const unsigned lo16 = (lane & 15) * 16, lo2 = lane * 2, lo4b = lane * 4;
    const float* Wd = (const float*)(p.ws + O_KD); const float* Bd = (const float*)(p.ws + O_Y); const u16* KB = (const u16*)(p.ws + O_K); const float* A = (const float*)(p.ws + O_A); const float* R = (const float*)(p.ws + O_R); const unsigned lo8 = (lane & 15) * 8;
    const u16* V = (const u16*)(p.ws + O_V); const float* SIT = (const float*)(p.ws + O_SIT); float* Y = p.out;
    for (int item = blockIdx.x * 8 + wid; item < 32 * NC; item += gridDim.x * 8) {
        const int bh = item / NC, c = item - bh * NC, b = bh >> 4, h = bh & 15;
        const int t0 = d ? (SEQ - 1 - c * LC) : c * LC;
        const size_t off0 = ((size_t)(b * SEQ + t0)) * RW + h * 64; const long stp = d ? -(long)RW : (long)RW;
        const unsigned ob4 = (unsigned)(off0 * 4), ob2 = (unsigned)(off0 * 2);
        const __amdgpu_buffer_rsrc_t rW = MKR(Wd), rA = MKR(A), rB = MKR(Bd), rK = MKR(KB), rV = MKR(V), rR = MKR(R), rY = MKR(Y);
        const f32x4 ka4 = *(const f32x4*)(p.k_a + h * 64 + (lane & 15) * 4), c04 = 1.0f - ka4;
        float S[64];
        if (c == 0) {
#pragma unroll
            for (int i = 0; i < 64; ++i) S[i] = 0.f;
        } else { const float* si = SIT + ((size_t)(bh * NC + c)) * 4096 + lane * 64;
#pragma unroll
            for (int i = 0; i < 16; ++i) { const f32x4 q = *(const f32x4*)(si + 4 * i); S[4 * i] = q[0]; S[4 * i + 1] = q[1]; S[4 * i + 2] = q[2]; S[4 * i + 3] = q[3]; } }
#define LD2(set, s) { const int e_ = min((int)(s), LC - 1) * (int)stp; const unsigned s4_ = ob4 + (unsigned)(e_ * 4), s2_ = ob2 + (unsigned)(e_ * 2); set.w = LDX(rW, s4_); set.a = LDX(rA, s4_); set.b = LDX(rB, s4_); \
            set.kw = __builtin_amdgcn_raw_buffer_load_b64(rK, lo8, s2_, 0); set.r = LDX(rR, s4_); set.v = __builtin_amdgcn_raw_buffer_load_b16(rV, lo2, s2_, 0); \
            set.yo = d ? __uint_as_float(__builtin_amdgcn_raw_buffer_load_b32(rY, lo4b, s4_, 0)) : 0.f; }
#define ST2(set, s) { DERIVE_BK(set); float sd[4]; ScanK<0>::dot(S, set.a, sd); float y0 = set.yo, y1 = 0.f; ScanK<0>::upd(S, set, -((sd[0] + sd[1]) + (sd[2] + sd[3])), __uint_as_float(set.v << 16), y0, y1); __builtin_amdgcn_raw_buffer_store_b32(__float_as_uint(y0 + y1), rY, lo4b, ob4 + (unsigned)((int)(s) * (int)stp * 4), 0); }
#define TOUCH2(set) asm volatile("" :: "v"(set.w), "v"(set.a), "v"(set.b), "v"(set.kw), "v"(set.r), "v"(set.v), "v"(set.yo))
        In2 i0, i1; LD2(i0, 0);
#pragma unroll 1
        for (int s = 0; s < LC; s += 2) { TOUCH2(i0); SB; LD2(i1, s + 1); SB; ST2(i0, s); TOUCH2(i1); SB; LD2(i0, s + 2); SB; ST2(i1, s + 1); }
#undef LD2
#undef ST2
    }
}

__device__ __forceinline__ void post_phase(const Params& p) {
    const int lane = threadIdx.x & 63, wid = threadIdx.x >> 6;
    const float* Y = p.out; const u16* V = (const u16*)(p.ws + O_V); const u16* ZG = (const u16*)(p.ws + O_ZG); const float* BON = (const float*)(p.ws + O_BON);
    u16* MIX = (u16*)(p.ws + O_HN); u16* PB = (u16*)(p.ws + O_AL);
    for (int t = blockIdx.x * 8 + wid; t < NTOK; t += gridDim.x * 8) {
        const int c = lane * 16; const size_t o = (size_t)t * RW + c;
        float y[16], v[16], g[16]; float s = 0.f;
#pragma unroll
        for (int j4 = 0; j4 < 4; ++j4) { const f32x4 a = *(const f32x4*)(Y + o + j4 * 4); y[j4 * 4] = a[0]; y[j4 * 4 + 1] = a[1]; y[j4 * 4 + 2] = a[2]; y[j4 * 4 + 3] = a[3]; s += a[0] + a[1] + a[2] + a[3]; }
        ld16bf(V + o, v); ld16bf(ZG + o, g);
        s += __shfl_xor(s, 1); s += __shfl_xor(s, 2); const float mu = s * (1.0f / 64.0f);
        float q = 0.f;
#pragma unroll
        for (int j = 0; j < 16; ++j) { y[j] -= mu; q += y[j] * y[j]; }
        q += __shfl_xor(q, 1); q += __shfl_xor(q, 2); const float rs = rsqrtf(q * (1.0f / 64.0f) + 64e-5f);
        const float bon = BON[(size_t)t * 16 + (lane >> 2)];
        float outv[16];
#pragma unroll
        for (int j4 = 0; j4 < 4; ++j4) { const f32x4 lw = *(const f32x4*)(p.lnx_w + c + j4 * 4), lb = *(const f32x4*)(p.lnx_b + c + j4 * 4);
#pragma unroll
            for (int j = 0; j < 4; ++j) { const int i = j4 * 4 + j; const float yn = y[i] * rs * lw[j] + lb[j]; outv[i] = (yn + bon * v[i]) * g[i] * sigmoidf_(g[i]); } }
        st16bf(MIX + (size_t)t * DM + c, outv);
        { const f32x4 pv = *(const f32x4*)(p.p + (size_t)t * 256 + lane * 4); u32x2 w; w.x = cvt_pk_bf16(pv[0], pv[1]); w.y = cvt_pk_bf16(pv[2], pv[3]); *(u32x2*)(PB + (size_t)t * 256 + lane * 4) = w; }
    }
}

#define XB_TMO      128
#define XB_XCNT(j)  (256  + 64 * (j))
#define XB_XSUB(j)  (1280 + 64 * (j))
#define XB_XGEN(j)  (2304 + 64 * (j))
#define XB_TOP      3328
#define XB_TOPGEN   3392
#define XCD_BAR_WORDS 3456
#define XB_SPIN_CAP (1u << 18)
__device__ __forceinline__ unsigned xb_ld(unsigned* p)              { return __hip_atomic_load(p, __ATOMIC_RELAXED, __HIP_MEMORY_SCOPE_AGENT); }
__device__ __forceinline__ unsigned xb_add(unsigned* p, unsigned v) { return __hip_atomic_fetch_add(p, v, __ATOMIC_RELAXED, __HIP_MEMORY_SCOPE_AGENT); }
__device__ __forceinline__ unsigned xb_xcc_id() { return (unsigned)__builtin_amdgcn_s_getreg((3 << 11) | 20) & 0xFu; }
#define XB_SPIN(cond, bar) do { unsigned _sp = 0; while (cond) { __builtin_amdgcn_s_sleep(1); \
    if ((++_sp & 255u) == 0u) { if (xb_ld(&(bar)[XB_TMO])) break; if (_sp > XB_SPIN_CAP) { atomicAdd(&(bar)[XB_TMO], 1u); break; } } } } while (0)
struct XcdBarrier { unsigned* bar; unsigned x; volatile LAS unsigned* st; };
__device__ __forceinline__ XcdBarrier xcd_barrier_post(unsigned* bar, volatile LAS unsigned* st) {
    XcdBarrier b; b.bar = bar; b.x = xb_xcc_id(); b.st = st;
    if (threadIdx.x == 0) (void)xb_add(&bar[XB_XCNT(b.x)], 1u);
    return b;
}
__device__ __forceinline__ void xcd_barrier_complete(unsigned* bar, unsigned x, unsigned& nloc, unsigned& nx) {
    const unsigned G = gridDim.x * gridDim.y * gridDim.z;
    unsigned sum, cnt, mine, sp = 0u;
    for (;;) {
        sum = 0u; cnt = 0u; mine = 0u;
#pragma unroll
        for (unsigned j = 0; j < 16; ++j) { const unsigned c = xb_ld(&bar[XB_XCNT(j)]); sum += c; cnt += (c > 0u) ? 1u : 0u; mine = (j == x) ? c : mine; }
        if (sum == G) break;
        __builtin_amdgcn_s_sleep(1);
        if ((++sp & 255u) == 0u) { if (xb_ld(&bar[XB_TMO])) break; if (sp > XB_SPIN_CAP) { atomicAdd(&bar[XB_TMO], 1u); break; } }
    }
    nloc = mine > 0u ? mine : 1u; nx = cnt > 0u ? cnt : 1u;
}
__device__ __forceinline__ void xcd_barrier(const XcdBarrier& b) {
    asm volatile("s_waitcnt vmcnt(0)" ::: "memory");
    __syncthreads();
    if (threadIdx.x == 0) {
        unsigned* bar = b.bar;
        __builtin_amdgcn_s_waitcnt(0);
        unsigned nloc = b.st[0], nx = b.st[1];
        if (nloc == 0u) { xcd_barrier_complete(bar, b.x, nloc, nx); b.st[0] = nloc; b.st[1] = nx; }
        const unsigned old = xb_add(&bar[XB_XSUB(b.x)], 1u);
        const unsigned gen = old / nloc;
        if (old + 1u == (gen + 1u) * nloc) {
            __builtin_amdgcn_fence(__ATOMIC_RELEASE, "agent");
            asm volatile("s_waitcnt vmcnt(0)" ::: "memory");
            const unsigned og = xb_add(&bar[XB_TOP], 1u);
            const unsigned tg = og / nx;
            if (og + 1u == (tg + 1u) * nx) xb_add(&bar[XB_TOPGEN], 1u);
            else XB_SPIN(xb_ld(&bar[XB_TOPGEN]) == tg, bar);
            __builtin_amdgcn_fence(__ATOMIC_ACQUIRE, "agent");
            xb_add(&bar[XB_XGEN(b.x)], 1u);
            asm volatile("s_waitcnt vmcnt(0)" ::: "memory");
        } else {
            XB_SPIN(xb_ld(&bar[XB_XGEN(b.x)]) == gen, bar);
            __builtin_amdgcn_fence(__ATOMIC_ACQUIRE, "agent");
            asm volatile("s_waitcnt vmcnt(0)" ::: "memory");
        }
    }
    __syncthreads();
}

__global__ void __launch_bounds__(NTHREADS, 2) mega(Params p) {
    extern __shared__ __attribute__((aligned(16))) unsigned char lds[];
    cg::grid_group grid = cg::this_grid();
    unsigned char* ws = p.ws;
    volatile LAS unsigned* xbw = (volatile LAS unsigned*)((LAS unsigned char*)lds + LDS_XB);
    if (threadIdx.x < 4) xbw[threadIdx.x] = 0u;
    __syncthreads();
    const XcdBarrier xbar = xcd_barrier_post((unsigned*)(ws + O_BAR), xbw);
#define PH_ON(n) (p.ph_lo <= (n) && (n) < p.ph_hi)
#define PH_END(n) do { if ((n) + 1 < p.ph_hi) { if ((n) == 0) grid.sync(); else xcd_barrier(xbar); } } while (0)
#ifndef PROBE_PH
#define PROBE_PH -1
#endif
#define RUN(n, ...) if (PH_ON(n)) { __VA_ARGS__ if (PROBE_PH == (n)) { __syncthreads(); __VA_ARGS__ } PH_END(n); }
    RUN(0,
        transpose_cvt(p.w_in, 2048, 8448, (u16*)(ws + O_W1T), 2048, (float*)lds);
        transpose_cvt(p.w_out, 2048, 2048, (u16*)(ws + O_W2T), 2048, (float*)lds);
        transpose_cvt(p.w_ple_gate, 2048, 2048, (u16*)(ws + O_W3T), 2048, (float*)lds);
        transpose_cvt(p.w_ple_proj, 256, 2048, (u16*)(ws + O_WPT), 256, (float*)lds);
        build_wlt(p);
        rownorm<true>(p.x, p.norm_mix_g, ws + O_HN);)
    RUN(1, {
        EpiZ e; e.zs = (u16*)(ws + O_ZS); e.zg = (u16*)(ws + O_ZG); e.qn = (u16*)p.out; e.kn = e.qn + (size_t)NTOK * RW; e.vt = e.kn + (size_t)NTOK * RW; e.gn = e.vt + (size_t)NTOK * RW;
        run_gemm(lds, (const u16*)(ws + O_HN), (const u16*)(ws + O_W1T), NTOK, 8448, 2048, e); })
    RUN(2, prep_phase(p);)
#define SCAN_DIR(d, pb) \
    RUN(pb, { \
        EpiLora e; e.w0 = p.decay_w0 + (d) * RW; e.a0 = p.iclr_a0 + (d) * RW; e.Wd = (float*)(ws + O_KD); e.IC = (float*)(ws + O_Y); \
        run_gemm(lds, (const u16*)(ws + O_AL) + 128 * (d), (const u16*)(ws + O_WLT) + (size_t)(d) * 2048 * 128, NTOK, 2048, 128, e, 256, 128); }) \
    RUN(pb + 1, scan_pass1<(d) == 0>(p, d, (float*)lds);) \
    RUN(pb + 2, scan_combine(p, lds);) \
    RUN(pb + 3, scan_pass2(p, d);)
    SCAN_DIR(0, 3)
    SCAN_DIR(1, 7)
    RUN(11, post_phase(p);)
    RUN(12, {
        EpiH e; e.X = p.x; e.H = p.out;
        run_gemm(lds, (const u16*)(ws + O_HN), (const u16*)(ws + O_W2T), NTOK, 2048, 2048, e);
        EpiBf e2; e2.O = (u16*)(ws + O_R); e2.ld = DM;
        run_gemm(lds, (const u16*)(ws + O_AL), (const u16*)(ws + O_WPT), NTOK, 2048, 256, e2); })
    RUN(13, rownorm<true>(p.out, p.ple_norm_g, ws + O_HN);)
    RUN(14, {
        EpiGate e; e.H = p.out; e.PP = (const u16*)(ws + O_R);
        run_gemm(lds, (const u16*)(ws + O_HN), (const u16*)(ws + O_W3T), NTOK, 2048, 2048, e); })
    RUN(15, rownorm<false>(p.out, p.final_g, p.out);)
}

extern "C" void kernel_launch(void* const* d_in, const int* in_sizes, int n_in, void* d_out, int out_size, void* d_ws, size_t ws_size, hipStream_t stream) {
    static int grid = 0;
    if (grid == 0) {
        if (n_in != 21 || out_size != NTOK * DM || ws_size < WS_END) { fprintf(stderr, "kernel_launch: unexpected shapes (n_in %d out %d ws %zu need %zu)\n", n_in, out_size, ws_size, (size_t)WS_END); grid = -1; return; }
        int dev = 0, cus = 0, per_cu = 0;
        hipGetDevice(&dev); hipDeviceGetAttribute(&cus, hipDeviceAttributeMultiprocessorCount, dev);
        hipFuncSetAttribute((const void*)mega, hipFuncAttributeMaxDynamicSharedMemorySize, LDS_BYTES);
        hipOccupancyMaxActiveBlocksPerMultiprocessor(&per_cu, (const void*)mega, NTHREADS, LDS_BYTES);
        if (per_cu < 1) { fprintf(stderr, "kernel_launch: occupancy query says %d blocks/CU\n", per_cu); grid = -1; return; }
        grid = cus;
    }
    if (grid < 0) return;
    Params p{};
    const float** f = (const float**)&p;
    for (int i = 0; i < 21; ++i) f[i] = (const float*)d_in[i];
    p.out = (float*)d_out; p.ws = (unsigned char*)d_ws;
    hipMemsetAsync((unsigned char*)d_ws + O_BAR, 0, XCD_BAR_WORDS * sizeof(unsigned), stream);
#if MULTI_LAUNCH
    for (int ph = 0; ph < 16; ++ph) { p.ph_lo = ph; p.ph_hi = ph + 1; hipLaunchKernelGGL(mega, dim3(grid), dim3(NTHREADS), LDS_BYTES, stream, p); }
#else
    p.ph_lo = 0; p.ph_hi = 16;
    void* args[] = {&p};
    hipError_t e = hipLaunchCooperativeKernel((const void*)mega, dim3(grid), dim3(NTHREADS), args, LDS_BYTES, stream);
    if (e != hipSuccess) fprintf(stderr, "cooperative launch failed: %s (grid %d)\n", hipGetErrorString(e), grid);
#endif
}
```

```cpp
#include <hip/hip_runtime.h>
#include <hip/hip_cooperative_groups.h>
#include <cstdio>
namespace cg = cooperative_groups;

#ifndef MULTI_LAUNCH
#define MULTI_LAUNCH 0
#endif

#define LAS __attribute__((address_space(3)))
typedef unsigned short u16;
typedef short bf16x8 __attribute__((ext_vector_type(8)));
typedef float f32x4 __attribute__((ext_vector_type(4)));
typedef float f32x2 __attribute__((ext_vector_type(2)));
typedef unsigned u32x4 __attribute__((ext_vector_type(4)));
typedef unsigned u32x2 __attribute__((ext_vector_type(2)));
typedef const __attribute__((address_space(4))) f32x2* cf2p;

constexpr int SEQ = 16384, NTOK = 32768, DM = 2048, RW = 1024;
constexpr int NC = 64, LC = SEQ / NC;
constexpr int NTHREADS = 512, LDS_XB = 131072, LDS_BYTES = 131072 + 16;
constexpr float DECAY_SCALE = 0.6065306597126334f;

constexpr size_t MiB = 1ull << 20;
constexpr size_t O_W1T = 0, O_W2T = 33 * MiB, O_W3T = 41 * MiB, O_WPT = 49 * MiB, O_WLT = 50 * MiB;
constexpr size_t O_HN = 56 * MiB;
constexpr size_t O_ZS = 184 * MiB;
constexpr size_t O_KD = O_ZS, O_PT = O_ZS + 128 * MiB, O_SLT = O_ZS + 160 * MiB;
constexpr size_t O_ZG = 392 * MiB;
constexpr size_t O_R = 456 * MiB;
constexpr size_t O_A = 584 * MiB;
constexpr size_t O_V = 712 * MiB;
constexpr size_t O_K = 776 * MiB;
constexpr size_t O_AL = 840 * MiB;
constexpr size_t O_BON = 856 * MiB;
constexpr size_t O_Y = 858 * MiB;
constexpr size_t O_SIT = 986 * MiB;
constexpr size_t O_BAR = 1018 * MiB;
constexpr size_t WS_END = 1019 * MiB;

struct Params {
    const float *x, *p, *norm_mix_g, *w_in, *mu_prev, *mu_next, *decay_w0, *decay_w2, *iclr_a0, *iclr_a2, *k_k, *k_a, *r_k, *lnx_w, *lnx_b, *rpb, *w_out,
        *ple_norm_g, *w_ple_gate, *w_ple_proj, *final_g;
    float* out; unsigned char* ws;
    int ph_lo, ph_hi;
};

__device__ __forceinline__ float bf2f(u16 b) { return __uint_as_float(((unsigned)b) << 16); }
__device__ __forceinline__ float bflo(unsigned w) { return __uint_as_float(w << 16); }
__device__ __forceinline__ float bfhi(unsigned w) { return __uint_as_float(w & 0xffff0000u); }
__device__ __forceinline__ unsigned cvt_pk_bf16(float lo, float hi) { unsigned r; asm volatile("v_cvt_pk_bf16_f32 %0, %1, %2" : "=v"(r) : "v"(lo), "v"(hi)); return r; }
__device__ __forceinline__ float sigmoidf_(float x) { return __builtin_amdgcn_rcpf(1.0f + __expf(-x)); }
__device__ __forceinline__ f32x2 fma2(f32x2 a, f32x2 b, f32x2 c) { return __builtin_elementwise_fma(a, b, c); }

namespace pg8 {
constexpr int BM = 256, BK = 64, HALF = 128, HTB = HALF * BK * 2, NXCD = 8, WGM = 8;
__device__ __forceinline__ int lds_byte(int r, int c) { const int st = (r >> 4) * 2 + (c >> 5), rr = r & 15, cc = c & 31, ob = rr * 64 + cc * 2; return st * 1024 + (ob ^ (((ob >> 9) & 1) << 5)); }
__device__ __forceinline__ void stage_rc(int b, int& R, int& C) { const int st = b / 1024, sb = b % 1024, swz = sb ^ (((sb >> 9) & 1) << 5); R = (st >> 1) * 16 + swz / 64; C = (st & 1) * 32 + (swz % 64) / 2; }
__device__ __forceinline__ int perm32(int rho) { const int n = rho >> 4, i = rho & 15; return 8 * (i >> 2) + 4 * n + (i & 3); }
struct Unit { int pm, pn; };
struct Gemm { const u16* A; const u16* Bt; int M, N, K, lda, ldb; };
struct StaticOrder {
    int nM, nN, nwg, G, c;
    __device__ void init(int M, int N, int G_, int c_) { nM = M / BM; nN = N / BM; nwg = nM * nN; G = G_; c = c_; }
    __device__ bool next(int i, Unit& u) const {
        const long L = (long)i * G + c; if (L >= nwg) return false;
        int wgid = (int)L; { const int q = nwg / NXCD, r = nwg % NXCD, xcd = wgid % NXCD, off = wgid / NXCD; wgid = (xcd < r ? xcd * (q + 1) : r * (q + 1) + (xcd - r) * q) + off; }
        const int nig = WGM * nN, gid = wgid / nig, fm = gid * WGM, gsz = (nM - fm) < WGM ? (nM - fm) : WGM;
        u.pm = fm + ((wgid % nig) % gsz); u.pn = (wgid % nig) / gsz; return true;
    }
};
template <class Epi>
__device__ __forceinline__ void gemm_phase(LAS unsigned char* lds, const Gemm g, const StaticOrder& S, const Epi& E) {
    const int tid = threadIdx.x, wid = __builtin_amdgcn_readfirstlane(tid >> 6), lane = tid & 63, wr = wid >> 2, wc = wid & 3, fr = lane & 15, fq = lane >> 4;
    const int K = g.K, nt = K / BK;
    unsigned voffA[2], voffB[2];
#pragma unroll
    for (int i = 0; i < 2; ++i) { int R, C; stage_rc(tid * 16 + i * 8192, R, C); const int Rb = Epi::PERM ? ((R & ~31) + perm32(R & 31)) : R;
        voffA[i] = (unsigned)(R * g.lda + C) * 2u; voffB[i] = (unsigned)(Rb * g.ldb + C) * 2u; }
    const size_t kstep = (size_t)(BK * 2);
    const size_t hstepA = (size_t)HALF * g.lda * 2, hstepB = (size_t)HALF * g.ldb * 2;
    const size_t tstepA = 2 * hstepA, tstepB = 2 * hstepB;
    const unsigned ldsw = (unsigned)wid * 1024u;
    const int aoff = lds_byte(wr * 64 + fr, fq * 8), boff = lds_byte(wc * 32 + fr, fq * 8);
#define PG8_SA(b, h) (((b) * 2 + (h)) * HTB)
#define PG8_SB(b, h) ((4 + (b) * 2 + (h)) * HTB)
#define PG8_STAGE(bufoff, gbase, voff) do { _Pragma("unroll") for (int _i = 0; _i < 2; ++_i) \
        __builtin_amdgcn_global_load_lds((const unsigned*)((const char*)(gbase) + (voff)[_i]), (LAS unsigned*)(lds + (bufoff) + ldsw + _i * 8192), 16, 0, 0); } while (0)
#define PG8_LDA(dst, b, h) do { _Pragma("unroll") for (int m = 0; m < 4; ++m) _Pragma("unroll") for (int k = 0; k < 2; ++k) dst[m][k] = *(const LAS bf16x8*)(lds + PG8_SA(b, h) + aoff + m * 2048 + k * 1024); } while (0)
#define PG8_LDB(dst, b, h) do { _Pragma("unroll") for (int n = 0; n < 2; ++n) _Pragma("unroll") for (int k = 0; k < 2; ++k) dst[n][k] = *(const LAS bf16x8*)(lds + PG8_SB(b, h) + boff + n * 2048 + k * 1024); } while (0)
#define PG8_MMA(ai, bj, At, Bt) do { __builtin_amdgcn_s_setprio(1); _Pragma("unroll") for (int m = 0; m < 4; ++m) _Pragma("unroll") for (int n = 0; n < 2; ++n) _Pragma("unroll") for (int k = 0; k < 2; ++k) \
        acc[ai][bj][m][n] = __builtin_amdgcn_mfma_f32_16x16x32_bf16(Bt[n][k], At[m][k], acc[ai][bj][m][n], 0, 0, 0); __builtin_amdgcn_s_setprio(0); } while (0)
#define PG8_WAIT_V(n) asm volatile("s_waitcnt vmcnt(" #n ")" ::: "memory")
#define PG8_WAIT_L(n) asm volatile("s_waitcnt lgkmcnt(" #n ")" ::: "memory")
#define PG8_BAR __builtin_amdgcn_s_barrier()
#define PG8_SCHED __builtin_amdgcn_sched_barrier(0)
    Unit cur, nxt; int ui = 0;
    if (!S.next(0, cur)) return;
    f32x4 acc[2][2][4][2];
#pragma unroll
    for (int a = 0; a < 2; ++a)
#pragma unroll
        for (int b = 0; b < 2; ++b)
#pragma unroll
            for (int m = 0; m < 4; ++m)
#pragma unroll
                for (int n = 0; n < 2; ++n) acc[a][b][m][n] = (f32x4){0.f, 0.f, 0.f, 0.f};
    bf16x8 At[4][2], B0[2][2], B1[2][2];
    const char* cA = (const char*)g.A + (size_t)cur.pm * tstepA; const char* cB = (const char*)g.Bt + (size_t)cur.pn * tstepB;
    PG8_STAGE(PG8_SB(0, 0), cB, voffB); PG8_STAGE(PG8_SA(0, 0), cA, voffA); PG8_STAGE(PG8_SB(0, 1), cB + hstepB, voffB); PG8_STAGE(PG8_SA(0, 1), cA + hstepA, voffA);
    if (wr == 1) PG8_BAR;
    PG8_WAIT_V(4); PG8_BAR;
    PG8_STAGE(PG8_SB(1, 0), cB + kstep, voffB); PG8_STAGE(PG8_SA(1, 0), cA + kstep, voffA); PG8_STAGE(PG8_SB(1, 1), cB + hstepB + kstep, voffB);
    PG8_WAIT_V(6); PG8_BAR;
    for (;;) {
        const bool has_next = S.next(ui + 1, nxt);
        const char* nA = has_next ? (const char*)g.A + (size_t)nxt.pm * tstepA : cA; const char* nB = has_next ? (const char*)g.Bt + (size_t)nxt.pn * tstepB : cB;
        for (int t = 0; t < nt; t += 2) {
            const bool last = (t == nt - 2);
            const char* a1 = cA + (size_t)(t + 1) * kstep;
            const char* a2 = last ? nA : cA + (size_t)(t + 2) * kstep; const char* b2 = last ? nB : cB + (size_t)(t + 2) * kstep;
            const char* a3 = a2 + kstep; const char* b3 = b2 + kstep;
            PG8_LDB(B0, 0, 0); PG8_SCHED; PG8_LDA(At, 0, 0); PG8_STAGE(PG8_SA(1, 1), a1 + hstepA, voffA);
            PG8_WAIT_L(8); PG8_BAR; PG8_WAIT_L(0); PG8_MMA(0, 0, At, B0); PG8_BAR; PG8_SCHED;
            PG8_LDB(B1, 0, 1); PG8_STAGE(PG8_SB(0, 0), b2, voffB);
            PG8_BAR; PG8_WAIT_L(0); PG8_MMA(0, 1, At, B1); PG8_BAR;
            PG8_LDA(At, 0, 1); PG8_STAGE(PG8_SA(0, 0), a2, voffA);
            PG8_BAR; PG8_WAIT_L(0); PG8_MMA(1, 0, At, B0); PG8_BAR; PG8_SCHED;
            PG8_STAGE(PG8_SB(0, 1), b2 + hstepB, voffB);
            PG8_WAIT_V(6); PG8_BAR; PG8_MMA(1, 1, At, B1); PG8_BAR;
            PG8_LDB(B0, 1, 0); PG8_SCHED; PG8_LDA(At, 1, 0); PG8_STAGE(PG8_SA(0, 1), a2 + hstepA, voffA);
            PG8_WAIT_L(8); PG8_BAR; PG8_WAIT_L(0); PG8_MMA(0, 0, At, B0); PG8_BAR; PG8_SCHED;
            PG8_LDB(B1, 1, 1); PG8_STAGE(PG8_SB(1, 0), b3, voffB);
            PG8_BAR; PG8_WAIT_L(0); PG8_MMA(0, 1, At, B1); PG8_BAR;
            PG8_LDA(At, 1, 1); PG8_STAGE(PG8_SA(1, 0), a3, voffA);
            PG8_BAR; PG8_WAIT_L(0); PG8_MMA(1, 0, At, B0); PG8_BAR; PG8_SCHED;
            PG8_STAGE(PG8_SB(1, 1), b3 + hstepB, voffB);
            PG8_WAIT_V(6); PG8_BAR; PG8_MMA(1, 1, At, B1); PG8_BAR;
        }
        E(acc, cur, wr, wc, fr, fq);
        if (!has_next) break;
#pragma unroll
        for (int a = 0; a < 2; ++a)
#pragma unroll
            for (int b = 0; b < 2; ++b)
#pragma unroll
                for (int m = 0; m < 4; ++m)
#pragma unroll
                    for (int n = 0; n < 2; ++n) acc[a][b][m][n] = (f32x4){0.f, 0.f, 0.f, 0.f};
        cur = nxt; cA = nA; cB = nB; ++ui;
    }
    PG8_WAIT_V(0);
    if (wr == 0) PG8_BAR;
    PG8_BAR;
#undef PG8_SA
#undef PG8_SB
#undef PG8_STAGE
#undef PG8_LDA
#undef PG8_LDB
#undef PG8_MMA
#undef PG8_WAIT_V
#undef PG8_WAIT_L
#undef PG8_BAR
#undef PG8_SCHED
}
}
using pg8::Unit;
typedef f32x4 AccT[2][2][4][2];

struct EpiZ {
    static constexpr bool PERM = true;
    u16 *zs, *zg, *qn, *kn, *vt, *gn;
    __device__ __forceinline__ void operator()(const AccT& acc, const Unit& u, int wr, int wc, int fr, int fq) const {
        const int row0 = u.pm * 256 + wr * 64 + fr; const int pn = u.pn;
        if (pn >= 25 && pn < 29) {
            const int cb = (pn - 25) * 256 + wc * 32 + 8 * fq;
#pragma unroll
            for (int ai = 0; ai < 2; ++ai)
#pragma unroll
                for (int m = 0; m < 4; ++m) { const int row = row0 + ai * 128 + m * 16; const int b = row >> 14, tt = row & (SEQ - 1);
#pragma unroll
                    for (int bj = 0; bj < 2; ++bj)
#pragma unroll
                        for (int n = 0; n < 2; ++n)
#pragma unroll
                            for (int j = 0; j < 4; ++j) { const int ch = cb + bj * 128 + 4 * n + j;
                                vt[((size_t)(b * 1024 + ch)) * SEQ + tt] = (u16)(cvt_pk_bf16(acc[ai][bj][m][n][j], 0.f) & 0xffffu); } }
            return;
        }
        u16* base; int ld, colt;
        if (pn < 13) { base = zs; ld = 3328; colt = pn * 256; }
        else if (pn < 17) { base = zg; ld = 1024; colt = (pn - 13) * 256; }
        else if (pn < 21) { base = qn; ld = 1024; colt = (pn - 17) * 256; }
        else if (pn < 25) { base = kn; ld = 1024; colt = (pn - 21) * 256; }
        else { base = gn; ld = 1024; colt = (pn - 29) * 256; }
        const int col0 = colt + wc * 32 + 8 * fq;
#pragma unroll
        for (int ai = 0; ai < 2; ++ai)
#pragma unroll
            for (int m = 0; m < 4; ++m) { u16* rowp = base + (size_t)(row0 + ai * 128 + m * 16) * ld + col0;
#pragma unroll
                for (int bj = 0; bj < 2; ++bj) { const f32x4 v0 = acc[ai][bj][m][0], v1 = acc[ai][bj][m][1];
                    u32x4 w; w.x = cvt_pk_bf16(v0[0], v0[1]); w.y = cvt_pk_bf16(v0[2], v0[3]); w.z = cvt_pk_bf16(v1[0], v1[1]); w.w = cvt_pk_bf16(v1[2], v1[3]);
                    *(u32x4*)(rowp + bj * 128) = w; } }
    }
};
struct EpiBf {
    static constexpr bool PERM = true;
    u16* O; int ld;
    __device__ __forceinline__ void operator()(const AccT& acc, const Unit& u, int wr, int wc, int fr, int fq) const {
        const int row0 = u.pm * 256 + wr * 64 + fr, col0 = u.pn * 256 + wc * 32 + 8 * fq;
#pragma unroll
        for (int ai = 0; ai < 2; ++ai)
#pragma unroll
            for (int m = 0; m < 4; ++m) { u16* rowp = O + (size_t)(row0 + ai * 128 + m * 16) * ld + col0;
#pragma unroll
                for (int bj = 0; bj < 2; ++bj) { const f32x4 v0 = acc[ai][bj][m][0], v1 = acc[ai][bj][m][1];
                    u32x4 w; w.x = cvt_pk_bf16(v0[0], v0[1]); w.y = cvt_pk_bf16(v0[2], v0[3]); w.z = cvt_pk_bf16(v1[0], v1[1]); w.w = cvt_pk_bf16(v1[2], v1[3]);
                    *(u32x4*)(rowp + bj * 128) = w; } }
    }
};
struct EpiLora {
    static constexpr bool PERM = false;
    const float *w0, *a0; float *Wd, *IC;
    __device__ __forceinline__ void operator()(const AccT& acc, const Unit& u, int wr, int wc, int fr, int fq) const {
        const int row0 = u.pm * 256 + wr * 64 + fr, col0 = u.pn * 256 + wc * 32 + 4 * fq;
        if (u.pn < 4) {
#pragma unroll
            for (int bj = 0; bj < 2; ++bj)
#pragma unroll
                for (int n = 0; n < 2; ++n) { const int col = col0 + bj * 128 + n * 16; const f32x4 wv = *(const f32x4*)(w0 + col);
#pragma unroll
                    for (int ai = 0; ai < 2; ++ai)
#pragma unroll
                        for (int m = 0; m < 4; ++m) { const int row = row0 + ai * 128 + m * 16; f32x4 o;
#pragma unroll
                            for (int j = 0; j < 4; ++j) o[j] = __expf(-DECAY_SCALE * sigmoidf_(wv[j] + acc[ai][bj][m][n][j]));
                            *(f32x4*)(Wd + (size_t)row * RW + col) = o; asm volatile("" ::: "memory"); } }
        } else {
#pragma unroll
            for (int bj = 0; bj < 2; ++bj)
#pragma unroll
                for (int n = 0; n < 2; ++n) { const int col = col0 - 1024 + bj * 128 + n * 16; const f32x4 av0 = *(const f32x4*)(a0 + col);
#pragma unroll
                    for (int ai = 0; ai < 2; ++ai)
#pragma unroll
                        for (int m = 0; m < 4; ++m) { const int row = row0 + ai * 128 + m * 16; f32x4 o;
#pragma unroll
                            for (int j = 0; j < 4; ++j) o[j] = sigmoidf_(av0[j] + acc[ai][bj][m][n][j]);
                            *(f32x4*)(IC + (size_t)row * RW + col) = o; asm volatile("" ::: "memory"); } }
        }
    }
};
struct EpiH {
    static constexpr bool PERM = false;
    const float* X; float* H;
    __device__ __forceinline__ void operator()(const AccT& acc, const Unit& u, int wr, int wc, int fr, int fq) const {
        const int row0 = u.pm * 256 + wr * 64 + fr, col0 = u.pn * 256 + wc * 32 + 4 * fq;
#pragma unroll
        for (int ai = 0; ai < 2; ++ai)
#pragma unroll
            for (int m = 0; m < 4; ++m) { const size_t ro = (size_t)(row0 + ai * 128 + m * 16) * DM + col0;
#pragma unroll
                for (int bj = 0; bj < 2; ++bj)
#pragma unroll
                    for (int n = 0; n < 2; ++n) { const size_t o = ro + bj * 128 + n * 16; *(f32x4*)(H + o) = acc[ai][bj][m][n] + *(const f32x4*)(X + o); } asm volatile("" ::: "memory"); }
    }
};
struct EpiGate {
    static constexpr bool PERM = false;
    float* H; const u16* PP;
    __device__ __forceinline__ void operator()(const AccT& acc, const Unit& u, int wr, int wc, int fr, int fq) const {
        const int row0 = u.pm * 256 + wr * 64 + fr, col0 = u.pn * 256 + wc * 32 + 4 * fq;
#pragma unroll
        for (int ai = 0; ai < 2; ++ai)
#pragma unroll
            for (int m = 0; m < 4; ++m) { const size_t ro = (size_t)(row0 + ai * 128 + m * 16) * DM + col0;
#pragma unroll
                for (int bj = 0; bj < 2; ++bj)
#pragma unroll
                    for (int n = 0; n < 2; ++n) { const size_t o = ro + bj * 128 + n * 16; const f32x4 h = *(const f32x4*)(H + o); const u32x2 pw = *(const u32x2*)(PP + o);
                        const f32x4 a = acc[ai][bj][m][n]; f32x4 r;
                        r[0] = h[0] + bflo(pw.x) * sigmoidf_(a[0]); r[1] = h[1] + bfhi(pw.x) * sigmoidf_(a[1]); r[2] = h[2] + bflo(pw.y) * sigmoidf_(a[2]); r[3] = h[3] + bfhi(pw.y) * sigmoidf_(a[3]);
                        *(f32x4*)(H + o) = r; asm volatile("" ::: "memory"); } }
    }
};

template <class Epi> __device__ __forceinline__ void run_gemm(unsigned char* lds, const u16* A, const u16* Bt, int M, int N, int K, const Epi& E, int lda = 0, int ldb = 0) {
    pg8::Gemm g; g.A = A; g.Bt = Bt; g.M = M; g.N = N; g.K = K; g.lda = lda ? lda : K; g.ldb = ldb ? ldb : K;
    pg8::StaticOrder S; S.init(M, N, gridDim.x, blockIdx.x);
    pg8::gemm_phase<Epi>((LAS unsigned char*)lds, g, S, E);
    __syncthreads();
}

__device__ __forceinline__ void transpose_cvt(const float* __restrict__ src, int K, int N, u16* __restrict__ dst, int ldd, float* tile) {
    const int tid = threadIdx.x, tn = N / 64, ntile = (K / 64) * tn, G = gridDim.x;
    for (int t = blockIdx.x; t < ntile; t += 4 * G) {
        f32x4 v[4][2];
#pragma unroll
        for (int u = 0; u < 4; ++u) { const int tt = t + u * G; if (tt < ntile) { const int k0 = (tt / tn) * 64, n0 = (tt % tn) * 64;
#pragma unroll
            for (int ps = 0; ps < 2; ++ps) { const int r = (tid >> 4) + ps * 32, c4 = (tid & 15) * 4; v[u][ps] = *(const f32x4*)(src + (size_t)(k0 + r) * N + n0 + c4); } } }
#pragma unroll
        for (int u = 0; u < 4; ++u) { if (t + u * G < ntile) { float* tl = tile + u * (64 * 65);
#pragma unroll
            for (int ps = 0; ps < 2; ++ps) { const int r = (tid >> 4) + ps * 32, c4 = (tid & 15) * 4; tl[r * 65 + c4] = v[u][ps][0]; tl[r * 65 + c4 + 1] = v[u][ps][1]; tl[r * 65 + c4 + 2] = v[u][ps][2]; tl[r * 65 + c4 + 3] = v[u][ps][3]; } } }
        __syncthreads();
#pragma unroll
        for (int u = 0; u < 4; ++u) { const int tt = t + u * G; if (tt < ntile) { const int k0 = (tt / tn) * 64, n0 = (tt % tn) * 64; const float* tl = tile + u * (64 * 65);
            const int n = tid >> 3, ks = (tid & 7) * 8; u32x4 w;
            w.x = cvt_pk_bf16(tl[(ks + 0) * 65 + n], tl[(ks + 1) * 65 + n]); w.y = cvt_pk_bf16(tl[(ks + 2) * 65 + n], tl[(ks + 3) * 65 + n]);
            w.z = cvt_pk_bf16(tl[(ks + 4) * 65 + n], tl[(ks + 5) * 65 + n]); w.w = cvt_pk_bf16(tl[(ks + 6) * 65 + n], tl[(ks + 7) * 65 + n]);
            *(u32x4*)(dst + (size_t)(n0 + n) * ldd + k0 + ks) = w; } }
        __syncthreads();
    }
}
__device__ __forceinline__ void build_wlt(const Params& p) {
    u16* W = (u16*)(p.ws + O_WLT);
    for (int i = blockIdx.x * NTHREADS + threadIdx.x; i < 2 * 2048 * 128; i += gridDim.x * NTHREADS) {
        const int k = i & 127, n = (i >> 7) & 2047, d = i >> 18; float v = 0.f;
        if (n < 1024) { if (k < 64) v = p.decay_w2[((size_t)d * 64 + k) * RW + n]; }
        else { if (k >= 64) v = p.iclr_a2[((size_t)d * 64 + (k - 64)) * RW + (n - 1024)]; }
        W[i] = (u16)(cvt_pk_bf16(v, 0.f) & 0xffffu);
    }
}
template <bool BF> __device__ __forceinline__ void rownorm(const float* src, const float* __restrict__ g, void* dst) {
    const int lane = threadIdx.x & 63, wid = threadIdx.x >> 6;
    for (int row = blockIdx.x * 8 + wid; row < NTOK; row += gridDim.x * 8) {
        const float* s = src + (size_t)row * DM + lane * 4; f32x4 v[8]; float ss = 0.f;
#pragma unroll
        for (int i = 0; i < 8; ++i) { v[i] = *(const f32x4*)(s + i * 256); ss += v[i][0] * v[i][0] + v[i][1] * v[i][1] + v[i][2] * v[i][2] + v[i][3] * v[i][3]; }
#pragma unroll
        for (int o = 32; o >= 1; o >>= 1) ss += __shfl_xor(ss, o);
        const float sc = rsqrtf(ss * (1.0f / DM) + 1e-6f);
#pragma unroll
        for (int i = 0; i < 8; ++i) { const f32x4 gv = *(const f32x4*)(g + lane * 4 + i * 256); const f32x4 o = v[i] * sc * gv;
            if (BF) { u32x2 w; w.x = cvt_pk_bf16(o[0], o[1]); w.y = cvt_pk_bf16(o[2], o[3]); *(u32x2*)((u16*)dst + (size_t)row * DM + lane * 4 + i * 256) = w; }
            else *(f32x4*)((float*)dst + (size_t)row * DM + lane * 4 + i * 256) = o; }
    }
}

__device__ __forceinline__ void ld16bf(const u16* p, float* o) {
    const u32x4 a = *(const u32x4*)p, b = *(const u32x4*)(p + 8);
    o[0] = bflo(a.x); o[1] = bfhi(a.x); o[2] = bflo(a.y); o[3] = bfhi(a.y); o[4] = bflo(a.z); o[5] = bfhi(a.z); o[6] = bflo(a.w); o[7] = bfhi(a.w);
    o[8] = bflo(b.x); o[9] = bfhi(b.x); o[10] = bflo(b.y); o[11] = bfhi(b.y); o[12] = bflo(b.z); o[13] = bfhi(b.z); o[14] = bflo(b.w); o[15] = bfhi(b.w);
}
__device__ __forceinline__ void st16bf(u16* p, const float* v) {
    u32x4 a, b; a.x = cvt_pk_bf16(v[0], v[1]); a.y = cvt_pk_bf16(v[2], v[3]); a.z = cvt_pk_bf16(v[4], v[5]); a.w = cvt_pk_bf16(v[6], v[7]);
    b.x = cvt_pk_bf16(v[8], v[9]); b.y = cvt_pk_bf16(v[10], v[11]); b.z = cvt_pk_bf16(v[12], v[13]); b.w = cvt_pk_bf16(v[14], v[15]);
    *(u32x4*)p = a; *(u32x4*)(p + 8) = b;
}
__device__ __forceinline__ void shift16(const u16* zc, bool hp, bool hn, const float* __restrict__ mp, const float* __restrict__ mn, int c, float* o) {
    float z[16], zp[16], zn[16]; ld16bf(zc + c, z);
    if (hp) ld16bf(zc - 3328 + c, zp); else {
#pragma unroll
        for (int j = 0; j < 16; ++j) zp[j] = 0.f; }
    if (hn) ld16bf(zc + 3328 + c, zn); else {
#pragma unroll
        for (int j = 0; j < 16; ++j) zn[j] = 0.f; }
#pragma unroll
    for (int j4 = 0; j4 < 4; ++j4) { const f32x4 a = *(const f32x4*)(mp + c + j4 * 4), b = *(const f32x4*)(mn + c + j4 * 4);
#pragma unroll
        for (int j = 0; j < 4; ++j) { const int q = j4 * 4 + j; o[q] = z[q] + a[j] * (zp[q] - z[q]) + b[j] * (zn[q] - z[q]); } }
}
struct Z16 { u32x4 a, b; };
__device__ __forceinline__ Z16 ldz(const u16* p) { Z16 z; z.a = *(const u32x4*)p; z.b = *(const u32x4*)(p + 8); return z; }
__device__ __forceinline__ Z16 zz() { Z16 z; z.a = (u32x4){0u, 0u, 0u, 0u}; z.b = z.a; return z; }
__device__ __forceinline__ void unz(const Z16& z, float* o) {
    o[0] = bflo(z.a.x); o[1] = bfhi(z.a.x); o[2] = bflo(z.a.y); o[3] = bfhi(z.a.y); o[4] = bflo(z.a.z); o[5] = bfhi(z.a.z); o[6] = bflo(z.a.w); o[7] = bfhi(z.a.w);
    o[8] = bflo(z.b.x); o[9] = bfhi(z.b.x); o[10] = bflo(z.b.y); o[11] = bfhi(z.b.y); o[12] = bflo(z.b.z); o[13] = bfhi(z.b.z); o[14] = bflo(z.b.w); o[15] = bfhi(z.b.w);
}
__device__ __forceinline__ void ld16f(const float* p, float* o) {
#pragma unroll
    for (int j = 0; j < 4; ++j) { const f32x4 v = *(const f32x4*)(p + 4 * j); o[4 * j] = v[0]; o[4 * j + 1] = v[1]; o[4 * j + 2] = v[2]; o[4 * j + 3] = v[3]; }
}
__device__ __forceinline__ void mix16(const Z16& zp, const Z16& zc, const Z16& zn, const float* mp, const float* mn, float* o) {
    float p_[16], c_[16], n_[16]; unz(zp, p_); unz(zc, c_); unz(zn, n_);
#pragma unroll
    for (int q = 0; q < 16; ++q) o[q] = c_[q] + mp[q] * (p_[q] - c_[q]) + mn[q] * (n_[q] - c_[q]);
}
__device__ __forceinline__ void prep_phase(const Params& p) {
    const int lane = threadIdx.x & 63, wid = threadIdx.x >> 6, c = lane * 16;
    const u16* ZS = (const u16*)(p.ws + O_ZS);
    float* R = (float*)(p.ws + O_R); float* A = (float*)(p.ws + O_A); u16* V = (u16*)(p.ws + O_V); u16* Kb = (u16*)(p.ws + O_K); u16* AL = (u16*)(p.ws + O_AL); float* BON = (float*)(p.ws + O_BON);
    for (int t0 = (blockIdx.x * 8 + wid) * 16; t0 < NTOK; t0 += gridDim.x * 8 * 16) {
        const int tt0 = t0 & (SEQ - 1);
        {
            float mpk[16], mnk[16], kkc[16]; ld16f(p.mu_prev + 1024 + c, mpk); ld16f(p.mu_next + 1024 + c, mnk); ld16f(p.k_k + c, kkc);
            const u16* zc = ZS + (size_t)t0 * 3328 + 1024 + c;
            Z16 kp = tt0 > 0 ? ldz(zc - 3328) : zz(), kc = ldz(zc);
#pragma unroll 2
            for (int i = 0; i < 16; ++i) {
                const bool hn = (tt0 + i) < SEQ - 1; const Z16 kn = hn ? ldz(zc + (size_t)(i + 1) * 3328) : zz();
                float k[16], kk[16]; mix16(kp, kc, kn, mpk, mnk, k);
                float s2 = 0.f;
#pragma unroll
                for (int q = 0; q < 16; ++q) { kk[q] = k[q] * kkc[q]; s2 += kk[q] * kk[q]; }
                s2 += __shfl_xor(s2, 1); s2 += __shfl_xor(s2, 2);
                const float inv = -1.0f / fmaxf(sqrtf(s2), 1e-12f);
                const size_t o = (size_t)(t0 + i) * RW + c;
#pragma unroll
                for (int j4 = 0; j4 < 4; ++j4) *(f32x4*)(A + o + j4 * 4) = (f32x4){kk[j4 * 4] * inv, kk[j4 * 4 + 1] * inv, kk[j4 * 4 + 2] * inv, kk[j4 * 4 + 3] * inv};
                st16bf(Kb + o, k);
                kp = kc; kc = kn;
            }
        }
        {
            float mpr[16], mnr[16], rkc[16]; ld16f(p.mu_prev + c, mpr); ld16f(p.mu_next + c, mnr); ld16f(p.r_k + c, rkc);
            const u16* zc = ZS + (size_t)t0 * 3328 + c;
            Z16 rp = tt0 > 0 ? ldz(zc - 3328) : zz(), rc = ldz(zc);
#pragma unroll 2
            for (int i = 0; i < 16; ++i) {
                const bool hn = (tt0 + i) < SEQ - 1; const Z16 rn = hn ? ldz(zc + (size_t)(i + 1) * 3328) : zz();
                const size_t o = (size_t)(t0 + i) * RW + c;
                float r[16], k[16]; mix16(rp, rc, rn, mpr, mnr, r); unz(ldz(Kb + o), k);
                float bs = 0.f;
#pragma unroll
                for (int q = 0; q < 16; ++q) bs += r[q] * k[q] * rkc[q];
                bs += __shfl_xor(bs, 1); bs += __shfl_xor(bs, 2);
#pragma unroll
                for (int j4 = 0; j4 < 4; ++j4) *(f32x4*)(R + o + j4 * 4) = (f32x4){r[j4 * 4], r[j4 * 4 + 1], r[j4 * 4 + 2], r[j4 * 4 + 3]};
                if ((lane & 3) == 0) BON[(size_t)(t0 + i) * 16 + (lane >> 2)] = bs;
                rp = rc; rc = rn;
            }
        }
        {
            float mpv[16], mnv[16]; ld16f(p.mu_prev + 2048 + c, mpv); ld16f(p.mu_next + 2048 + c, mnv);
            const int cl = 3072 + lane * 4; const f32x4 la = *(const f32x4*)(p.mu_prev + cl), lb = *(const f32x4*)(p.mu_next + cl);
            const int alc = ((lane >> 4) & 1) * 128 + (lane >> 5) * 64 + (lane & 15) * 4;
            const u16* zc = ZS + (size_t)t0 * 3328;
            Z16 vp = tt0 > 0 ? ldz(zc - 3328 + 2048 + c) : zz(), vc = ldz(zc + 2048 + c);
            u32x2 lp = tt0 > 0 ? *(const u32x2*)(zc - 3328 + cl) : (u32x2){0u, 0u}, lc = *(const u32x2*)(zc + cl);
#pragma unroll 2
            for (int i = 0; i < 16; ++i) {
                const bool hn = (tt0 + i) < SEQ - 1; const u16* zn = zc + (size_t)(i + 1) * 3328;
                const Z16 vn = hn ? ldz(zn + 2048 + c) : zz(); const u32x2 ln = hn ? *(const u32x2*)(zn + cl) : (u32x2){0u, 0u};
                float v[16]; mix16(vp, vc, vn, mpv, mnv, v);
                st16bf(V + (size_t)(t0 + i) * RW + c, v);
                const float z4[4] = {bflo(lc.x), bfhi(lc.x), bflo(lc.y), bfhi(lc.y)}, p4[4] = {bflo(lp.x), bfhi(lp.x), bflo(lp.y), bfhi(lp.y)}, n4[4] = {bflo(ln.x), bfhi(ln.x), bflo(ln.y), bfhi(ln.y)};
                float o4[4];
#pragma unroll
                for (int j = 0; j < 4; ++j) { const float sft = z4[j] + la[j] * (p4[j] - z4[j]) + lb[j] * (n4[j] - z4[j]); o4[j] = (lane < 32) ? tanhf(sft) : sft; }
                u32x2 w; w.x = cvt_pk_bf16(o4[0], o4[1]); w.y = cvt_pk_bf16(o4[2], o4[3]); *(u32x2*)(AL + (size_t)(t0 + i) * 256 + alc) = w;
                vp = vc; vc = vn; lp = lc; lc = ln;
            }
        }
    }
}

__device__ __forceinline__ void nat_phase(const Params& p, float* ldsf, int wave0, int nwaves) {
    const int lane = threadIdx.x & 63, wid = __builtin_amdgcn_readfirstlane(threadIdx.x >> 6), l15 = lane & 15, lq = lane >> 4;
    const u16* Qn = (const u16*)p.out; const u16* Kn = Qn + (size_t)NTOK * RW; const u16* VT = Kn + (size_t)NTOK * RW; const u16* Gn = VT + (size_t)NTOK * RW;
    u16* MIX = (u16*)(p.ws + O_HN);
    for (int item = wave0; item < 8192; item += nwaves) {
        const int r = item & 255, h = (item >> 8) & 15, b = item >> 12;
        const int rs = min(max(r - 4, 0), 248);
        const u16* Qb = Qn + (size_t)(b * SEQ + r * 64) * RW + h * 64;
        const u16* Kb = Kn + (size_t)(b * SEQ + rs * 64) * RW + h * 64;
        const u16* Vb = VT + (size_t)((b * 16 + h) * 64) * SEQ + rs * 64;
        float* tb = ldsf + wid * 256;
        { const float* rpb = p.rpb + h * 465 + (rs - r + 7) * 31;
#pragma unroll
          for (int q = 0; q < 4; ++q) { const int e = lane + q * 64; if (e < 248) tb[e] = rpb[e]; } }
#pragma unroll 1
        for (int qt = 0; qt < 4; ++qt) {
            const int c0 = qt * 16, cs0 = (qt == 0) ? 0 : (qt == 1 ? 8 : (qt == 2 ? 24 : 32));
            const int c = c0 + l15, csq = min(max(c - 8, 0), 48);
            const bf16x8 bq0 = *(const bf16x8*)(Qb + (size_t)c * RW + lq * 8), bq1 = *(const bf16x8*)(Qb + (size_t)c * RW + 32 + lq * 8);
            f32x4 sc[8][2];
#pragma unroll
            for (int i = 0; i < 8; ++i)
#pragma unroll
                for (int hf = 0; hf < 2; ++hf) { const u16* kp = Kb + (size_t)(i * 64 + cs0 + (l15 >> 2) * 8 + hf * 4 + (l15 & 3)) * RW + lq * 8;
                    const bf16x8 a0 = *(const bf16x8*)kp, a1 = *(const bf16x8*)(kp + 32); f32x4 z = {0.f, 0.f, 0.f, 0.f};
                    z = __builtin_amdgcn_mfma_f32_16x16x32_bf16(a0, bq0, z, 0, 0, 0); z = __builtin_amdgcn_mfma_f32_16x16x32_bf16(a1, bq1, z, 0, 0, 0); sc[i][hf] = z; }
            float mx = -1e30f;
#pragma unroll
            for (int i = 0; i < 8; ++i)
#pragma unroll
                for (int hf = 0; hf < 2; ++hf)
#pragma unroll
                    for (int j = 0; j < 4; ++j) { const int kc = cs0 + lq * 8 + hf * 4 + j; const bool valid = (kc >= csq) && (kc < csq + 16); const int bc = valid ? (kc - c + 15) : 0;
                        const float s = valid ? sc[i][hf][j] * 0.125f + tb[i * 31 + bc] : -1e30f; sc[i][hf][j] = s; mx = fmaxf(mx, s); }
            mx = fmaxf(mx, __shfl_xor(mx, 16)); mx = fmaxf(mx, __shfl_xor(mx, 32));
            float sum = 0.f;
#pragma unroll
            for (int i = 0; i < 8; ++i)
#pragma unroll
                for (int hf = 0; hf < 2; ++hf)
#pragma unroll
                    for (int j = 0; j < 4; ++j) { const float e = __expf(sc[i][hf][j] - mx); sc[i][hf][j] = e; sum += e; }
            sum += __shfl_xor(sum, 16); sum += __shfl_xor(sum, 32);
            const float inv = 1.0f / sum;
            f32x4 o[4];
#pragma unroll
            for (int mt = 0; mt < 4; ++mt) o[mt] = (f32x4){0.f, 0.f, 0.f, 0.f};
#pragma unroll
            for (int i = 0; i < 8; ++i) {
                u32x4 pw; pw.x = cvt_pk_bf16(sc[i][0][0] * inv, sc[i][0][1] * inv); pw.y = cvt_pk_bf16(sc[i][0][2] * inv, sc[i][0][3] * inv);
                pw.z = cvt_pk_bf16(sc[i][1][0] * inv, sc[i][1][1] * inv); pw.w = cvt_pk_bf16(sc[i][1][2] * inv, sc[i][1][3] * inv);
                const bf16x8 bp = __builtin_bit_cast(bf16x8, pw);
#pragma unroll
                for (int mt = 0; mt < 4; ++mt) { const u16* vp = Vb + (size_t)(mt * 16 + l15) * SEQ + i * 64 + cs0 + lq * 8;
                    o[mt] = __builtin_amdgcn_mfma_f32_16x16x32_bf16(*(const bf16x8*)vp, bp, o[mt], 0, 0, 0); }
            }
            const size_t tok = (size_t)(b * SEQ + r * 64 + c);
#pragma unroll
            for (int mt = 0; mt < 4; ++mt) { const int ch = h * 64 + mt * 16 + lq * 4; const u32x2 gw = *(const u32x2*)(Gn + tok * RW + ch);
                const float g0 = bflo(gw.x), g1 = bfhi(gw.x), g2 = bflo(gw.y), g3 = bfhi(gw.y);
                u32x2 w; w.x = cvt_pk_bf16(o[mt][0] * g0 * sigmoidf_(g0), o[mt][1] * g1 * sigmoidf_(g1)); w.y = cvt_pk_bf16(o[mt][2] * g2 * sigmoidf_(g2), o[mt][3] * g3 * sigmoidf_(g3));
                *(u32x2*)(MIX + tok * DM + 1024 + ch) = w; }
        }
    }
}

template <int N> __device__ __forceinline__ void fmac_bc(float& d, float bsrc, float o) { asm volatile("v_fmac_f32_dpp %0, %1, %2 row_newbcast:%3 row_mask:0xf bank_mask:0xf" : "+v"(d) : "v"(bsrc), "v"(o), "n"(N)); }
template <int N> __device__ __forceinline__ float mul_bc(float bsrc, float o) { float d; asm volatile("v_mul_f32_dpp %0, %1, %2 row_newbcast:%3 row_mask:0xf bank_mask:0xf" : "=v"(d) : "v"(bsrc), "v"(o), "n"(N)); return d; }
struct In1 { f32x4 w, a, b, kd; unsigned v; u32x2 kw; };
struct In2 { f32x4 w, a, b, kd, r; unsigned v; float yo; u32x2 kw; };
#define DERIVE_B(set) { set.b = set.a * set.b; asm volatile("" : "+v"(set.b)); }
#define DERIVE_BK(set) { const f32x4 f_ = set.b * ka4 + c04; set.b = set.a * set.b; const f32x4 k_ = {bflo(set.kw.x), bfhi(set.kw.x), bflo(set.kw.y), bfhi(set.kw.y)}; set.kd = k_ * f_; asm volatile("" : "+v"(set.b), "+v"(set.kd)); }
#define BC(x, k) x[(k) & 3]
#define DPPM " row_mask:0xf bank_mask:0xf\n"
template <int K> struct ScanK {
    static constexpr int N0 = K >> 2, N1 = (K + 4) >> 2;
    static __device__ __forceinline__ void dot(const float (&S)[64], const f32x4& a, float (&s)[4]) {
        if constexpr (K == 0) {
            asm volatile("v_mul_f32_dpp %0, %4, %8 row_newbcast:%16" DPPM "v_mul_f32_dpp %1, %5, %9 row_newbcast:%16" DPPM "v_mul_f32_dpp %2, %6, %10 row_newbcast:%16" DPPM "v_mul_f32_dpp %3, %7, %11 row_newbcast:%16" DPPM
                         "v_fmac_f32_dpp %0, %4, %12 row_newbcast:%17" DPPM "v_fmac_f32_dpp %1, %5, %13 row_newbcast:%17" DPPM "v_fmac_f32_dpp %2, %6, %14 row_newbcast:%17" DPPM "v_fmac_f32_dpp %3, %7, %15 row_newbcast:%17" DPPM
                         : "=&v"(s[0]), "=&v"(s[1]), "=&v"(s[2]), "=&v"(s[3])
                         : "v"(a[0]), "v"(a[1]), "v"(a[2]), "v"(a[3]), "v"(S[K]), "v"(S[K + 1]), "v"(S[K + 2]), "v"(S[K + 3]), "v"(S[K + 4]), "v"(S[K + 5]), "v"(S[K + 6]), "v"(S[K + 7]), "n"(N0), "n"(N1));
        } else
        asm volatile("v_fmac_f32_dpp %0, %4, %8 row_newbcast:%16" DPPM "v_fmac_f32_dpp %1, %5, %9 row_newbcast:%16" DPPM "v_fmac_f32_dpp %2, %6, %10 row_newbcast:%16" DPPM "v_fmac_f32_dpp %3, %7, %11 row_newbcast:%16" DPPM
                     "v_fmac_f32_dpp %0, %4, %12 row_newbcast:%17" DPPM "v_fmac_f32_dpp %1, %5, %13 row_newbcast:%17" DPPM "v_fmac_f32_dpp %2, %6, %14 row_newbcast:%17" DPPM "v_fmac_f32_dpp %3, %7, %15 row_newbcast:%17" DPPM
                     : "+v"(s[0]), "+v"(s[1]), "+v"(s[2]), "+v"(s[3])
                     : "v"(a[0]), "v"(a[1]), "v"(a[2]), "v"(a[3]), "v"(S[K]), "v"(S[K + 1]), "v"(S[K + 2]), "v"(S[K + 3]), "v"(S[K + 4]), "v"(S[K + 5]), "v"(S[K + 6]), "v"(S[K + 7]), "n"(N0), "n"(N1));
        if constexpr (K + 8 < 64) ScanK<K + 8>::dot(S, a, s);
    }
    static __device__ __forceinline__ void upd(float (&S)[64], const In2& in, float sa, float vv, float& y0, float& y1) {
        float t0, t1, t2, t3;
        asm volatile("v_mul_f32_dpp %0, %10, %27 row_newbcast:%28" DPPM "v_mul_f32_dpp %1, %11, %27 row_newbcast:%28" DPPM "v_mul_f32_dpp %2, %12, %27 row_newbcast:%28" DPPM "v_mul_f32_dpp %3, %13, %27 row_newbcast:%28" DPPM
                     "v_fmac_f32_dpp %0, %14, %6 row_newbcast:%28" DPPM "v_fmac_f32_dpp %1, %15, %7 row_newbcast:%28" DPPM "v_fmac_f32_dpp %2, %16, %8 row_newbcast:%28" DPPM "v_fmac_f32_dpp %3, %17, %9 row_newbcast:%28" DPPM
                     "v_fmac_f32_dpp %0, %18, %26 row_newbcast:%28" DPPM "v_fmac_f32_dpp %1, %19, %26 row_newbcast:%28" DPPM "v_fmac_f32_dpp %2, %20, %26 row_newbcast:%28" DPPM "v_fmac_f32_dpp %3, %21, %26 row_newbcast:%28" DPPM
                     "v_fmac_f32_dpp %4, %22, %0 row_newbcast:%28" DPPM "v_fmac_f32_dpp %5, %23, %1 row_newbcast:%28" DPPM "v_fmac_f32_dpp %4, %24, %2 row_newbcast:%28" DPPM "v_fmac_f32_dpp %5, %25, %3 row_newbcast:%28" DPPM
                     : "=&v"(t0), "=&v"(t1), "=&v"(t2), "=&v"(t3), "+v"(y0), "+v"(y1)
                     : "v"(S[K]), "v"(S[K + 1]), "v"(S[K + 2]), "v"(S[K + 3]), "v"(in.kd[0]), "v"(in.kd[1]), "v"(in.kd[2]), "v"(in.kd[3]), "v"(in.w[0]), "v"(in.w[1]), "v"(in.w[2]), "v"(in.w[3]),
                       "v"(in.b[0]), "v"(in.b[1]), "v"(in.b[2]), "v"(in.b[3]), "v"(in.r[0]), "v"(in.r[1]), "v"(in.r[2]), "v"(in.r[3]), "v"(sa), "v"(vv), "n"(N0));
        S[K] = t0; S[K + 1] = t1; S[K + 2] = t2; S[K + 3] = t3;
        if constexpr (K + 4 < 64) ScanK<K + 4>::upd(S, in, sa, vv, y0, y1);
    }
    static __device__ __forceinline__ void updS(float (&S)[64], const In1& in, float sa, float vv) {
        float t0, t1, t2, t3;
        asm volatile("v_mul_f32_dpp %0, %8, %21 row_newbcast:%22" DPPM "v_mul_f32_dpp %1, %9, %21 row_newbcast:%22" DPPM "v_mul_f32_dpp %2, %10, %21 row_newbcast:%22" DPPM "v_mul_f32_dpp %3, %11, %21 row_newbcast:%22" DPPM
                     "v_fmac_f32_dpp %0, %12, %4 row_newbcast:%22" DPPM "v_fmac_f32_dpp %1, %13, %5 row_newbcast:%22" DPPM "v_fmac_f32_dpp %2, %14, %6 row_newbcast:%22" DPPM "v_fmac_f32_dpp %3, %15, %7 row_newbcast:%22" DPPM
                     "v_fmac_f32_dpp %0, %16, %20 row_newbcast:%22" DPPM "v_fmac_f32_dpp %1, %17, %20 row_newbcast:%22" DPPM "v_fmac_f32_dpp %2, %18, %20 row_newbcast:%22" DPPM "v_fmac_f32_dpp %3, %19, %20 row_newbcast:%22" DPPM
                     : "=&v"(t0), "=&v"(t1), "=&v"(t2), "=&v"(t3)
                     : "v"(S[K]), "v"(S[K + 1]), "v"(S[K + 2]), "v"(S[K + 3]), "v"(in.kd[0]), "v"(in.kd[1]), "v"(in.kd[2]), "v"(in.kd[3]), "v"(in.w[0]), "v"(in.w[1]), "v"(in.w[2]), "v"(in.w[3]),
                       "v"(in.b[0]), "v"(in.b[1]), "v"(in.b[2]), "v"(in.b[3]), "v"(sa), "v"(vv), "n"(N0));
        S[K] = t0; S[K + 1] = t1; S[K + 2] = t2; S[K + 3] = t3;
        if constexpr (K + 4 < 64) ScanK<K + 4>::updS(S, in, sa, vv);
    }
    static __device__ __forceinline__ void updP(float (&P)[64], const In1& in, float sa) {
        float u0, u1, u2, u3;
        asm volatile("v_mul_f32_dpp %0, %8, %4 row_newbcast:%17" DPPM "v_mul_f32_dpp %1, %9, %5 row_newbcast:%17" DPPM "v_mul_f32_dpp %2, %10, %6 row_newbcast:%17" DPPM "v_mul_f32_dpp %3, %11, %7 row_newbcast:%17" DPPM
                     "v_fmac_f32_dpp %0, %12, %16 row_newbcast:%17" DPPM "v_fmac_f32_dpp %1, %13, %16 row_newbcast:%17" DPPM "v_fmac_f32_dpp %2, %14, %16 row_newbcast:%17" DPPM "v_fmac_f32_dpp %3, %15, %16 row_newbcast:%17" DPPM
                     : "=&v"(u0), "=&v"(u1), "=&v"(u2), "=&v"(u3)
                     : "v"(P[K]), "v"(P[K + 1]), "v"(P[K + 2]), "v"(P[K + 3]), "v"(in.w[0]), "v"(in.w[1]), "v"(in.w[2]), "v"(in.w[3]), "v"(in.b[0]), "v"(in.b[1]), "v"(in.b[2]), "v"(in.b[3]), "v"(sa), "n"(N0));
        P[K] = u0; P[K + 1] = u1; P[K + 2] = u2; P[K + 3] = u3;
        if constexpr (K + 4 < 64) ScanK<K + 4>::updP(P, in, sa);
    }
};
template <bool MIX> __device__ __forceinline__ void scan_pass1(const Params& p, int d, float* ldsf) {
    const int lane = threadIdx.x & 63, wid = __builtin_amdgcn_readfirstlane(threadIdx.x >> 6); const unsigned lo16 = (lane & 15) * 16, lo2 = lane * 2;
    const float* Wd = (const float*)(p.ws + O_KD); const float* Bd = (const float*)(p.ws + O_Y); const u16* KB = (const u16*)(p.ws + O_K); const float* A = (const float*)(p.ws + O_A);
    const u16* V = (const u16*)(p.ws + O_V); float* PT = (float*)(p.ws + O_PT); float* SLT = (float*)(p.ws + O_SLT); const unsigned lo8 = (lane & 15) * 8;
    constexpr int NS = 32 * (NC - 1);
    unsigned* qctr = (unsigned*)(p.ws + O_BAR);
    if (MIX && wid >= 4) nat_phase(p, ldsf, blockIdx.x * 4 + (wid - 4), gridDim.x * 4);
#define NEXT_ITEM() (MIX ? (int)__builtin_amdgcn_readfirstlane(lane == 0 ? __hip_atomic_fetch_add(qctr, 1u, __ATOMIC_RELAXED, __HIP_MEMORY_SCOPE_AGENT) : 0u) : item + (int)gridDim.x * 8)
    for (int item = MIX ? NEXT_ITEM() : (int)(blockIdx.x * 8 + wid); item < 2 * NS; item = NEXT_ITEM()) {
        const bool isP = item >= NS; const int idx = isP ? item - NS : item;
        const int bh = idx / (NC - 1), c = idx - bh * (NC - 1), b = bh >> 4, h = bh & 15;
        const int t0 = d ? (SEQ - 1 - c * LC) : c * LC;
        const size_t off0 = ((size_t)(b * SEQ + t0)) * RW + h * 64; const long stp = d ? -(long)RW : (long)RW;
        const unsigned ob4 = (unsigned)(off0 * 4), ob2 = (unsigned)(off0 * 2);
        const f32x4 ka4 = *(const f32x4*)(p.k_a + h * 64 + (lane & 15) * 4), c04 = 1.0f - ka4;
        float S[64]; int ln = lane; asm volatile("" : "+v"(ln));
#define SB __builtin_amdgcn_sched_barrier(0)
#define MKR(ptr) __builtin_amdgcn_make_buffer_rsrc((void*)(ptr), 0, 0x7fffffff, 0x00027000)
#define LDX(rs, so4) __builtin_bit_cast(f32x4, __builtin_amdgcn_raw_buffer_load_b128(rs, lo16, so4, 0))
        const __amdgpu_buffer_rsrc_t rW = MKR(Wd), rA = MKR(A), rB = MKR(Bd), rK = MKR(KB), rV = MKR(V);
        if (!isP) {
#pragma unroll
            for (int i = 0; i < 64; ++i) S[i] = 0.f;
#define LD1(set, s) { const int e_ = min((int)(s), LC - 1) * (int)stp; const unsigned s4_ = ob4 + (unsigned)(e_ * 4), s2_ = ob2 + (unsigned)(e_ * 2); set.w = LDX(rW, s4_); set.a = LDX(rA, s4_); set.b = LDX(rB, s4_); \
            set.kw = __builtin_amdgcn_raw_buffer_load_b64(rK, lo8, s2_, 0); set.v = __builtin_amdgcn_raw_buffer_load_b16(rV, lo2, s2_, 0); }
#define TOUCH1(set) asm volatile("" :: "v"(set.w), "v"(set.a), "v"(set.b), "v"(set.kw), "v"(set.v))
#define ST1(set) { DERIVE_BK(set); float sd[4]; ScanK<0>::dot(S, set.a, sd); ScanK<0>::updS(S, set, -((sd[0] + sd[1]) + (sd[2] + sd[3])), __uint_as_float(set.v << 16)); }
            In1 i0, i1; LD1(i0, 0);
#pragma unroll 1
            for (int s = 0; s < LC; s += 2) { TOUCH1(i0); SB; LD1(i1, s + 1); SB; ST1(i0); TOUCH1(i1); SB; LD1(i0, s + 2); SB; ST1(i1); }
#undef LD1
#undef TOUCH1
#undef ST1
        } else {
#pragma unroll
            for (int i = 0; i < 64; ++i) S[i] = (ln == i) ? 1.f : 0.f;
#define LD1(set, s) { const int e_ = min((int)(s), LC - 1) * (int)stp; const unsigned s4_ = ob4 + (unsigned)(e_ * 4); set.w = LDX(rW, s4_); set.a = LDX(rA, s4_); set.b = LDX(rB, s4_); }
#define TOUCH1(set) asm volatile("" :: "v"(set.w), "v"(set.a), "v"(set.b))
#define ST1(set) { DERIVE_B(set); float sd[4]; ScanK<0>::dot(S, set.a, sd); ScanK<0>::updP(S, set, -((sd[0] + sd[1]) + (sd[2] + sd[3]))); }
            In1 i0, i1; LD1(i0, 0);
#pragma unroll 1
            for (int s = 0; s < LC; s += 2) { TOUCH1(i0); SB; LD1(i1, s + 1); SB; ST1(i0); TOUCH1(i1); SB; LD1(i0, s + 2); SB; ST1(i1); }
#undef LD1
#undef TOUCH1
#undef ST1
        }
        float* po = (isP ? PT : SLT) + ((size_t)(bh * NC + c)) * 4096 + lane * 64;
#pragma unroll
        for (int i = 0; i < 16; ++i) *(f32x4*)(po + 4 * i) = (f32x4){S[4 * i], S[4 * i + 1], S[4 * i + 2], S[4 * i + 3]};
    }
}
template <int J> struct CombJ {
    static __device__ __forceinline__ void run(const LAS float* pl, const float (&sq)[4], float (&ac)[4]) {
        const float p0 = pl[(J) * 64], p1 = pl[(16 + J) * 64], p2 = pl[(32 + J) * 64], p3 = pl[(48 + J) * 64];
        fmac_bc<J>(ac[0], sq[0], p0); fmac_bc<J>(ac[1], sq[1], p1); fmac_bc<J>(ac[2], sq[2], p2); fmac_bc<J>(ac[3], sq[3], p3);
        if constexpr (J + 1 < 16) CombJ<J + 1>::run(pl, sq, ac);
    }
};
__device__ __forceinline__ void scan_combine(const Params& p, unsigned char* lds) {
    const int tid = threadIdx.x, lane = tid & 63, wid = __builtin_amdgcn_readfirstlane(tid >> 6), l15 = lane & 15;
    const float* PT = (const float*)(p.ws + O_PT); const float* SLT = (const float*)(p.ws + O_SLT); float* SIT = (float*)(p.ws + O_SIT);
    LAS float* pbuf = (LAS float*)(LAS unsigned char*)lds;
    LAS float* rowb = pbuf + 8192 + wid * 64;
    for (int item = blockIdx.x; item < 256; item += gridDim.x) {
        const int bh = item >> 3, row = (item & 7) * 8 + wid;
        const float* pt = PT + (size_t)bh * NC * 4096 + tid * 8; const float* st = SLT + (size_t)bh * NC * 4096 + row * 64 + lane; float* si = SIT + (size_t)bh * NC * 4096 + row * 64 + lane;
        __syncthreads();
        { const f32x4 pa = *(const f32x4*)pt, pb = *(const f32x4*)(pt + 4); *(LAS f32x4*)(pbuf + tid * 8) = pa; *(LAS f32x4*)(pbuf + tid * 8 + 4) = pb; }
#define PLD(A, B, ci) { const size_t o_ = (size_t)min((int)(ci), NC - 2) * 4096; A = *(const f32x4*)(pt + o_); B = *(const f32x4*)(pt + o_ + 4); }
#define SLD(Sv, ci) { Sv = st[(size_t)min((int)(ci), NC - 2) * 4096]; }
        f32x4 pa0, pb0, pa1, pb1, pa2, pb2; float sl0, sl1, sl2;
        PLD(pa0, pb0, 1); PLD(pa1, pb1, 2); PLD(pa2, pb2, 3); SLD(sl0, 0); SLD(sl1, 1); SLD(sl2, 2);
        float sq[4] = {0.f, 0.f, 0.f, 0.f};
        __syncthreads();
#define CSTEP(c, PA, PB, SLV) { \
            const LAS float* pl = pbuf + ((c) & 1) * 4096 + lane; \
            float ac[4] = {SLV, 0.f, 0.f, 0.f}; \
            CombJ<0>::run(pl, sq, ac); \
            const float acc = (ac[0] + ac[1]) + (ac[2] + ac[3]); \
            rowb[lane] = acc; si[(size_t)((c) + 1) * 4096] = acc; \
            sq[0] = rowb[l15]; sq[1] = rowb[16 + l15]; sq[2] = rowb[32 + l15]; sq[3] = rowb[48 + l15]; \
            { LAS float* pn = pbuf + (((c) + 1) & 1) * 4096 + tid * 8; *(LAS f32x4*)pn = PA; *(LAS f32x4*)(pn + 4) = PB; } \
            PLD(PA, PB, (c) + 4); SLD(SLV, (c) + 3); \
            __syncthreads(); }
#pragma unroll 1
        for (int c = 0; c < NC - 1; c += 3) { CSTEP(c, pa0, pb0, sl0); CSTEP(c + 1, pa1, pb1, sl1); CSTEP(c + 2, pa2, pb2, sl2); }
#undef CSTEP
#undef PLD
#undef SLD
    }
}
__device__ __forceinline__ void scan_pass2(const Params& p, int d) {
    const int lane = threadIdx.x & 63, wid = __builtin_amdgcn_readfirstlane(threadIdx.x >> 6); const unsigned lo16 = (lane & 15) * 16, lo2 = lane * 2, lo4b = lane * 4;
    const float* Wd = (const float*)(p.ws + O_KD); const float* Bd = (const float*)(p.ws + O_Y); const u16* KB = (const u16*)(p.ws + O_K); const float* A = (const float*)(p.ws + O_A); const float* R = (const float*)(p.ws + O_R); const unsigned lo8 = (lane & 15) * 8;
    const u16* V = (const u16*)(p.ws + O_V); const float* SIT = (const float*)(p.ws + O_SIT); float* Y = p.out;
    for (int item = blockIdx.x * 8 + wid; item < 32 * NC; item += gridDim.x * 8) {
        const int bh = item / NC, c = item - bh * NC, b = bh >> 4, h = bh & 15;
        const int t0 = d ? (SEQ - 1 - c * LC) : c * LC;
        const size_t off0 = ((size_t)(b * SEQ + t0)) * RW + h * 64; const long stp = d ? -(long)RW : (long)RW;
        const unsigned ob4 = (unsigned)(off0 * 4), ob2 = (unsigned)(off0 * 2);
        const __amdgpu_buffer_rsrc_t rW = MKR(Wd), rA = MKR(A), rB = MKR(Bd), rK = MKR(KB), rV = MKR(V), rR = MKR(R), rY = MKR(Y);
        const f32x4 ka4 = *(const f32x4*)(p.k_a + h * 64 + (lane & 15) * 4), c04 = 1.0f - ka4;
        float S[64];
        if (c == 0) {
#pragma unroll
            for (int i = 0; i < 64; ++i) S[i] = 0.f;
        } else { const float* si = SIT + ((size_t)(bh * NC + c)) * 4096 + lane * 64;
#pragma unroll
            for (int i = 0; i < 16; ++i) { const f32x4 q = *(const f32x4*)(si + 4 * i); S[4 * i] = q[0]; S[4 * i + 1] = q[1]; S[4 * i + 2] = q[2]; S[4 * i + 3] = q[3]; } }
#define LD2(set, s) { const int e_ = min((int)(s), LC - 1) * (int)stp; const unsigned s4_ = ob4 + (unsigned)(e_ * 4), s2_ = ob2 + (unsigned)(e_ * 2); set.w = LDX(rW, s4_); set.a = LDX(rA, s4_); set.b = LDX(rB, s4_); \
            set.kw = __builtin_amdgcn_raw_buffer_load_b64(rK, lo8, s2_, 0); set.r = LDX(rR, s4_); set.v = __builtin_amdgcn_raw_buffer_load_b16(rV, lo2, s2_, 0); \
            set.yo = d ? __uint_as_float(__builtin_amdgcn_raw_buffer_load_b32(rY, lo4b, s4_, 0)) : 0.f; }
#define ST2(set, s) { DERIVE_BK(set); float sd[4]; ScanK<0>::dot(S, set.a, sd); float y0 = set.yo, y1 = 0.f; ScanK<0>::upd(S, set, -((sd[0] + sd[1]) + (sd[2] + sd[3])), __uint_as_float(set.v << 16), y0, y1); __builtin_amdgcn_raw_buffer_store_b32(__float_as_uint(y0 + y1), rY, lo4b, ob4 + (unsigned)((int)(s) * (int)stp * 4), 0); }
#define TOUCH2(set) asm volatile("" :: "v"(set.w), "v"(set.a), "v"(set.b), "v"(set.kw), "v"(set.r), "v"(set.v), "v"(set.yo))
        In2 i0, i1; LD2(i0, 0);
#pragma unroll 1
        for (int s = 0; s < LC; s += 2) { TOUCH2(i0); SB; LD2(i1, s + 1); SB; ST2(i0, s); TOUCH2(i1); SB; LD2(i0, s + 2); SB; ST2(i1, s + 1); }
#undef LD2
#undef ST2
    }
}

__device__ __forceinline__ void post_phase(const Params& p) {
    const int lane = threadIdx.x & 63, wid = threadIdx.x >> 6;
    const float* Y = p.out; const u16* V = (const u16*)(p.ws + O_V); const u16* ZG = (const u16*)(p.ws + O_ZG); const float* BON = (const float*)(p.ws + O_BON);
    u16* MIX = (u16*)(p.ws + O_HN); u16* PB = (u16*)(p.ws + O_AL);
    for (int t = blockIdx.x * 8 + wid; t < NTOK; t += gridDim.x * 8) {
        const int c = lane * 16; const size_t o = (size_t)t * RW + c;
        float y[16], v[16], g[16]; float s = 0.f;
#pragma unroll
        for (int j4 = 0; j4 < 4; ++j4) { const f32x4 a = *(const f32x4*)(Y + o + j4 * 4); y[j4 * 4] = a[0]; y[j4 * 4 + 1] = a[1]; y[j4 * 4 + 2] = a[2]; y[j4 * 4 + 3] = a[3]; s += a[0] + a[1] + a[2] + a[3]; }
        ld16bf(V + o, v); ld16bf(ZG + o, g);
        s += __shfl_xor(s, 1); s += __shfl_xor(s, 2); const float mu = s * (1.0f / 64.0f);
        float q = 0.f;
#pragma unroll
        for (int j = 0; j < 16; ++j) { y[j] -= mu; q += y[j] * y[j]; }
        q += __shfl_xor(q, 1); q += __shfl_xor(q, 2); const float rs = rsqrtf(q * (1.0f / 64.0f) + 64e-5f);
        const float bon = BON[(size_t)t * 16 + (lane >> 2)];
        float outv[16];
#pragma unroll
        for (int j4 = 0; j4 < 4; ++j4) { const f32x4 lw = *(const f32x4*)(p.lnx_w + c + j4 * 4), lb = *(const f32x4*)(p.lnx_b + c + j4 * 4);
#pragma unroll
            for (int j = 0; j < 4; ++j) { const int i = j4 * 4 + j; const float yn = y[i] * rs * lw[j] + lb[j]; outv[i] = (yn + bon * v[i]) * g[i] * sigmoidf_(g[i]); } }
        st16bf(MIX + (size_t)t * DM + c, outv);
        { const f32x4 pv = *(const f32x4*)(p.p + (size_t)t * 256 + lane * 4); u32x2 w; w.x = cvt_pk_bf16(pv[0], pv[1]); w.y = cvt_pk_bf16(pv[2], pv[3]); *(u32x2*)(PB + (size_t)t * 256 + lane * 4) = w; }
    }
}

#define XB_TMO      128
#define XB_XCNT(j)  (256  + 64 * (j))
#define XB_XSUB(j)  (1280 + 64 * (j))
#define XB_XGEN(j)  (2304 + 64 * (j))
#define XB_TOP      3328
#define XB_TOPGEN   3392
#define XCD_BAR_WORDS 3456
#define XB_SPIN_CAP (1u << 18)
__device__ __forceinline__ unsigned xb_ld(unsigned* p)              { return __hip_atomic_load(p, __ATOMIC_RELAXED, __HIP_MEMORY_SCOPE_AGENT); }
__device__ __forceinline__ unsigned xb_add(unsigned* p, unsigned v) { return __hip_atomic_fetch_add(p, v, __ATOMIC_RELAXED, __HIP_MEMORY_SCOPE_AGENT); }
__device__ __forceinline__ unsigned xb_xcc_id() { return (unsigned)__builtin_amdgcn_s_getreg((3 << 11) | 20) & 0xFu; }
#define XB_SPIN(cond, bar) do { unsigned _sp = 0; while (cond) { __builtin_amdgcn_s_sleep(1); \
    if ((++_sp & 255u) == 0u) { if (xb_ld(&(bar)[XB_TMO])) break; if (_sp > XB_SPIN_CAP) { atomicAdd(&(bar)[XB_TMO], 1u); break; } } } } while (0)
struct XcdBarrier { unsigned* bar; unsigned x; volatile LAS unsigned* st; };
__device__ __forceinline__ XcdBarrier xcd_barrier_post(unsigned* bar, volatile LAS unsigned* st) {
    XcdBarrier b; b.bar = bar; b.x = xb_xcc_id(); b.st = st;
    if (threadIdx.x == 0) (void)xb_add(&bar[XB_XCNT(b.x)], 1u);
    return b;
}
__device__ __forceinline__ void xcd_barrier_complete(unsigned* bar, unsigned x, unsigned& nloc, unsigned& nx) {
    const unsigned G = gridDim.x * gridDim.y * gridDim.z;
    unsigned sum, cnt, mine, sp = 0u;
    for (;;) {
        sum = 0u; cnt = 0u; mine = 0u;
#pragma unroll
        for (unsigned j = 0; j < 16; ++j) { const unsigned c = xb_ld(&bar[XB_XCNT(j)]); sum += c; cnt += (c > 0u) ? 1u : 0u; mine = (j == x) ? c : mine; }
        if (sum == G) break;
        __builtin_amdgcn_s_sleep(1);
        if ((++sp & 255u) == 0u) { if (xb_ld(&bar[XB_TMO])) break; if (sp > XB_SPIN_CAP) { atomicAdd(&bar[XB_TMO], 1u); break; } }
    }
    nloc = mine > 0u ? mine : 1u; nx = cnt > 0u ? cnt : 1u;
}
__device__ __forceinline__ void xcd_barrier(const XcdBarrier& b) {
    asm volatile("s_waitcnt vmcnt(0)" ::: "memory");
    __syncthreads();
    if (threadIdx.x == 0) {
        unsigned* bar = b.bar;
        __builtin_amdgcn_s_waitcnt(0);
        unsigned nloc = b.st[0], nx = b.st[1];
        if (nloc == 0u) { xcd_barrier_complete(bar, b.x, nloc, nx); b.st[0] = nloc; b.st[1] = nx; }
        const unsigned old = xb_add(&bar[XB_XSUB(b.x)], 1u);
        const unsigned gen = old / nloc;
        if (old + 1u == (gen + 1u) * nloc) {
            __builtin_amdgcn_fence(__ATOMIC_RELEASE, "agent");
            asm volatile("s_waitcnt vmcnt(0)" ::: "memory");
            const unsigned og = xb_add(&bar[XB_TOP], 1u);
            const unsigned tg = og / nx;
            if (og + 1u == (tg + 1u) * nx) xb_add(&bar[XB_TOPGEN], 1u);
            else XB_SPIN(xb_ld(&bar[XB_TOPGEN]) == tg, bar);
            __builtin_amdgcn_fence(__ATOMIC_ACQUIRE, "agent");
            xb_add(&bar[XB_XGEN(b.x)], 1u);
            asm volatile("s_waitcnt vmcnt(0)" ::: "memory");
        } else {
            XB_SPIN(xb_ld(&bar[XB_XGEN(b.x)]) == gen, bar);
            __builtin_amdgcn_fence(__ATOMIC_ACQUIRE, "agent");
            asm volatile("s_waitcnt vmcnt(0)" ::: "memory");
        }
    }
    __syncthreads();
}

__global__ void __launch_bounds__(NTHREADS, 2) mega(Params p) {
    extern __shared__ __attribute__((aligned(16))) unsigned char lds[];
    cg::grid_group grid = cg::this_grid();
    unsigned char* ws = p.ws;
    volatile LAS unsigned* xbw = (volatile LAS unsigned*)((LAS unsigned char*)lds + LDS_XB);
    if (threadIdx.x < 4) xbw[threadIdx.x] = 0u;
    __syncthreads();
    const XcdBarrier xbar = xcd_barrier_post((unsigned*)(ws + O_BAR), xbw);
#define PH_ON(n) (p.ph_lo <= (n) && (n) < p.ph_hi)
#define PH_END(n) do { if ((n) + 1 < p.ph_hi) { if ((n) == 0) grid.sync(); else xcd_barrier(xbar); } } while (0)
#ifndef PROBE_PH
#define PROBE_PH -1
#endif
#define RUN(n, ...) if (PH_ON(n)) { __VA_ARGS__ if (PROBE_PH == (n)) { __syncthreads(); __VA_ARGS__ } PH_END(n); }
    RUN(0,
        transpose_cvt(p.w_in, 2048, 8448, (u16*)(ws + O_W1T), 2048, (float*)lds);
        transpose_cvt(p.w_out, 2048, 2048, (u16*)(ws + O_W2T), 2048, (float*)lds);
        transpose_cvt(p.w_ple_gate, 2048, 2048, (u16*)(ws + O_W3T), 2048, (float*)lds);
        transpose_cvt(p.w_ple_proj, 256, 2048, (u16*)(ws + O_WPT), 256, (float*)lds);
        build_wlt(p);
        rownorm<true>(p.x, p.norm_mix_g, ws + O_HN);)
    RUN(1, {
        EpiZ e; e.zs = (u16*)(ws + O_ZS); e.zg = (u16*)(ws + O_ZG); e.qn = (u16*)p.out; e.kn = e.qn + (size_t)NTOK * RW; e.vt = e.kn + (size_t)NTOK * RW; e.gn = e.vt + (size_t)NTOK * RW;
        run_gemm(lds, (const u16*)(ws + O_HN), (const u16*)(ws + O_W1T), NTOK, 8448, 2048, e); })
    RUN(2, prep_phase(p);)
#define SCAN_DIR(d, pb) \
    RUN(pb, { \
        EpiLora e; e.w0 = p.decay_w0 + (d) * RW; e.a0 = p.iclr_a0 + (d) * RW; e.Wd = (float*)(ws + O_KD); e.IC = (float*)(ws + O_Y); \
        run_gemm(lds, (const u16*)(ws + O_AL) + 128 * (d), (const u16*)(ws + O_WLT) + (size_t)(d) * 2048 * 128, NTOK, 2048, 128, e, 256, 128); }) \
    RUN(pb + 1, scan_pass1<(d) == 0>(p, d, (float*)lds);) \
    RUN(pb + 2, scan_combine(p, lds);) \
    RUN(pb + 3, scan_pass2(p, d);)
    SCAN_DIR(0, 3)
    SCAN_DIR(1, 7)
    RUN(11, post_phase(p);)
    RUN(12, {
        EpiH e; e.X = p.x; e.H = p.out;
        run_gemm(lds, (const u16*)(ws + O_HN), (const u16*)(ws + O_W2T), NTOK, 2048, 2048, e);
        EpiBf e2; e2.O = (u16*)(ws + O_R); e2.ld = DM;
        run_gemm(lds, (const u16*)(ws + O_AL), (const u16*)(ws + O_WPT), NTOK, 2048, 256, e2); })
    RUN(13, rownorm<true>(p.out, p.ple_norm_g, ws + O_HN);)
    RUN(14, {
        EpiGate e; e.H = p.out; e.PP = (const u16*)(ws + O_R);
        run_gemm(lds, (const u16*)(ws + O_HN), (const u16*)(ws + O_W3T), NTOK, 2048, 2048, e); })
    RUN(15, rownorm<false>(p.out, p.final_g, p.out);)
}

extern "C" void kernel_launch(void* const* d_in, const int* in_sizes, int n_in, void* d_out, int out_size, void* d_ws, size_t ws_size, hipStream_t stream) {
    static int grid = 0;
    if (grid == 0) {
        if (n_in != 21 || out_size != NTOK * DM || ws_size < WS_END) { fprintf(stderr, "kernel_launch: unexpected shapes (n_in %d out %d ws %zu need %zu)\n", n_in, out_size, ws_size, (size_t)WS_END); grid = -1; return; }
        int dev = 0, cus = 0, per_cu = 0;
        hipGetDevice(&dev); hipDeviceGetAttribute(&cus, hipDeviceAttributeMultiprocessorCount, dev);
        hipFuncSetAttribute((const void*)mega, hipFuncAttributeMaxDynamicSharedMemorySize, LDS_BYTES);
        hipOccupancyMaxActiveBlocksPerMultiprocessor(&per_cu, (const void*)mega, NTHREADS, LDS_BYTES);
        if (per_cu < 1) { fprintf(stderr, "kernel_launch: occupancy query says %d blocks/CU\n", per_cu); grid = -1; return; }
        grid = cus;
    }
    if (grid < 0) return;
    Params p{};
    const float** f = (const float**)&p;
    for (int i = 0; i < 21; ++i) f[i] = (const float*)d_in[i];
    p.out = (float*)d_out; p.ws = (unsigned char*)d_ws;
    hipMemsetAsync((unsigned char*)d_ws + O_BAR, 0, XCD_BAR_WORDS * sizeof(unsigned), stream);
#if MULTI_LAUNCH
    for (int ph = 0; ph < 16; ++ph) { p.ph_lo = ph; p.ph_hi = ph + 1; hipLaunchKernelGGL(mega, dim3(grid), dim3(NTHREADS), LDS_BYTES, stream, p); }
#else
    p.ph_lo = 0; p.ph_hi = 16;
    void* args[] = {&p};
    hipError_t e = hipLaunchCooperativeKernel((const void*)mega, dim3(grid), dim3(NTHREADS), args, LDS_BYTES, stream);
    if (e != hipSuccess) fprintf(stderr, "cooperative launch failed: %s (grid %d)\n", hipGetErrorString(e), grid);
#endif
}
```
